# Optimizing an MI355X kernel written in HIP

```python
import math
import jax
import jax.numpy as jnp
from jax import lax
import numpy as np

D_MODEL = 1024
BATCH = 8
SEQ = 4096
DEPTH = 2

GRID_W = 64
CTX_LEN = 256
HEAD_DIM = 64
ROPE_THETA = 10000.0
ROPE_PAIRS_PER_AXIS = HEAD_DIM // 4
QBLOCK = 128
WINDOW = 128
A_HEADS = 8
A_KV_HEADS = 2
B_HEADS = 4
B_V_DIM = 2 * HEAD_DIM
C_HEADS = 8
C_KV_HEADS = 2
N_BRANCHES = 3
A_WIDTH = A_HEADS * HEAD_DIM
B_WIDTH = B_HEADS * B_V_DIM
C_WIDTH = C_HEADS * HEAD_DIM
Q_SIZES = (A_HEADS * HEAD_DIM, B_HEADS * 2 * HEAD_DIM, C_HEADS * HEAD_DIM, N_BRANCHES * D_MODEL)
KV_SIZES = (A_KV_HEADS * HEAD_DIM, A_KV_HEADS * HEAD_DIM, B_HEADS * 2 * HEAD_DIM, B_HEADS * B_V_DIM,
            C_KV_HEADS * HEAD_DIM, C_KV_HEADS * HEAD_DIM)
Q_COLS = sum(Q_SIZES)
IN_COLS = Q_COLS + sum(KV_SIZES)
N_GROUPS = 4
EXPERTS_PER_GROUP = 8
N_EXPERTS = N_GROUPS * EXPERTS_PER_GROUP
TOP_K = 2
EXPERT_HIDDEN = D_MODEL // 2
N_MOD = 6
EPS = 1e-6
NEG_INF = -1e30

kernel_name = "hybrid_diffusion_backbone_ctx_prefix"


def rms_norm(x, gain=None):
    xf = x.astype(jnp.float32)
    y = xf * lax.rsqrt(jnp.mean(xf * xf, axis=-1, keepdims=True) + EPS)
    if gain is not None:
        y = y * gain.astype(jnp.float32)
    return y.astype(x.dtype)


def modulate(x, shift, scale):
    return x * (1 + scale) + shift


def split_cols(t, sizes):
    return jnp.split(t, np.cumsum(sizes)[:-1].tolist(), axis=-1)


def axial_rope_tables(n_tokens):
    rows = n_tokens // GRID_W
    row = jnp.repeat(jnp.arange(rows, dtype=jnp.float32), GRID_W)
    col = jnp.tile(jnp.arange(GRID_W, dtype=jnp.float32), rows)
    freqs = ROPE_THETA ** (-jnp.arange(ROPE_PAIRS_PER_AXIS, dtype=jnp.float32) / ROPE_PAIRS_PER_AXIS)
    ang = jnp.concatenate([row[:, None] * freqs, col[:, None] * freqs], axis=-1)
    return jnp.cos(ang), jnp.sin(ang)


def apply_rope(x, rope):
    cos, sin = rope
    shape = (cos.shape[0],) + (1,) * (x.ndim - 3) + (cos.shape[1],)
    cos, sin = cos.reshape(shape), sin.reshape(shape)
    half = HEAD_DIM // 2
    xf = x.astype(jnp.float32)
    x1, x2 = xf[..., :half], xf[..., half:]
    return jnp.concatenate([x1 * cos - x2 * sin, x1 * sin + x2 * cos], axis=-1).astype(x.dtype)


def split_queries(qg, P, rope):
    aq, bq, cq, gates = split_cols(qg, Q_SIZES)
    n, t = qg.shape[:2]
    aq = rms_norm(aq.reshape(n, t, A_HEADS, HEAD_DIM), P["a_qnorm"])
    bq = rms_norm(bq.reshape(n, t, B_HEADS, 2, HEAD_DIM), P["b_qnorm"])
    cq = rms_norm(cq.reshape(n, t, C_HEADS, HEAD_DIM), P["c_qnorm"])
    if rope is not None:
        aq, bq, cq = apply_rope(aq, rope), apply_rope(bq, rope), apply_rope(cq, rope)
    aq = aq.reshape(n, t, A_KV_HEADS, A_HEADS // A_KV_HEADS, HEAD_DIM)
    cq = cq.reshape(n, t, C_KV_HEADS, C_HEADS // C_KV_HEADS, HEAD_DIM)
    return aq, bq, cq, gates


def split_keys_values(kv, P, rope):
    ak, av, bk, bv, ck, cv = split_cols(kv, KV_SIZES)
    n, s = kv.shape[:2]
    ak = rms_norm(ak.reshape(n, s, A_KV_HEADS, HEAD_DIM), P["a_knorm"])
    bk = rms_norm(bk.reshape(n, s, B_HEADS, 2, HEAD_DIM), P["b_knorm"])
    ck = rms_norm(ck.reshape(n, s, C_KV_HEADS, HEAD_DIM), P["c_knorm"])
    if rope is not None:
        ak, bk, ck = apply_rope(ak, rope), apply_rope(bk, rope), apply_rope(ck, rope)
    av = av.reshape(n, s, A_KV_HEADS, HEAD_DIM)
    bv = bv.reshape(n, s, B_HEADS, B_V_DIM)
    cv = cv.reshape(n, s, C_KV_HEADS, HEAD_DIM)
    return ak, av, bk, bv, ck, cv


def gqa_attend(q, k, v, mask=None, sink=None):
    s = jnp.einsum("btkgd,bskd->bkgts", q, k).astype(jnp.float32) * (q.shape[-1] ** -0.5)
    if mask is not None:
        s = jnp.where(mask, s, NEG_INF)
    if sink is not None:
        snk = jnp.broadcast_to(sink.astype(jnp.float32).reshape(1, k.shape[2], -1, 1, 1), s.shape[:-1] + (1,))
        p = jax.nn.softmax(jnp.concatenate([s, snk], axis=-1), axis=-1)[..., :-1]
    else:
        p = jax.nn.softmax(s, axis=-1)
    o = jnp.einsum("bkgts,bskd->btkgd", p.astype(v.dtype), v)
    return o.reshape(o.shape[:2] + (-1,))


def diff_attend(q, k, v, lam, subln_gain, lam_init):
    s = jnp.einsum("btncd,bsncd->bncts", q, k).astype(jnp.float32) * (q.shape[-1] ** -0.5)
    p = jax.nn.softmax(s, axis=-1)
    a = p[:, :, 0] - lam * p[:, :, 1]
    o = jnp.einsum("bnts,bsne->btne", a.astype(v.dtype), v)
    o = rms_norm(o, subln_gain) * (1.0 - lam_init)
    return o.reshape(o.shape[:2] + (-1,))


def sweep_query_blocks(attend_block, q):
    n, length = q.shape[:2]
    nb = length // QBLOCK
    qb = jnp.moveaxis(q.reshape((n, nb, QBLOCK) + q.shape[2:]), 1, 0)
    o = lax.map(lambda a: attend_block(a[0], a[1]), (jnp.arange(nb), qb))
    return jnp.moveaxis(o, 0, 1).reshape(n, length, -1)


def windowed_latent(q, k_lat, v_lat, k_ctx, v_ctx, sink):
    length = k_lat.shape[1]
    span = QBLOCK + 2 * WINDOW
    pad = ((0, 0), (WINDOW, WINDOW), (0, 0), (0, 0))
    kp, vp = jnp.pad(k_lat, pad), jnp.pad(v_lat, pad)
    rel = jnp.arange(span)[None, :] - WINDOW - jnp.arange(QBLOCK)[:, None]
    band = jnp.abs(rel) <= WINDOW
    ctx_cols = jnp.ones((QBLOCK, k_ctx.shape[1]), dtype=bool)

    def block(b, qb):
        start = b * QBLOCK
        kb = lax.dynamic_slice_in_dim(kp, start, span, axis=1)
        vb = lax.dynamic_slice_in_dim(vp, start, span, axis=1)
        kpos = start - WINDOW + jnp.arange(span)
        valid = band & ((kpos >= 0) & (kpos < length))[None, :]
        mask = jnp.concatenate([valid, ctx_cols], axis=-1)
        return gqa_attend(qb, jnp.concatenate([kb, k_ctx], axis=1), jnp.concatenate([vb, v_ctx], axis=1), mask, sink)

    return sweep_query_blocks(block, q)


def merge_branches(ya, yb, yc, gates, P):
    g = jax.nn.sigmoid(gates.astype(jnp.float32)).astype(ya.dtype)
    ga, gb, gc = jnp.split(g, N_BRANCHES, axis=-1)
    m = ga * (ya @ P["w_branch_a"]) + gb * (yb @ P["w_branch_b"]) + gc * (yc @ P["w_branch_c"])
    return m @ P["w_out"]


def hier_moe(h, w_rg, w_re, w_gate, w_up, w_down):
    n = h.shape[0]
    g_logits = (h @ w_rg).astype(jnp.float32)
    g_prob = jax.nn.softmax(g_logits, axis=-1)
    g_idx = jnp.argmax(g_logits, axis=-1)
    g_w = jnp.take_along_axis(g_prob, g_idx[:, None], axis=-1)
    e_logits = (h @ w_re).astype(jnp.float32).reshape(n, N_GROUPS, EXPERTS_PER_GROUP)
    e_in_group = jnp.take_along_axis(e_logits, g_idx[:, None, None], axis=1)[:, 0]
    top_v, top_i = lax.top_k(e_in_group, TOP_K)
    w = jax.nn.softmax(top_v, axis=-1) * g_w
    flat_e = (g_idx[:, None] * EXPERTS_PER_GROUP + top_i).reshape(-1)
    order = jnp.argsort(flat_e)
    tok = order // TOP_K
    sizes = jnp.bincount(flat_e, length=N_EXPERTS).astype(jnp.int32)
    xs = h[tok]
    a = lax.ragged_dot(xs, w_gate, sizes)
    u = lax.ragged_dot(xs, w_up, sizes)
    y = lax.ragged_dot(jax.nn.silu(a) * u, w_down, sizes)
    y = y * w.reshape(-1)[order][:, None].astype(y.dtype)
    return jax.ops.segment_sum(y, tok, num_segments=n)


def hybrid_layer(l, x, ctx, silu_c, silu_c_ctx, P, rope, need_ctx):
    n, length, d = x.shape
    c_len = ctx.shape[1]
    mod = (silu_c @ P["w_ada"] + P["b_ada"]).reshape(n, N_MOD, 1, d)
    cmod = (silu_c_ctx @ P["w_ada"] + P["b_ada"]).reshape(N_MOD, 1, 1, d)
    lam_init = 0.8 - 0.6 * math.exp(-0.3 * l)
    lam = (jnp.exp(jnp.sum(P["lambda_q1"].astype(jnp.float32) * P["lambda_k1"].astype(jnp.float32)))
           - jnp.exp(jnp.sum(P["lambda_q2"].astype(jnp.float32) * P["lambda_k2"].astype(jnp.float32)))
           + lam_init)

    h = modulate(rms_norm(x), mod[:, 0], mod[:, 1])
    hc = modulate(rms_norm(ctx), cmod[0], cmod[1])
    proj = h @ P["w_in"]
    aq, bq, cq, gates = split_queries(proj[..., :Q_COLS], P, rope)
    ak, av, bk, bv, ck, cv = split_keys_values(proj[..., Q_COLS:], P, rope)
    if need_ctx:
        cproj = hc @ P["w_in"]
        ckv_in = cproj[..., Q_COLS:]
    else:
        ckv_in = hc @ P["w_in"][:, Q_COLS:]
    xak, xav, xbk, xbv, xck, xcv = split_keys_values(ckv_in, P, None)

    k_a, v_a = jnp.concatenate([ak, xak], axis=1), jnp.concatenate([av, xav], axis=1)
    k_b, v_b = jnp.concatenate([bk, xbk], axis=1), jnp.concatenate([bv, xbv], axis=1)
    ya = sweep_query_blocks(lambda b, qb: gqa_attend(qb, k_a, v_a), aq)
    yb = sweep_query_blocks(lambda b, qb: diff_attend(qb, k_b, v_b, lam, P["b_subln"], lam_init), bq)
    yc = windowed_latent(cq, ck, cv, xck, xcv, P["c_sink"])
    x = x + mod[:, 2] * merge_branches(ya, yb, yc, gates, P)

    if need_ctx:
        caq, cbq, ccq, cgates = split_queries(cproj[..., :Q_COLS], P, None)
        cya = gqa_attend(caq, xak, xav)
        cyb = diff_attend(cbq, xbk, xbv, lam, P["b_subln"], lam_init)
        cyc = gqa_attend(ccq, xck, xcv, sink=P["c_sink"])
        ctx = ctx + cmod[2] * merge_branches(cya, cyb, cyc, cgates, P)

    h2 = modulate(rms_norm(x), mod[:, 3], mod[:, 4])
    tokens = h2.reshape(n * length, d)
    if need_ctx:
        hc2 = modulate(rms_norm(ctx), cmod[3], cmod[4])
        tokens = jnp.concatenate([tokens, hc2.reshape(n * c_len, d)], axis=0)
    f = hier_moe(tokens, P["w_router_group"], P["w_router_expert"], P["w_exp_gate"], P["w_exp_up"], P["w_exp_down"])
    f = f.astype(x.dtype)
    x = x + mod[:, 5] * f[: n * length].reshape(n, length, d)
    if need_ctx:
        ctx = ctx + cmod[5] * f[n * length:].reshape(n, c_len, d)
    return x, ctx


def setup_inputs(seed: int = 0) -> dict:
    key = jax.random.key(seed)
    ks = jax.random.split(key, 28)
    f32 = jnp.float32
    nrm = lambda k, shape, s: jax.random.normal(k, shape, f32) * s
    gain = lambda k, shape: 1.0 + 0.05 * jax.random.normal(k, shape, f32)
    D = D_MODEL
    return {
        "x": nrm(ks[0], (BATCH, SEQ, D), 1.0),
        "c": nrm(ks[1], (BATCH, D), 1.0),
        "ctx": nrm(ks[2], (BATCH, CTX_LEN, D), 1.0),
        "c_ctx": nrm(ks[3], (D,), 1.0),
        "w_ada": nrm(ks[4], (DEPTH, D, N_MOD * D), 0.5 * D ** -0.5),
        "b_ada": nrm(ks[5], (DEPTH, N_MOD * D), 0.02),
        "w_in": nrm(ks[6], (DEPTH, D, IN_COLS), D ** -0.5),
        "a_qnorm": gain(ks[7], (DEPTH, HEAD_DIM)),
        "a_knorm": gain(ks[8], (DEPTH, HEAD_DIM)),
        "b_qnorm": gain(ks[9], (DEPTH, HEAD_DIM)),
        "b_knorm": gain(ks[10], (DEPTH, HEAD_DIM)),
        "c_qnorm": gain(ks[11], (DEPTH, HEAD_DIM)),
        "c_knorm": gain(ks[12], (DEPTH, HEAD_DIM)),
        "lambda_q1": nrm(ks[13], (DEPTH, HEAD_DIM), 0.1),
        "lambda_k1": nrm(ks[14], (DEPTH, HEAD_DIM), 0.1),
        "lambda_q2": nrm(ks[15], (DEPTH, HEAD_DIM), 0.1),
        "lambda_k2": nrm(ks[16], (DEPTH, HEAD_DIM), 0.1),
        "b_subln": gain(ks[17], (DEPTH, B_V_DIM)),
        "c_sink": nrm(ks[18], (DEPTH, C_HEADS), 0.5),
        "w_branch_a": nrm(ks[19], (DEPTH, A_WIDTH, D), A_WIDTH ** -0.5),
        "w_branch_b": nrm(ks[20], (DEPTH, B_WIDTH, D), B_WIDTH ** -0.5),
        "w_branch_c": nrm(ks[21], (DEPTH, C_WIDTH, D), C_WIDTH ** -0.5),
        "w_out": nrm(ks[22], (DEPTH, D, D), D ** -0.5),
        "w_router_group": nrm(ks[23], (DEPTH, D, N_GROUPS), D ** -0.5),
        "w_router_expert": nrm(ks[24], (DEPTH, D, N_EXPERTS), D ** -0.5),
        "w_exp_gate": nrm(ks[25], (DEPTH, N_EXPERTS, D, EXPERT_HIDDEN), D ** -0.5),
        "w_exp_up": nrm(ks[26], (DEPTH, N_EXPERTS, D, EXPERT_HIDDEN), D ** -0.5),
        "w_exp_down": nrm(ks[27], (DEPTH, N_EXPERTS, EXPERT_HIDDEN, D), EXPERT_HIDDEN ** -0.5),
    }


def reference(x, c, ctx, c_ctx, w_ada, b_ada, w_in, a_qnorm, a_knorm, b_qnorm, b_knorm, c_qnorm, c_knorm,
              lambda_q1, lambda_k1, lambda_q2, lambda_k2, b_subln, c_sink, w_branch_a, w_branch_b, w_branch_c,
              w_out, w_router_group, w_router_expert, w_exp_gate, w_exp_up, w_exp_down):
    rope = axial_rope_tables(x.shape[1])
    silu_c = jax.nn.silu(c)
    silu_c_ctx = jax.nn.silu(c_ctx)
    for l in range(DEPTH):
        P = {
            "w_ada": w_ada[l], "b_ada": b_ada[l], "w_in": w_in[l],
            "a_qnorm": a_qnorm[l], "a_knorm": a_knorm[l], "b_qnorm": b_qnorm[l], "b_knorm": b_knorm[l],
            "c_qnorm": c_qnorm[l], "c_knorm": c_knorm[l],
            "lambda_q1": lambda_q1[l], "lambda_k1": lambda_k1[l], "lambda_q2": lambda_q2[l], "lambda_k2": lambda_k2[l],
            "b_subln": b_subln[l], "c_sink": c_sink[l],
            "w_branch_a": w_branch_a[l], "w_branch_b": w_branch_b[l], "w_branch_c": w_branch_c[l], "w_out": w_out[l],
            "w_router_group": w_router_group[l], "w_router_expert": w_router_expert[l],
            "w_exp_gate": w_exp_gate[l], "w_exp_up": w_exp_up[l], "w_exp_down": w_exp_down[l],
        }
        x, ctx = hybrid_layer(l, x, ctx, silu_c, silu_c_ctx, P, rope, l < DEPTH - 1)
    return x
```

```cpp
#include <hip/hip_runtime.h>
#include <hip/hip_bf16.h>
#include <cstdio>
#include <cstdint>
#include <cmath>

#ifndef MK_MULTI
#define MK_MULTI 0
#endif

constexpr int DM = 1024, NB = 8, SEQL = 4096, CTXL = 256, TOKB = SEQL + CTXL  , TT = NB * TOKB  ;
constexpr int RT_PER_B = TOKB / 256  , NRT = TT / 256  ;
constexpr int PW = 3072, GW = 3072, YW = 1536, OBW = 1024;
constexpr int NEXP = 32, EHID = 512, SLOT_MAX = 2 * TT + NEXP * 256  ;
constexpr float QSCALE = 0.125f * 1.4426950408889634f;
constexpr float LOG2E = 1.4426950408889634f;
constexpr int PC_AQ = 0, PC_BQ = 512, PC_CQ = 1024, PC_AK = 1536, PC_AV = 1664, PC_BK = 1792, PC_BV = 2304, PC_CK = 2816, PC_CV = 2944;

constexpr size_t MiB = 1u << 20;
constexpr size_t WS_CTL = 0, CTL_ZERO_BYTES = 1 * MiB;
constexpr size_t WS_SMALL = 1 * MiB;
constexpr size_t WS_WATT = 8 * MiB;
constexpr size_t WS_XCTX = 26 * MiB;
constexpr size_t WS_RP = 34 * MiB;
constexpr size_t WS_RG = 238 * MiB;
constexpr size_t WS_RY = 442 * MiB;
constexpr size_t WS_RO = 544 * MiB;
constexpr size_t WS_END = 612 * MiB;
constexpr size_t WS_W1T = WS_RG, WS_W2T = WS_RG + 64 * MiB, WS_ACT = WS_RG + 96 * MiB;
constexpr size_t SM_MOD = 0;
constexpr size_t SM_ROPE = 512 * 1024;
constexpr size_t SM_WRT = 640 * 1024;
constexpr size_t SM_RTE = 1 * MiB;
constexpr size_t SM_RTR = SM_RTE + 512 * 1024;
constexpr size_t SM_RTW = SM_RTR + 512 * 1024;
constexpr size_t SM_SLOT = SM_RTW + 512 * 1024;
constexpr size_t SM_WSLOT = SM_SLOT + 512 * 1024;
constexpr size_t SM_RTTAB = SM_WSLOT + 512 * 1024;
static_assert(SM_RTTAB + 4096 <= 7 * MiB, "small map");
constexpr int CW_BAR = 4096;
constexpr int CW_CNT = 16384;

namespace pg8 {
#define PG8_LAS __attribute__((address_space(3)))
typedef unsigned short bf16_t;
typedef short bf16x8 __attribute__((ext_vector_type(8)));
typedef float f32x4 __attribute__((ext_vector_type(4)));
typedef unsigned u32x4 __attribute__((ext_vector_type(4)));
typedef unsigned u32x2 __attribute__((ext_vector_type(2)));
constexpr int BM = 256, BK = 64, HALF = 128, HTB = HALF * BK * 2  , STAGE_BYTES = 8 * HTB, NXCD = 8, WGM = 8;

__host__ __device__ __forceinline__ int lds_byte(int r, int c) { const int st = (r >> 4) * 2 + (c >> 5), rr = r & 15, cc = c & 31, ob = rr * 64 + cc * 2; return st * 1024 + (ob ^ (((ob >> 9) & 1) << 5)); }
__host__ __device__ __forceinline__ void stage_rc(int b, int& R, int& C) { const int st = b / 1024, sb = b % 1024, swz = sb ^ (((sb >> 9) & 1) << 5); R = (st >> 1) * 16 + swz / 64; C = (st & 1) * 32 + (swz % 64) / 2; }
__host__ __device__ __forceinline__ int perm32(int rho) { const int n = rho >> 4, i = rho & 15; return 8 * (i >> 2) + 4 * n + (i & 3); }

struct Unit { const char* a; const char* b; int pm, pn, aux; };
struct Gemm { int lda, ldb, K; };

__device__ __forceinline__ unsigned cvt_pk_bf16(float lo, float hi) { unsigned r; asm volatile("v_cvt_pk_bf16_f32 %0, %1, %2" : "=v"(r) : "v"(lo), "v"(hi)); return r; }
__device__ __forceinline__ float bf_lo(unsigned u) { return __uint_as_float(u << 16); }
__device__ __forceinline__ float bf_hi(unsigned u) { return __uint_as_float(u & 0xffff0000u); }

__device__ __forceinline__ void tile_order(int wgid, int nM, int nN, int& pm, int& pn) {
    const int nwg = nM * nN;
    { const int q = nwg / NXCD, r = nwg % NXCD, xcd = wgid % NXCD, off = wgid / NXCD; wgid = (xcd < r ? xcd * (q + 1) : r * (q + 1) + (xcd - r) * q) + off; }
    const int nig = WGM * nN, gid = wgid / nig, fm = gid * WGM, gsz = (nM - fm) < WGM ? (nM - fm) : WGM;
    pm = fm + ((wgid % nig) % gsz); pn = (wgid % nig) / gsz;
}

template <class Epi, class Sched, bool ALIGN_EPI>
__device__ __forceinline__ void gemm_phase(PG8_LAS unsigned char* lds, const Gemm g, const Sched& S, const Epi& E) {
    int tid_ = threadIdx.x; asm volatile("" : "+v"(tid_));
    const int tid = tid_, wid = __builtin_amdgcn_readfirstlane(tid >> 6), lane = tid & 63, wr = wid >> 2, wc = wid & 3, fr = lane & 15, fq = lane >> 4;
    const int K = g.K, nt = K / BK;
    unsigned voffA[2], voffB[2];
#pragma unroll
    for (int i = 0; i < 2; ++i) { int R, C; stage_rc(tid * 16 + i * 8192, R, C); const int Rb = Epi::PERM ? ((R & ~31) + perm32(R & 31)) : R;
        voffA[i] = (unsigned)(R * g.lda + C) * 2u; voffB[i] = (unsigned)(Rb * g.ldb + C) * 2u; }
    const size_t kstep = (size_t)(BK * 2);
    const size_t hstepA = (size_t)HALF * g.lda * 2, hstepB = (size_t)HALF * g.ldb * 2;
    const unsigned ldsw = (unsigned)wid * 1024u;
    const int aoff = lds_byte(wr * 64 + fr, fq * 8), boff = lds_byte(wc * 32 + fr, fq * 8);
#define PG8_SA(b, h) (((b) * 2 + (h)) * HTB)
#define PG8_SB(b, h) ((4 + (b) * 2 + (h)) * HTB)
#define PG8_STAGE(bufoff, gbase, voff) do { _Pragma("unroll") for (int _i = 0; _i < 2; ++_i) \
        __builtin_amdgcn_global_load_lds((const unsigned*)((const char*)(gbase) + (voff)[_i]), (PG8_LAS unsigned*)(lds + (bufoff) + ldsw + _i * 8192), 16, 0, 0); } while (0)
#define PG8_LDA(dst, b, h) do { _Pragma("unroll") for (int m = 0; m < 4; ++m) _Pragma("unroll") for (int k = 0; k < 2; ++k) dst[m][k] = *(const PG8_LAS bf16x8*)(lds + PG8_SA(b, h) + aoff + m * 2048 + k * 1024); } while (0)
#define PG8_LDB(dst, b, h) do { _Pragma("unroll") for (int n = 0; n < 2; ++n) _Pragma("unroll") for (int k = 0; k < 2; ++k) dst[n][k] = *(const PG8_LAS bf16x8*)(lds + PG8_SB(b, h) + boff + n * 2048 + k * 1024); } while (0)
#define PG8_MMA(ai, bj, At, Bt) do { __builtin_amdgcn_s_setprio(1); _Pragma("unroll") for (int m = 0; m < 4; ++m) _Pragma("unroll") for (int n = 0; n < 2; ++n) _Pragma("unroll") for (int k = 0; k < 2; ++k) \
        acc[ai][bj][m][n] = __builtin_amdgcn_mfma_f32_16x16x32_bf16(Bt[n][k], At[m][k], acc[ai][bj][m][n], 0, 0, 0); __builtin_amdgcn_s_setprio(0); } while (0)
#define PG8_WAIT_V(n) asm volatile("s_waitcnt vmcnt(" #n ")" ::: "memory")
#define PG8_WAIT_L(n) asm volatile("s_waitcnt lgkmcnt(" #n ")" ::: "memory")
#define PG8_BAR __builtin_amdgcn_s_barrier()
#define PG8_SCHED __builtin_amdgcn_sched_barrier(0)
    Unit cur, nxt; int ui = 0;
    if (!S.next(0, cur)) return;
    f32x4 acc[2][2][4][2];
#pragma unroll
    for (int a = 0; a < 2; ++a)
#pragma unroll
        for (int b = 0; b < 2; ++b)
#pragma unroll
            for (int m = 0; m < 4; ++m)
#pragma unroll
                for (int n = 0; n < 2; ++n) acc[a][b][m][n] = (f32x4){0.f, 0.f, 0.f, 0.f};
    bf16x8 At[4][2], B0[2][2], B1[2][2];
    const char* cA = cur.a; const char* cB = cur.b;
    PG8_STAGE(PG8_SB(0, 0), cB, voffB); PG8_STAGE(PG8_SB(0, 1), cB + hstepB, voffB); PG8_STAGE(PG8_SA(0, 0), cA, voffA); PG8_STAGE(PG8_SA(0, 1), cA + hstepA, voffA);
    if (wr == 1) PG8_BAR;
    PG8_WAIT_V(2); PG8_BAR;
    PG8_STAGE(PG8_SB(1, 0), cB + kstep, voffB); PG8_STAGE(PG8_SA(1, 0), cA + kstep, voffA); PG8_STAGE(PG8_SB(1, 1), cB + hstepB + kstep, voffB);
    PG8_WAIT_V(6); PG8_BAR;
    for (;;) {
        const bool has_next = S.next(ui + 1, nxt);
        const char* nA = has_next ? nxt.a : cA; const char* nB = has_next ? nxt.b : cB;
        for (int t = 0; t < nt; t += 2) {
            const bool last = (t == nt - 2);
            const char* a1 = cA + (size_t)(t + 1) * kstep;
            const char* a2 = last ? nA : cA + (size_t)(t + 2) * kstep; const char* b2 = last ? nB : cB + (size_t)(t + 2) * kstep;
            const char* a3 = a2 + kstep; const char* b3 = b2 + kstep;
            PG8_LDB(B0, 0, 0); PG8_LDB(B1, 0, 1); PG8_SCHED; PG8_LDA(At, 0, 0); PG8_STAGE(PG8_SA(1, 1), a1 + hstepA, voffA);
            PG8_WAIT_V(8); PG8_WAIT_L(0); PG8_BAR; PG8_MMA(0, 0, At, B0); PG8_MMA(0, 1, At, B1); PG8_BAR; PG8_SCHED;
            PG8_LDA(At, 0, 1); PG8_STAGE(PG8_SB(0, 0), b2, voffB); PG8_STAGE(PG8_SB(0, 1), b2 + hstepB, voffB); PG8_STAGE(PG8_SA(0, 0), a2, voffA);
            PG8_WAIT_V(8); PG8_WAIT_L(0); PG8_BAR; PG8_MMA(1, 0, At, B0); PG8_MMA(1, 1, At, B1); PG8_BAR; PG8_SCHED;
            PG8_LDB(B0, 1, 0); PG8_LDB(B1, 1, 1); PG8_SCHED; PG8_LDA(At, 1, 0); PG8_STAGE(PG8_SA(0, 1), a2 + hstepA, voffA);
            PG8_WAIT_V(8); PG8_WAIT_L(0); PG8_BAR; PG8_MMA(0, 0, At, B0); PG8_MMA(0, 1, At, B1); PG8_BAR; PG8_SCHED;
            PG8_LDA(At, 1, 1); PG8_STAGE(PG8_SB(1, 0), b3, voffB); PG8_STAGE(PG8_SB(1, 1), b3 + hstepB, voffB); PG8_STAGE(PG8_SA(1, 0), a3, voffA);
            PG8_WAIT_V(8); PG8_WAIT_L(0); PG8_BAR; PG8_MMA(1, 0, At, B0); PG8_MMA(1, 1, At, B1); PG8_BAR; PG8_SCHED;
        }
        if constexpr (ALIGN_EPI) { if (wr == 0) PG8_BAR; }
        E(acc, cur, wr, wc, fr, fq);
        if (!has_next) break;
#pragma unroll
        for (int a = 0; a < 2; ++a)
#pragma unroll
            for (int b = 0; b < 2; ++b)
#pragma unroll
                for (int m = 0; m < 4; ++m)
#pragma unroll
                    for (int n = 0; n < 2; ++n) acc[a][b][m][n] = (f32x4){0.f, 0.f, 0.f, 0.f};
        cur = nxt; cA = nA; cB = nB; ++ui;
        if constexpr (ALIGN_EPI) { if (wr == 1) PG8_BAR; }
    }
    PG8_WAIT_V(0);
    if constexpr (!ALIGN_EPI) { if (wr == 0) PG8_BAR; }
    PG8_BAR;
#undef PG8_SA
#undef PG8_SB
#undef PG8_STAGE
#undef PG8_LDA
#undef PG8_LDB
#undef PG8_MMA
#undef PG8_WAIT_V
#undef PG8_WAIT_L
#undef PG8_BAR
#undef PG8_SCHED
}

struct EpiProj {
    static constexpr bool PERM = true;
    bf16_t* P; bf16_t* G; const float* gains  ; const float* rope  ;
    __device__ __forceinline__ void operator()(const f32x4 (&acc)[2][2][4][2], const Unit& u, int wr, int wc, int fr, int fq) const {
        const int t = u.pn, jt = u.pm % RT_PER_B; const bool isctx = (jt == RT_PER_B - 1);
        int mode = 0; const float* gain = gains; float scale = 1.f; bf16_t* outp; int ocol;
        if (t >= 12) { mode = 2; outp = G; ocol = (t - 12) * 256 + wc * 64; }
        else { outp = P; ocol = t * 256 + wc * 64;
            if (t < 6) { mode = 1; gain = gains + (t >> 1) * 64; scale = QSCALE; }
            else if (t == 6) { if (wc < 2) { mode = 1; gain = gains + 3 * 64; } }
            else if (t <= 8) { mode = 1; gain = gains + 4 * 64; }
            else if (t == 11) { if (wc < 2) { mode = 1; gain = gains + 5 * 64; } } }
        const int rin0 = wr * 64 + fr;
        f32x4 g0a = (f32x4){1.f, 1.f, 1.f, 1.f}, g0b = g0a, g1a = g0a, g1b = g0a;
        if (mode == 1) { g0a = *(const f32x4*)(gain + 8 * fq); g0b = *(const f32x4*)(gain + 8 * fq + 4); g1a = *(const f32x4*)(gain + 32 + 8 * fq); g1b = *(const f32x4*)(gain + 36 + 8 * fq); }
#pragma unroll
        for (int ai = 0; ai < 2; ++ai)
#pragma unroll
            for (int m = 0; m < 4; ++m) {
                const int rin = rin0 + ai * HALF + m * 16;
                f32x4 a0 = acc[ai][0][m][0], a1 = acc[ai][0][m][1], b0 = acc[ai][1][m][0], b1 = acc[ai][1][m][1];
                if (mode == 1) {
                    float ss = (a0[0] * a0[0] + a0[1] * a0[1]) + (a0[2] * a0[2] + a0[3] * a0[3]);
                    ss += (a1[0] * a1[0] + a1[1] * a1[1]) + (a1[2] * a1[2] + a1[3] * a1[3]);
                    ss += (b0[0] * b0[0] + b0[1] * b0[1]) + (b0[2] * b0[2] + b0[3] * b0[3]);
                    ss += (b1[0] * b1[0] + b1[1] * b1[1]) + (b1[2] * b1[2] + b1[3] * b1[3]);
                    ss += __shfl_xor(ss, 16); ss += __shfl_xor(ss, 32);
                    const float rs = 1.0f / sqrtf(ss * (1.0f / 64.0f) + 1e-6f);
                    a0 = a0 * rs * g0a; a1 = a1 * rs * g0b; b0 = b0 * rs * g1a; b1 = b1 * rs * g1b;
                    if (!isctx) {
                        const int pos = jt * 256 + rin;
                        const int nidx = (fq < 2) ? (pos >> 6) : (pos & 63);
                        const f32x4* cs = (const f32x4*)(rope + (nidx * 16 + 8 * (fq & 1)) * 2);
                        const f32x4 c01 = cs[0], c23 = cs[1], c45 = cs[2], c67 = cs[3];
#define ROT_(x1, x2, c, s) do { const float n1_ = (x1) * (c) - (x2) * (s), n2_ = (x1) * (s) + (x2) * (c); (x1) = n1_; (x2) = n2_; } while (0)
                        ROT_(a0[0], b0[0], c01[0], c01[1]); ROT_(a0[1], b0[1], c01[2], c01[3]); ROT_(a0[2], b0[2], c23[0], c23[1]); ROT_(a0[3], b0[3], c23[2], c23[3]);
                        ROT_(a1[0], b1[0], c45[0], c45[1]); ROT_(a1[1], b1[1], c45[2], c45[3]); ROT_(a1[2], b1[2], c67[0], c67[1]); ROT_(a1[3], b1[3], c67[2], c67[3]);
#undef ROT_
                    }
                    a0 = a0 * scale; a1 = a1 * scale; b0 = b0 * scale; b1 = b1 * scale;
                } else if (mode == 2) {
#pragma unroll
                    for (int j = 0; j < 4; ++j) { a0[j] = 1.0f / (1.0f + __expf(-a0[j])); a1[j] = 1.0f / (1.0f + __expf(-a1[j])); b0[j] = 1.0f / (1.0f + __expf(-b0[j])); b1[j] = 1.0f / (1.0f + __expf(-b1[j])); }
                }
                bf16_t* rowp = outp + (size_t)(u.pm * 256 + rin) * PW + ocol + 8 * fq;
                u32x4 w0, w1;
                w0.x = cvt_pk_bf16(a0[0], a0[1]); w0.y = cvt_pk_bf16(a0[2], a0[3]); w0.z = cvt_pk_bf16(a1[0], a1[1]); w0.w = cvt_pk_bf16(a1[2], a1[3]);
                w1.x = cvt_pk_bf16(b0[0], b0[1]); w1.y = cvt_pk_bf16(b0[2], b0[3]); w1.z = cvt_pk_bf16(b1[0], b1[1]); w1.w = cvt_pk_bf16(b1[2], b1[3]);
                *(u32x4*)(rowp) = w0; *(u32x4*)(rowp + 32) = w1;
            }
    }
};
struct EpiMerge {
    static constexpr bool PERM = true;
    const bf16_t* G; bf16_t* Mb;
    __device__ __forceinline__ void operator()(const f32x4 (&acc)[2][2][4][2], const Unit& u, int wr, int wc, int fr, int fq) const {
        const int br = u.aux; const int row0 = u.pm * 256 + wr * 64 + fr, col0 = u.pn * 256 + wc * 32 + 8 * fq;
#pragma unroll
        for (int ai = 0; ai < 2; ++ai)
#pragma unroll
            for (int m = 0; m < 4; ++m) { const size_t r = (size_t)(row0 + ai * HALF + m * 16);
#pragma unroll
                for (int bj = 0; bj < 2; ++bj) { const int c = col0 + bj * HALF;
                    const u32x4 gv = *(const u32x4*)(G + r * GW + br * 1024 + c);
                    const f32x4 v0 = acc[ai][bj][m][0], v1 = acc[ai][bj][m][1];
                    float o0 = v0[0] * bf_lo(gv.x), o1 = v0[1] * bf_hi(gv.x), o2 = v0[2] * bf_lo(gv.y), o3 = v0[3] * bf_hi(gv.y);
                    float o4 = v1[0] * bf_lo(gv.z), o5 = v1[1] * bf_hi(gv.z), o6 = v1[2] * bf_lo(gv.w), o7 = v1[3] * bf_hi(gv.w);
                    bf16_t* mp = Mb + r * DM + c;
                    if (br > 0) { const u32x4 mo = *(const u32x4*)mp;
                        o0 += bf_lo(mo.x); o1 += bf_hi(mo.x); o2 += bf_lo(mo.y); o3 += bf_hi(mo.y); o4 += bf_lo(mo.z); o5 += bf_hi(mo.z); o6 += bf_lo(mo.w); o7 += bf_hi(mo.w); }
                    u32x4 w; w.x = cvt_pk_bf16(o0, o1); w.y = cvt_pk_bf16(o2, o3); w.z = cvt_pk_bf16(o4, o5); w.w = cvt_pk_bf16(o6, o7);
                    *(u32x4*)mp = w; } }
    }
};
struct EpiOut {
    static constexpr bool PERM = false;
    const float* srcL; const float* srcC; float* dstL; float* dstC; const float* modl  ;
    __device__ __forceinline__ void operator()(const f32x4 (&acc)[2][2][4][2], const Unit& u, int wr, int wc, int fr, int fq) const {
        const int b = u.pm / RT_PER_B, jt = u.pm % RT_PER_B; const bool isctx = (jt == RT_PER_B - 1);
        const float* gate = modl + (size_t)(isctx ? 8 : b) * 6144 + 2 * 1024;
        const int col0 = u.pn * 256 + wc * 32 + 4 * fq;
        const float* sb = isctx ? srcC + (size_t)b * CTXL * DM : srcL + ((size_t)b * SEQL + jt * 256) * DM;
        float* db = isctx ? dstC + (size_t)b * CTXL * DM : dstL + ((size_t)b * SEQL + jt * 256) * DM;
        f32x4 gv[2][2];
#pragma unroll
        for (int bj = 0; bj < 2; ++bj)
#pragma unroll
            for (int n = 0; n < 2; ++n) gv[bj][n] = *(const f32x4*)(gate + col0 + bj * HALF + n * 16);
#pragma unroll
        for (int ai = 0; ai < 2; ++ai)
#pragma unroll
            for (int m = 0; m < 4; ++m) { const size_t ro = (size_t)(ai * HALF + wr * 64 + m * 16 + fr) * DM + col0;
#pragma unroll
                for (int bj = 0; bj < 2; ++bj)
#pragma unroll
                    for (int n = 0; n < 2; ++n) { const f32x4 x = *(const f32x4*)(sb + ro + bj * HALF + n * 16);
                        *(f32x4*)(db + ro + bj * HALF + n * 16) = x + gv[bj][n] * acc[ai][bj][m][n]; } }
    }
};
struct EpiAct {
    static constexpr bool PERM = true;
    bf16_t* act;
    __device__ __forceinline__ void operator()(const f32x4 (&acc)[2][2][4][2], const Unit& u, int wr, int wc, int fr, int fq) const {
        const int row0 = u.pm * 256 + wr * 64 + fr, col0 = u.pn * 128 + wc * 16 + 4 * fq;
#pragma unroll
        for (int ai = 0; ai < 2; ++ai)
#pragma unroll
            for (int m = 0; m < 4; ++m) { bf16_t* rowp = act + (size_t)(row0 + ai * HALF + m * 16) * EHID + col0;
#pragma unroll
                for (int bj = 0; bj < 2; ++bj) { const f32x4 gt = acc[ai][bj][m][0], up = acc[ai][bj][m][1]; float o[4];
#pragma unroll
                    for (int j = 0; j < 4; ++j) o[j] = gt[j] / (1.0f + __expf(-gt[j])) * up[j];
                    u32x2 w; w.x = cvt_pk_bf16(o[0], o[1]); w.y = cvt_pk_bf16(o[2], o[3]);
                    *(u32x2*)(rowp + bj * 64) = w; } }
    }
};
struct EpiDown {
    static constexpr bool PERM = true;
    bf16_t* yout; const float* wslot;
    __device__ __forceinline__ void operator()(const f32x4 (&acc)[2][2][4][2], const Unit& u, int wr, int wc, int fr, int fq) const {
        const int row0 = u.pm * 256 + wr * 64 + fr, col0 = u.pn * 256 + wc * 32 + 8 * fq;
#pragma unroll
        for (int ai = 0; ai < 2; ++ai)
#pragma unroll
            for (int m = 0; m < 4; ++m) { const size_t r = (size_t)(row0 + ai * HALF + m * 16); const float sc = wslot[r]; bf16_t* rowp = yout + r * DM + col0;
#pragma unroll
                for (int bj = 0; bj < 2; ++bj) { const f32x4 v0 = acc[ai][bj][m][0] * sc, v1 = acc[ai][bj][m][1] * sc;
                    u32x4 w; w.x = cvt_pk_bf16(v0[0], v0[1]); w.y = cvt_pk_bf16(v0[2], v0[3]); w.z = cvt_pk_bf16(v1[0], v1[1]); w.w = cvt_pk_bf16(v1[2], v1[3]);
                    *(u32x4*)(rowp + bj * HALF) = w; } }
    }
};

__device__ __forceinline__ int rowsel_count(int sel) { return sel == 0 ? NRT : (sel == 1 ? NB * 16 : NB); }
__device__ __forceinline__ int rowsel_map(int sel, int q) { return sel == 0 ? q : (sel == 1 ? q + (q >> 4) : q * RT_PER_B + (RT_PER_B - 1)); }
struct SchedGrid2 {
    int G, c;
    int sel0, nN0, pn00, cnt0;
    int sel1, nN1, pn01, cnt1;
    const char* A; const char* B; size_t astep, bstep;
    __device__ __forceinline__ void init(int G_, int c_, const void* A_, int lda, const void* B_, int ldb, int s0, int n0, int p0, int s1, int n1, int p1) {
        G = G_; c = c_; A = (const char*)A_; B = (const char*)B_; astep = (size_t)256 * lda * 2; bstep = (size_t)256 * ldb * 2;
        sel0 = s0; nN0 = n0; pn00 = p0; cnt0 = rowsel_count(s0) * n0; sel1 = s1; nN1 = n1; pn01 = p1; cnt1 = n1 ? rowsel_count(s1) * n1 : 0; }
    __device__ __forceinline__ bool next(int i, Unit& u) const {
        long L = (long)i * G + c; int pm, pn;
        if (L < cnt0) { tile_order((int)L, rowsel_count(sel0), nN0, pm, pn); pm = rowsel_map(sel0, pm); pn += pn00; }
        else { L -= cnt0; if (L >= cnt1) return false; tile_order((int)L, rowsel_count(sel1), nN1, pm, pn); pm = rowsel_map(sel1, pm); pn += pn01; }
        u.pm = pm; u.pn = pn; u.aux = 0; u.a = A + (size_t)pm * astep; u.b = B + (size_t)pn * bstep; return true; }
};
struct SchedMerge {
    int G, c, sel, ntile; const char* Y; const char* W;
    __device__ __forceinline__ void init(int G_, int c_, const void* Y_, const void* W_, int sel_) { G = G_; c = c_; Y = (const char*)Y_; W = (const char*)W_; sel = sel_; ntile = rowsel_count(sel_) * 4; }
    __device__ __forceinline__ bool next(int i, Unit& u) const {
        const int br = i % 3; const long L = (long)(i / 3) * G + c; if (L >= ntile) return false;
        int pm, pn; tile_order((int)L, rowsel_count(sel), 4, pm, pn); pm = rowsel_map(sel, pm);
        u.pm = pm; u.pn = pn; u.aux = br;
        u.a = Y + ((size_t)pm * 256 * YW + br * 512) * 2; u.b = W + ((size_t)br * 1024 * 512 + (size_t)pn * 256 * 512) * 2; return true; }
};
struct SchedMoe {
    int G, c, nrt; const int* rte; const char* A; const char* W; size_t astep, wexp, wstep;
    __device__ __forceinline__ void init(int G_, int c_, const int* tab, const void* A_, int lda, const void* W_, int K) {
        G = G_; c = c_; rte = tab + 1; nrt = __builtin_amdgcn_readfirstlane(__hip_atomic_load(tab, __ATOMIC_RELAXED, __HIP_MEMORY_SCOPE_AGENT));
        A = (const char*)A_; W = (const char*)W_; astep = (size_t)256 * lda * 2; wexp = (size_t)1024 * K * 2; wstep = (size_t)256 * K * 2; }
    __device__ __forceinline__ bool next(int i, Unit& u) const {
        const long L = (long)i * G + c; const int rt = (int)(L >> 2), pn = (int)(L & 3); if (rt >= nrt) return false;
        const int e = __builtin_amdgcn_readfirstlane(__hip_atomic_load(rte + rt, __ATOMIC_RELAXED, __HIP_MEMORY_SCOPE_AGENT));
        u.pm = rt; u.pn = pn; u.aux = e; u.a = A + (size_t)rt * astep; u.b = W + (size_t)e * wexp + (size_t)pn * wstep; return true; }
};
}
namespace attn_body {
using bf16=__hip_bfloat16;
using bf16x8=__attribute__((ext_vector_type(8)))short;
using s16x4=__attribute__((ext_vector_type(4)))short;
using f32x16=__attribute__((ext_vector_type(16)))float;
using u32x4=__attribute__((ext_vector_type(4)))unsigned;
constexpr int D=64,DMP=PW;
constexpr int NW=8,QBLK=32,KVBLK=64;
__device__ __forceinline__ int crow(int r,int hi){return (r&3)+8*(r>>2)+4*hi;}
#define SBAR() __builtin_amdgcn_sched_barrier(0)
constexpr int NSLOT=3, SLOTB=8192;
constexpr int LDS_K=0, LDS_V=NSLOT*SLOTB, LDS_WS=2*NSLOT*SLOTB, LDS_OST=LDS_WS+NW*64*4, LDS_BYTES=LDS_OST+NW*4096;
__device__ __forceinline__ void glds16(const void*gsrc,unsigned lds_dst){unsigned keep;
  asm volatile("s_mov_b32 %0, m0\n\ts_mov_b32 m0, %2\n\ts_nop 0\n\tglobal_load_lds_dwordx4 %1, off\n\ts_mov_b32 m0, %0":"=&s"(keep):"v"(gsrc),"s"(lds_dst):"memory");}
__device__ __forceinline__ float max3f(float a,float b,float c){float r;asm("v_max3_f32 %0, %1, %2, %3":"=v"(r):"v"(a),"v"(b),"v"(c));return r;}
__device__ __forceinline__ float max2f(float a,float b){float r;asm("v_max_f32_e32 %0, %1, %2":"=v"(r):"v"(a),"v"(b));return r;}
__device__ __forceinline__ float fadd_s(float a,float b){float r;asm("v_add_f32_e32 %0, %1, %2":"=v"(r):"v"(a),"v"(b));return r;}
__device__ __forceinline__ float fsub_s(float a,float b){float r;asm("v_sub_f32_e32 %0, %1, %2":"=v"(r):"v"(a),"v"(b));return r;}
typedef float f32x2_t __attribute__((ext_vector_type(2))); typedef __bf16 bf16x2_t __attribute__((ext_vector_type(2)));
__device__ __forceinline__ unsigned cvtpk_s(float lo,float hi){f32x2_t v={lo,hi};bf16x2_t b=__builtin_convertvector(v,bf16x2_t);return __builtin_bit_cast(unsigned,b);}
#define WAIT_BAR(N) asm volatile("s_waitcnt vmcnt(" #N ") lgkmcnt(0)\n\ts_barrier":::"memory")

__device__ __forceinline__ void qkt(f32x16&p0,f32x16&p1,const char*Kslot,const bf16x8*qr,const f32x16&negm,int r32,int hi){
  const char*kb=Kslot+hi*1024+r32*16;
  #pragma unroll
  for(int d0=0;d0<4;++d0){
    const bf16x8 b0=*reinterpret_cast<const bf16x8*>(kb+d0*2048);
    const bf16x8 b1=*reinterpret_cast<const bf16x8*>(kb+d0*2048+512);
    if(d0==0){p0=__builtin_amdgcn_mfma_f32_32x32x16_bf16(b0,qr[0],negm,0,0,0);p1=__builtin_amdgcn_mfma_f32_32x32x16_bf16(b1,qr[0],negm,0,0,0);}
    else{p0=__builtin_amdgcn_mfma_f32_32x32x16_bf16(b0,qr[d0],p0,0,0,0);p1=__builtin_amdgcn_mfma_f32_32x32x16_bf16(b1,qr[d0],p1,0,0,0);}}
}
typedef __attribute__((address_space(3))) const char* lds_cptr;
typedef short v4i16_t __attribute__((ext_vector_type(4)));
__device__ __forceinline__ void kload8(bf16x8*kf,lds_cptr kp){
  kf[0]=*(const __attribute__((address_space(3))) bf16x8*)(kp);      kf[1]=*(const __attribute__((address_space(3))) bf16x8*)(kp+512);
  kf[2]=*(const __attribute__((address_space(3))) bf16x8*)(kp+2048); kf[3]=*(const __attribute__((address_space(3))) bf16x8*)(kp+2560);
  kf[4]=*(const __attribute__((address_space(3))) bf16x8*)(kp+4096); kf[5]=*(const __attribute__((address_space(3))) bf16x8*)(kp+4608);
  kf[6]=*(const __attribute__((address_space(3))) bf16x8*)(kp+6144); kf[7]=*(const __attribute__((address_space(3))) bf16x8*)(kp+6656);
}
__device__ __forceinline__ void kload2(bf16x8*kf,lds_cptr kp,int j){ kf[2*j]=*(const __attribute__((address_space(3))) bf16x8*)(kp+j*2048); kf[2*j+1]=*(const __attribute__((address_space(3))) bf16x8*)(kp+j*2048+512); }
__device__ __forceinline__ s16x4 vtr(lds_cptr p){ return __builtin_bit_cast(s16x4,__builtin_amdgcn_ds_read_tr16_b64_v4i16((__attribute__((address_space(3))) v4i16_t*)p)); }
__device__ __forceinline__ float rowmax(const f32x16&p0,const f32x16&p1){
  float a=max3f(p0[0],p0[1],p1[0]),b=max3f(p0[2],p0[3],p1[1]);a=max3f(a,p1[2],p1[3]);
  #pragma unroll
  for(int r=4;r<16;r+=4){a=max3f(a,p0[r],p0[r+1]);b=max3f(b,p0[r+2],p0[r+3]);a=max3f(a,p1[r],p1[r+1]);b=max3f(b,p1[r+2],p1[r+3]);}
  const float m=max2f(a,b);
  auto rr=__builtin_amdgcn_permlane32_swap(__float_as_uint(m),__float_as_uint(m),false,false);
  return max2f(__uint_as_float(rr[0]),__uint_as_float(rr[1]));
}
__device__ __forceinline__ void pv(f32x16*o,int vb,bf16x8 pa0,bf16x8 pa1,bf16x8 pa2,bf16x8 pa3){
  #pragma unroll
  for(int d0=0;d0<2;++d0){s16x4 lo[4],hi[4];
    #pragma unroll
    for(int ks=0;ks<4;++ks){
      asm volatile("ds_read_b64_tr_b16 %0,%1 offset:%c2":"=&v"(lo[ks]):"v"(vb),"i"(d0*4096+ks*1024):"memory");
      asm volatile("ds_read_b64_tr_b16 %0,%1 offset:%c2":"=&v"(hi[ks]):"v"(vb),"i"(d0*4096+ks*1024+512):"memory");}
    asm volatile("s_waitcnt lgkmcnt(0)":::"memory");SBAR();
    #define PK(k) (bf16x8){lo[k][0],lo[k][1],lo[k][2],lo[k][3],hi[k][0],hi[k][1],hi[k][2],hi[k][3]}
    o[d0]=__builtin_amdgcn_mfma_f32_32x32x16_bf16(pa0,PK(0),o[d0],0,0,0);
    o[d0]=__builtin_amdgcn_mfma_f32_32x32x16_bf16(pa1,PK(1),o[d0],0,0,0);
    o[d0]=__builtin_amdgcn_mfma_f32_32x32x16_bf16(pa2,PK(2),o[d0],0,0,0);
    o[d0]=__builtin_amdgcn_mfma_f32_32x32x16_bf16(pa3,PK(3),o[d0],0,0,0);
    #undef PK
  }
}
struct AttnU { const bf16* q; const bf16* k; const bf16* v; bf16* o; const float* sinkp; int opitch, rmask, rshift, NT, kbase, jq; };
__device__ __forceinline__ int win_tile(int t,int jq,int&lo,int&hi){
  int jt; lo=-1000; hi=1000;
  if(t==0) jt=jq;
  else if(t==1){ jt=jq-1; if(jt<0){jt=jq;lo=1000;hi=-1000;} }
  else if(t==2){ jt=jq+1; if(jt>63){jt=jq;lo=1000;hi=-1000;} }
  else if(t==3){ jt=jq-2; lo=0; if(jt<0){jt=jq;lo=1000;hi=-1000;} }
  else if(t==4){ jt=jq+2; hi=0; if(jt>63){jt=jq;lo=1000;hi=-1000;} }
  else if(t<9) jt=64+(t-5);
  else { jt=67; lo=1000; hi=-1000; }
  return jt*64;
}
__device__ __forceinline__ void wmask(f32x16&p0,f32x16&p1,int lo,int hi_,int dq){
  const float NEG=-INFINITY;
  #pragma unroll
  for(int r=0;r<16;++r){const int d=(r&3)+8*(r>>2)+dq; if(d<lo||d>hi_)p0[r]=NEG; if(d+32<lo||d+32>hi_)p1[r]=NEG;}
}
template<bool WIN> __device__ __forceinline__ int krow_of(int t,int kbase,int jq){ if constexpr(WIN){int lo_,hi_;return win_tile(t,jq,lo_,hi_);} else return kbase+t*KVBLK; }
template<bool WIN,int THRL> __device__ __forceinline__ void attn_unit(const AttnU&U,char*shm){
  int tid_=threadIdx.x; asm volatile("":"+v"(tid_));
  const int tid=tid_,lane=tid&63,r32=lane&31,hi=lane>>5; const int wid=__builtin_amdgcn_readfirstlane(tid>>6);
  const int wrow=(wid&U.rmask)*QBLK, wcol=(wid>>U.rshift)*D;
  const bf16*Qw=U.q+(long)wrow*DMP+wcol;
  const bf16*Kh=U.k,*Vh=U.v;
  const unsigned lds0=(unsigned)(uintptr_t)shm;
  float*wsf=(float*)(shm+LDS_WS)+wid*64;
  const bf16*ksrc=Kh+(long)lane*DMP+wid*8;
  const bf16*vsrc=Vh+(long)(16*(wid&3)+(lane>>2))*DMP+(wid>>2)*32+(lane&3)*8;
  const unsigned kdst=lds0+LDS_K+wid*1024, vdst=lds0+LDS_V+wid*1024;
  const int NT=U.NT, kbase=U.kbase, jq=U.jq;
  #define KROW(t) krow_of<WIN>((t),kbase,jq)
  #define DMA_K(t,slot) glds16(ksrc+(long)KROW(t)*DMP,(unsigned)__builtin_amdgcn_readfirstlane(kdst+(slot)))
  #define DMA_V(t,slot) glds16(vsrc+(long)KROW(t)*DMP,(unsigned)__builtin_amdgcn_readfirstlane(vdst+(slot)))
  const int vb0=(int)(lds0+LDS_V)+((lane>>4)&1)*32+(lane&3)*8+(4*hi+((lane&15)>>2))*64;
  const char*Kbase=shm+LDS_K; bf16x8 kf[8];
  const lds_cptr shm3=(lds_cptr)shm; const lds_cptr kp0=shm3+LDS_K+hi*1024+r32*16; const lds_cptr vp0=shm3+LDS_V+((lane>>4)&1)*32+(lane&3)*8+(4*hi+((lane&15)>>2))*64;
  DMA_K(0,0);DMA_V(0,0);DMA_K(1,SLOTB);
  bf16x8 qr[4];
  #pragma unroll
  for(int d0=0;d0<4;++d0)qr[d0]=*reinterpret_cast<const bf16x8*>(&Qw[(long)r32*DMP+d0*16+hi*8]);
  float mhat=0.f,l_reg=0.f;f32x16 o[2];o[0]=f32x16{};o[1]=f32x16{};f32x16 negm=f32x16{};asm volatile("":"+v"(negm));
  const int dq=4*hi-((wid&1)*QBLK+r32);
  #define CMASK(P0,P1,t) do{ if constexpr(WIN){ int lo_,hi_; (void)win_tile((t),jq,lo_,hi_); if(lo_>-64||hi_<64) wmask(P0,P1,lo_,hi_,dq); } }while(0)
  bool resc=false;
  #define START(P0,P1) do{ const float rm=rowmax(P0,P1); resc=false; \
    { const float dl=rm; mhat=fadd_s(mhat,dl); \
      _Pragma("unroll") for(int r=0;r<16;++r){P0[r]=fsub_s(P0[r],dl);P1[r]=fsub_s(P1[r],dl);} \
      _Pragma("unroll") for(int r=0;r<16;++r)negm[r]=-mhat; asm volatile("":"+v"(negm)); } \
    _Pragma("unroll") for(int r=0;r<16;++r)P0[r]=__builtin_amdgcn_exp2f(P0[r]); }while(0)
  #define RESC() do{ if(resc){ asm volatile("s_waitcnt lgkmcnt(0)":::"memory"); \
      _Pragma("unroll") for(int d_=0;d_<2;++d_) _Pragma("unroll") for(int r=0;r<16;++r)o[d_][r]*=wsf[crow(r,hi)]; } }while(0)
  f32x16 pA0,pA1,pB0,pB1;
  int sl_prev=0,sl_cur=0,sl_next=SLOTB;
  #define ROT() do{sl_prev=sl_cur;sl_cur=sl_next;sl_next=(sl_next==(NSLOT-1)*SLOTB)?0:sl_next+SLOTB;}while(0)
  DMA_K(2,2*SLOTB);
  WAIT_BAR(3);
  qkt(pA0,pA1,Kbase,qr,negm,r32,hi);asm volatile("s_nop 15\n\ts_nop 7":"+v"(pA0),"+v"(pA1));
  START(pA0,pA1);
  _Pragma("unroll") for(int r=0;r<16;++r)pA1[r]=__builtin_amdgcn_exp2f(pA1[r]);
  WAIT_BAR(0);
  DMA_K(3,0);DMA_V(1,SLOTB);
  ROT();
  kload8(kf,kp0+sl_cur);
  WAIT_BAR(2);
  s16x4 vlo[8],vhi[8]; u32x4 pw0,pw1,pw2,pw3;
  #define PKW(P,B) cvtpk_s(P[B],P[B+1])
  #define PAF(k) __builtin_bit_cast(bf16x8,pw##k)
  #define VFR(i) (bf16x8){vlo[i][0],vlo[i][1],vlo[i][2],vlo[i][3],vhi[i][0],vhi[i][1],vhi[i][2],vhi[i][3]}
  #define PIN(x) asm volatile("":"+v"(x))
  #define MX3(a,b,c) __builtin_fmaxf(__builtin_fmaxf((a),(b)),(c))
  #define GAPA(MF,A0,A1,A2,A3,W0,W1,PW_) do{ MF; sacc+=A0; sacc+=A1; sacc+=A2; sacc+=A3; PIN(sacc); W0; W1; PIN(PW_); SBAR(); }while(0)
  #define EX(v) __builtin_amdgcn_exp2f(v)
  #define GAPB(MF,X,B) do{ MF; X[B]=EX(X[B]); X[B+1]=EX(X[B+1]); X[B+2]=EX(X[B+2]); X[B+3]=EX(X[B+3]); PIN(X); SBAR(); }while(0)
  #define VRD(i) do{ vlo[i]=vtr(vp_+(((i)>>2)*4096+((i)&3)*1024)); vhi[i]=vtr(vp_+(((i)>>2)*4096+((i)&3)*1024+512)); }while(0)
  #define KRD(G_,j) do{ if(G_){ kload2(kf,kp0+sl_next,j); SBAR(); } }while(0)
  #define STEP(C0,C1,P0,P1,t,GK,GV,GL,DOMASK) do{ SBAR(); \
    const lds_cptr vp_=vp0+sl_prev; \
    VRD(0); SBAR(); float sacc=(P0[0]+P0[1]); \
    GAPA(C0=__builtin_amdgcn_mfma_f32_32x32x16_bf16(kf[0],qr[0],negm,0,0,0), P0[2],P0[3],P0[4],P0[5],     pw0[0]=PKW(P0,0), pw0[1]=PKW(P0,2), pw0); \
    VRD(4); SBAR(); GAPA(C1=__builtin_amdgcn_mfma_f32_32x32x16_bf16(kf[1],qr[0],negm,0,0,0), P0[6],P0[7],P0[8],P0[9],     pw0[2]=PKW(P0,4), pw0[3]=PKW(P0,6), pw0); \
    VRD(1); SBAR(); GAPA(C0=__builtin_amdgcn_mfma_f32_32x32x16_bf16(kf[2],qr[1],C0,0,0,0),   P0[10],P0[11],P0[12],P0[13], pw1[0]=PKW(P0,8), pw1[1]=PKW(P0,10), pw1); \
    VRD(5); SBAR(); GAPA(C1=__builtin_amdgcn_mfma_f32_32x32x16_bf16(kf[3],qr[1],C1,0,0,0),   P0[14],P0[15],P1[0],P1[1],   pw1[2]=PKW(P0,12),pw1[3]=PKW(P0,14), pw1); \
    VRD(2); SBAR(); GAPA(C0=__builtin_amdgcn_mfma_f32_32x32x16_bf16(kf[4],qr[2],C0,0,0,0),   P1[2],P1[3],P1[4],P1[5],     pw2[0]=PKW(P1,0), pw2[1]=PKW(P1,2), pw2); \
    VRD(6); SBAR(); GAPA(C1=__builtin_amdgcn_mfma_f32_32x32x16_bf16(kf[5],qr[2],C1,0,0,0),   P1[6],P1[7],P1[8],P1[9],     pw2[2]=PKW(P1,4), pw2[3]=PKW(P1,6), pw2); \
    VRD(3); SBAR(); GAPA(C0=__builtin_amdgcn_mfma_f32_32x32x16_bf16(kf[6],qr[3],C0,0,0,0),   P1[10],P1[11],P1[12],P1[13], pw3[0]=PKW(P1,8), pw3[1]=PKW(P1,10), pw3); \
    VRD(7); SBAR(); GAPA(C1=__builtin_amdgcn_mfma_f32_32x32x16_bf16(kf[7],qr[3],C1,0,0,0),   P1[14],P1[15],0.f,0.f,       pw3[2]=PKW(P1,12),pw3[3]=PKW(P1,14), pw3); \
    l_reg+=sacc; \
    if(GK){DMA_K((t)+3,sl_cur);} if(GV){DMA_V((t)+1,sl_next);} \
    if(DOMASK){ CMASK(C0,C1,t); } \
    { float a=MX3(C0[0],C0[1],C1[0]),b=MX3(C0[2],C0[3],C1[1]); a=MX3(a,C1[2],C1[3]); \
      _Pragma("unroll") for(int r=4;r<16;r+=4){a=MX3(a,C0[r],C0[r+1]);b=MX3(b,C0[r+2],C0[r+3]);a=MX3(a,C1[r],C1[r+1]);b=MX3(b,C1[r+2],C1[r+3]);} \
      float rm=__builtin_fmaxf(a,b); { auto rr=__builtin_amdgcn_permlane32_swap(__float_as_uint(rm),__float_as_uint(rm),false,false); rm=__builtin_fmaxf(__uint_as_float(rr[0]),__uint_as_float(rr[1])); } \
      resc=false; \
      if(__builtin_expect(__any(rm>(float)THRL),0)){ const float dl=__builtin_fmaxf(rm,0.f); mhat+=dl; \
        _Pragma("unroll") for(int r=0;r<16;++r){C0[r]-=dl;C1[r]-=dl;} \
        _Pragma("unroll") for(int r=0;r<16;++r)negm[r]=-mhat; asm volatile("":"+v"(negm)); \
        const float f=__builtin_amdgcn_exp2f(-dl); l_reg*=f; if(hi==0)wsf[r32]=f; resc=true; } } \
    SBAR(); \
    GAPB(o[0]=__builtin_amdgcn_mfma_f32_32x32x16_bf16(PAF(0),VFR(0),o[0],0,0,0), C0,0); \
    GAPB(o[1]=__builtin_amdgcn_mfma_f32_32x32x16_bf16(PAF(0),VFR(4),o[1],0,0,0), C0,4); \
    KRD(GL,0); GAPB(o[0]=__builtin_amdgcn_mfma_f32_32x32x16_bf16(PAF(1),VFR(1),o[0],0,0,0), C0,8); \
    KRD(GL,1); GAPB(o[1]=__builtin_amdgcn_mfma_f32_32x32x16_bf16(PAF(1),VFR(5),o[1],0,0,0), C0,12); \
    KRD(GL,2); GAPB(o[0]=__builtin_amdgcn_mfma_f32_32x32x16_bf16(PAF(2),VFR(2),o[0],0,0,0), C1,0); \
    KRD(GL,3); GAPB(o[1]=__builtin_amdgcn_mfma_f32_32x32x16_bf16(PAF(2),VFR(6),o[1],0,0,0), C1,4); \
    GAPB(o[0]=__builtin_amdgcn_mfma_f32_32x32x16_bf16(PAF(3),VFR(3),o[0],0,0,0), C1,8); \
    GAPB(o[1]=__builtin_amdgcn_mfma_f32_32x32x16_bf16(PAF(3),VFR(7),o[1],0,0,0), C1,12); \
    }while(0)
  int t=1;
  if constexpr(!WIN){
    for(;t+5<NT;t+=2){
      STEP(pB0,pB1,pA0,pA1,t,true,true,true,false);     WAIT_BAR(2); RESC(); ROT();
      STEP(pA0,pA1,pB0,pB1,t+1,true,true,true,false);   WAIT_BAR(2); RESC(); ROT();
    }
  }
  #define ENDW(tt) do{ if((tt)+3<NT){WAIT_BAR(2);} else if((tt)+2<NT){WAIT_BAR(1);} else {WAIT_BAR(0);} }while(0)
  for(;t+1<NT;t+=2){
    STEP(pB0,pB1,pA0,pA1,t,(t+3<NT),(t+1<NT),(t+1<NT),true);       ENDW(t);   RESC(); ROT();
    STEP(pA0,pA1,pB0,pB1,t+1,(t+4<NT),(t+2<NT),(t+2<NT),true);     ENDW(t+1); RESC(); ROT();
  }
  STEP(pB0,pB1,pA0,pA1,NT-1,false,false,false,true); RESC();
  { float sacc=pB0[0]+pB0[1]; _Pragma("unroll") for(int r=2;r<16;++r)sacc+=pB0[r]; _Pragma("unroll") for(int r=0;r<16;++r)sacc+=pB1[r]; l_reg+=sacc;
    pw0=(u32x4){PKW(pB0,0),PKW(pB0,2),PKW(pB0,4),PKW(pB0,6)};pw1=(u32x4){PKW(pB0,8),PKW(pB0,10),PKW(pB0,12),PKW(pB0,14)};pw2=(u32x4){PKW(pB1,0),PKW(pB1,2),PKW(pB1,4),PKW(pB1,6)};pw3=(u32x4){PKW(pB1,8),PKW(pB1,10),PKW(pB1,12),PKW(pB1,14)};
    SBAR(); pv(o,vb0+sl_cur,PAF(0),PAF(1),PAF(2),PAF(3)); }
  #undef PKW
  #undef PAF
  #undef VFR
  #undef PIN
  #undef MX3
  #undef GAPA
  #undef GAPB
  #undef EX
  #undef VRD
  #undef KRD
  #undef STEP
  #undef ENDW
  {auto rr=__builtin_amdgcn_permlane32_swap(__float_as_uint(l_reg),__float_as_uint(l_reg),false,false);l_reg=__uint_as_float(rr[0])+__uint_as_float(rr[1]);}
  if(U.sinkp){ const float sk=U.sinkp[wid>>U.rshift]; l_reg+=__builtin_amdgcn_exp2f(sk*LOG2E-mhat); }
  if(hi==0)wsf[32+r32]=l_reg;asm volatile("s_waitcnt lgkmcnt(0)":::"memory");
  float rli[16];
  #pragma unroll
  for(int r=0;r<16;++r)rli[r]=__builtin_amdgcn_rcpf(wsf[32+crow(r,hi)]);
  bf16*Ow=U.o+(long)wrow*U.opitch+wcol;
  { bf16*stg=(bf16*)(shm+LDS_OST)+wid*2048;
    #pragma unroll
    for(int r=0;r<16;++r){const int orow=crow(r,hi);
      #pragma unroll
      for(int d0=0;d0<2;++d0)stg[orow*64+d0*32+r32]=__float2bfloat16(o[d0][r]*rli[r]);}
    asm volatile("s_waitcnt lgkmcnt(0)":::"memory");
    #pragma unroll
    for(int i=0;i<4;++i){const int row=i*8+(lane>>3),ch=lane&7; const u32x4 v=*(const u32x4*)(stg+row*64+ch*8); *(u32x4*)(Ow+(long)row*U.opitch+ch*8)=v;} }
  asm volatile("s_waitcnt lgkmcnt(0)\n\ts_barrier":::"memory");
  #undef KROW
  #undef DMA_K
  #undef DMA_V
  #undef CMASK
  #undef START
  #undef RESC
  #undef ROT
}
constexpr int ATTN_LDS_BYTES=LDS_BYTES;
#undef SBAR
#undef WAIT_BAR
}
constexpr int RING_OFF = 0, RING_BYTES = 131072;
constexpr int LDSCTL_OFF = RING_BYTES, MISC_OFF = LDSCTL_OFF + 320;
constexpr int LDS_BYTES = 147456;
static_assert(MISC_OFF + 128 <= LDS_BYTES, "LDS map");
static_assert(attn_body::ATTN_LDS_BYTES <= RING_BYTES, "attention scratch fits the ring region");
constexpr int NWAVES = 8;

#define GAS __attribute__((address_space(1)))
#define LAS __attribute__((address_space(3)))
typedef unsigned short bf16;
typedef unsigned v4u __attribute__((ext_vector_type(4)));
typedef unsigned v2u __attribute__((ext_vector_type(2)));
typedef float f32x4 __attribute__((ext_vector_type(4)));
typedef GAS unsigned gu32;
#define RLX_AGENT __ATOMIC_RELAXED, __HIP_MEMORY_SCOPE_AGENT
#define LDS_WAIT() asm volatile("s_waitcnt lgkmcnt(0)" ::: "memory")
#define VM_WAIT() asm volatile("s_waitcnt vmcnt(0)" ::: "memory")
__device__ __forceinline__ unsigned f2bf(float f) { unsigned u = __builtin_bit_cast(unsigned, f); return (u + 0x7fffu + ((u >> 16) & 1u)) >> 16; }
__device__ __forceinline__ unsigned pk2(float lo, float hi) { return f2bf(lo) | (f2bf(hi) << 16); }
__device__ __forceinline__ float bflo(unsigned u) { return __uint_as_float(u << 16); }
__device__ __forceinline__ float bfhi(unsigned u) { return __uint_as_float(u & 0xffff0000u); }

#define XB_TMO      128
#define XB_XCNT(j)  (256  + 64 * (j))
#define XB_XSUB(j)  (1280 + 64 * (j))
#define XB_XGEN(j)  (2304 + 64 * (j))
#define XB_TOP      3328
#define XB_TOPGEN   3392
#define XCD_BAR_WORDS 3456
#define XB_SPIN_CAP (1u << 18)
__device__ __forceinline__ unsigned xb_ld(unsigned* p)              { return __hip_atomic_load(p, __ATOMIC_RELAXED, __HIP_MEMORY_SCOPE_AGENT); }
__device__ __forceinline__ unsigned xb_add(unsigned* p, unsigned v) { return __hip_atomic_fetch_add(p, v, __ATOMIC_RELAXED, __HIP_MEMORY_SCOPE_AGENT); }
__device__ __forceinline__ unsigned xb_xcc_id() { return (unsigned)__builtin_amdgcn_s_getreg((3 << 11) | 20) & 0xFu; }
#define XB_SPIN(cond, bar) do { unsigned _sp = 0; while (cond) { __builtin_amdgcn_s_sleep(1); \
    if ((++_sp & 255u) == 0u) { if (xb_ld(&(bar)[XB_TMO])) break; if (_sp > XB_SPIN_CAP) { atomicAdd(&(bar)[XB_TMO], 1u); break; } } } } while (0)
struct XcdBarrier { unsigned* bar; unsigned x; volatile LAS unsigned* st; };
__device__ __forceinline__ XcdBarrier xcd_barrier_post(unsigned* bar, volatile LAS unsigned* st) {
    XcdBarrier b; b.bar = bar; b.x = xb_xcc_id(); b.st = st;
    if (threadIdx.x == 0) (void)xb_add(&bar[XB_XCNT(b.x)], 1u);
    return b;
}
__device__ __forceinline__ void xcd_barrier_complete(unsigned* bar, unsigned x, unsigned& nloc, unsigned& nx) {
    const unsigned G = gridDim.x * gridDim.y * gridDim.z;
    unsigned sum, cnt, mine, sp = 0u;
    for (;;) {
        sum = 0u; cnt = 0u; mine = 0u;
#pragma unroll
        for (unsigned j = 0; j < 16; ++j) { const unsigned c = xb_ld(&bar[XB_XCNT(j)]); sum += c; cnt += (c > 0u) ? 1u : 0u; mine = (j == x) ? c : mine; }
        if (sum == G) break;
        __builtin_amdgcn_s_sleep(1);
        if ((++sp & 255u) == 0u) { if (xb_ld(&bar[XB_TMO])) break; if (sp > XB_SPIN_CAP) { atomicAdd(&bar[XB_TMO], 1u); break; } }
    }
    nloc = mine > 0u ? mine : 1u; nx = cnt > 0u ? cnt : 1u;
}
__device__ __forceinline__ void xcd_barrier(const XcdBarrier& b) {
    asm volatile("s_waitcnt vmcnt(0)" ::: "memory");
    __syncthreads();
    if (threadIdx.x == 0) {
        unsigned* bar = b.bar;
        __builtin_amdgcn_s_waitcnt(0);
        unsigned nloc = b.st[0], nx = b.st[1];
        if (nloc == 0u) { xcd_barrier_complete(bar, b.x, nloc, nx); b.st[0] = nloc; b.st[1] = nx; }
        const unsigned old = xb_add(&bar[XB_XSUB(b.x)], 1u);
        const unsigned gen = old / nloc;
        if (old + 1u == (gen + 1u) * nloc) {
            __builtin_amdgcn_fence(__ATOMIC_RELEASE, "agent");
            asm volatile("s_waitcnt vmcnt(0)" ::: "memory");
            const unsigned og = xb_add(&bar[XB_TOP], 1u);
            const unsigned tg = og / nx;
            if (og + 1u == (tg + 1u) * nx) xb_add(&bar[XB_TOPGEN], 1u);
            else XB_SPIN(xb_ld(&bar[XB_TOPGEN]) == tg, bar);
            __builtin_amdgcn_fence(__ATOMIC_ACQUIRE, "agent");
            xb_add(&bar[XB_XGEN(b.x)], 1u);
            asm volatile("s_waitcnt vmcnt(0)" ::: "memory");
        } else {
            XB_SPIN(xb_ld(&bar[XB_XGEN(b.x)]) == gen, bar);
            __builtin_amdgcn_fence(__ATOMIC_ACQUIRE, "agent");
            asm volatile("s_waitcnt vmcnt(0)" ::: "memory");
        }
    }
    __syncthreads();
}

struct Args { const float* in[28]; float* out; unsigned char* ws; int ph_lo, ph_hi; };
enum { I_X = 0, I_C, I_CTX, I_CCTX, I_WADA, I_BADA, I_WIN, I_AQN, I_AKN, I_BQN, I_BKN, I_CQN, I_CKN, I_LQ1, I_LK1, I_LQ2, I_LK2, I_SUBLN, I_SINK, I_WBA, I_WBB, I_WBC, I_WOUT, I_WRG, I_WRE, I_WEG, I_WEU, I_WED };
struct Frame { LAS unsigned char* lds; int tid, lane, wave, G, bid; };

__device__ __forceinline__ Frame local_frame(const Frame& F0) { Frame F = F0; int t = F0.tid; asm volatile("" : "+v"(t)); F.tid = t; F.lane = t & 63; return F; }
__device__ __forceinline__ float wave_sum(float v) {
#pragma unroll
    for (int o = 1; o < 64; o <<= 1) v += __shfl_xor(v, o);
    return v;
}
__device__ __forceinline__ const float* xrow_c(const float* lat, const float* ctx, int r) { const int b = r / TOKB, i = r - b * TOKB; return i < SEQL ? lat + ((size_t)b * SEQL + i) * DM : ctx + ((size_t)b * CTXL + (i - SEQL)) * DM; }
__device__ __forceinline__ float* xrow_m(float* lat, float* ctx, int r) { const int b = r / TOKB, i = r - b * TOKB; return i < SEQL ? lat + ((size_t)b * SEQL + i) * DM : ctx + ((size_t)b * CTXL + (i - SEQL)) * DM; }
__device__ __forceinline__ int modsel(int r) { const int b = r / TOKB, i = r - b * TOKB; return i < SEQL ? b : 8; }
__device__ __forceinline__ int latrow(int q) { return (q >> 12) * TOKB + (q & 4095); }

__device__ __forceinline__ void ph_prologue(const Frame& F0, const Args& a, float* mod, float* rope) {
    const Frame F = local_frame(F0);
    LAS float* sc = (LAS float*)(F.lds + RING_OFF); LAS float* red = (LAS float*)(F.lds + RING_OFF + 40960);
    if (F.bid < 192) {
        const int l = F.bid / 96, j0 = (F.bid % 96) * 64;
        for (int idx = F.tid; idx < 9 * 1024; idx += NWAVES * 64) { const int s = idx >> 10, k = idx & 1023; const float v = s < 8 ? a.in[I_C][s * 1024 + k] : a.in[I_CCTX][k]; sc[idx] = v / (1.0f + expf(-v)); }
        __syncthreads();
        float acc[9];
#pragma unroll
        for (int s = 0; s < 9; ++s) acc[s] = 0.f;
        const float* wp = a.in[I_WADA] + ((size_t)l * 1024 + F.wave * 128) * 6144 + j0 + F.lane;
#pragma unroll 4
        for (int k = 0; k < 128; ++k) { const float w = wp[(size_t)k * 6144];
#pragma unroll
            for (int s = 0; s < 9; ++s) acc[s] += sc[s * 1024 + F.wave * 128 + k] * w; }
#pragma unroll
        for (int s = 0; s < 9; ++s) red[(F.wave * 9 + s) * 64 + F.lane] = acc[s];
        __syncthreads();
        for (int idx = F.tid; idx < 576; idx += NWAVES * 64) { const int s = idx >> 6, jl = idx & 63; float sum = a.in[I_BADA][l * 6144 + j0 + jl];
#pragma unroll
            for (int w = 0; w < 8; ++w) sum += red[(w * 9 + s) * 64 + jl];
            mod[((size_t)l * 9 + s) * 6144 + j0 + jl] = sum; }
        __syncthreads();
    }
    if (F.bid == F.G - 1) {
        for (int idx = F.tid; idx < 1024; idx += NWAVES * 64) { const int n = idx >> 4, i = idx & 15; const float fr = powf(10000.0f, -(float)i / 16.0f); const float ang = (float)n * fr;
            rope[idx * 2] = cosf(ang); rope[idx * 2 + 1] = sinf(ang); }
    }
}

template <class SrcF, class MapF>
__device__ __forceinline__ void transpose_item(const SrcF& src, const MapF& nn_of_dr, bf16* dst  , int ldt, LAS float* scr, int lane) {
#pragma unroll 8
    for (int i = 0; i < 32; ++i) { const int kk = 2 * i + (lane >> 5); scr[kk * 33 + (lane & 31)] = src(kk, lane & 31); }
    LDS_WAIT(); asm volatile("" ::: "memory");
    const int c = lane & 7;
#pragma unroll
    for (int j = 0; j < 4; ++j) { const int dr = (lane >> 3) + 8 * j; const LAS float* s = scr + (8 * c) * 33 + nn_of_dr(dr);
        v4u o; o.x = pk2(s[0 * 33], s[1 * 33]); o.y = pk2(s[2 * 33], s[3 * 33]); o.z = pk2(s[4 * 33], s[5 * 33]); o.w = pk2(s[6 * 33], s[7 * 33]);
        *(GAS v4u*)(dst + (size_t)dr * ldt + 8 * c) = o; }
    LDS_WAIT(); asm volatile("" ::: "memory");
}
__device__ __forceinline__ int win_origbase(int t) { return t < 6 ? t * 256 : (t < 12 ? 4608 + (t - 6) * 256 : 1536 + (t - 12) * 256); }
__device__ __forceinline__ void ph_conv_attn(const Frame& F0, const Args& a, int l, bf16* WinT, bf16* WbrT, bf16* WoT, float* WrT) {
    const Frame F = local_frame(F0);
    LAS float* scr = (LAS float*)(F.lds + RING_OFF + F.wave * 16384);
    const int gw = F.bid * NWAVES + F.wave, NGW = F.G * NWAVES;
    constexpr int I_IN = 16 * 192, I_BR = 8 * 32, I_OUT = 16 * 32, NITEMS = I_IN + 3 * I_BR + I_OUT;
    const auto ident = [](int dr) { return dr; };
    for (int it = gw; it < NITEMS; it += NGW) {
        int r = it;
        if (r < I_IN) { const int kb = r / 192, q = r % 192, t = q >> 3, g8 = q & 7, bj = g8 >> 2, wc = g8 & 3; const int col0 = win_origbase(t) + wc * 64 + bj * 32;
            const float* W = a.in[I_WIN] + (size_t)l * 1024 * 6144 + (size_t)(kb * 64) * 6144 + col0;
            transpose_item([=](int kk, int nn) { return W[(size_t)kk * 6144 + nn]; }, ident, WinT + (size_t)(q * 32) * 1024 + kb * 64, 1024, scr, F.lane); continue; }
        r -= I_IN;
        if (r < 3 * I_BR) { const int br = r / I_BR, rr = r % I_BR, kb = rr / 32, q = rr % 32;
            const float* W = a.in[I_WBA + br] + (size_t)l * 512 * 1024 + (size_t)(kb * 64) * 1024 + q * 32;
            transpose_item([=](int kk, int nn) { return W[(size_t)kk * 1024 + nn]; }, ident, WbrT + (size_t)br * 1024 * 512 + (size_t)(q * 32) * 512 + kb * 64, 512, scr, F.lane); continue; }
        r -= 3 * I_BR;
        { const int kb = r / 32, q = r % 32;
            const float* W = a.in[I_WOUT] + (size_t)l * 1024 * 1024 + (size_t)(kb * 64) * 1024 + q * 32;
            transpose_item([=](int kk, int nn) { return W[(size_t)kk * 1024 + nn]; }, ident, WoT + (size_t)(q * 32) * 1024 + kb * 64, 1024, scr, F.lane); }
    }
    for (int idx = F.bid * NWAVES * 64 + F.tid; idx < 36 * 1024; idx += F.G * NWAVES * 64) { const int o = idx >> 10, k = idx & 1023;
        WrT[idx] = o < 4 ? a.in[I_WRG][((size_t)l * 1024 + k) * 4 + o] : a.in[I_WRE][((size_t)l * 1024 + k) * 32 + (o - 4)]; }
}
__device__ __forceinline__ void ph_conv_experts(const Frame& F0, const Args& a, int l, bf16* W1t, bf16* W2t) {
    const Frame F = local_frame(F0);
    LAS float* scr = (LAS float*)(F.lds + RING_OFF + F.wave * 16384);
    const int gw = F.bid * NWAVES + F.wave, NGW = F.G * NWAVES;
    constexpr int I_1 = 16 * 32, I_2 = 8 * 32, NITEMS = NEXP * (I_1 + I_2);
    for (int it = gw; it < NITEMS; it += NGW) {
        const int e = it / (I_1 + I_2); int r = it % (I_1 + I_2);
        if (r < I_1) { const int kb = r / 32, gq = r % 32, pn = gq >> 3, g8 = gq & 7, bj = g8 >> 2, wc = g8 & 3; const int hb = pn * 128 + bj * 64 + wc * 16;
            const float* Wg = a.in[I_WEG] + ((size_t)(l * NEXP + e) * 1024 + kb * 64) * EHID + hb;
            const float* Wu = a.in[I_WEU] + ((size_t)(l * NEXP + e) * 1024 + kb * 64) * EHID + hb;
            transpose_item([=](int kk, int nn) { return nn < 16 ? Wg[(size_t)kk * EHID + nn] : Wu[(size_t)kk * EHID + (nn - 16)]; },
                           [](int dr) { return ((dr >> 2) & 1) * 16 + (dr >> 3) * 4 + (dr & 3); },
                           W1t + ((size_t)e * 1024 + gq * 32) * 1024 + kb * 64, 1024, scr, F.lane); }
        else { r -= I_1; const int kb = r / 32, q = r % 32;
            const float* W = a.in[I_WED] + ((size_t)(l * NEXP + e) * EHID + kb * 64) * 1024 + q * 32;
            transpose_item([=](int kk, int nn) { return W[(size_t)kk * 1024 + nn]; }, [](int dr) { return dr; }, W2t + ((size_t)e * 1024 + q * 32) * EHID + kb * 64, EHID, scr, F.lane); }
    }
}

__device__ __forceinline__ void norm_mod_store(const f32x4 (&v)[4], const float* shift, const float* scale, bf16* hrow, int lane) {
    float s2 = 0.f;
#pragma unroll
    for (int j = 0; j < 4; ++j) s2 += (v[j][0] * v[j][0] + v[j][1] * v[j][1]) + (v[j][2] * v[j][2] + v[j][3] * v[j][3]);
    const float rstd = 1.0f / sqrtf(wave_sum(s2) * (1.0f / DM) + 1e-6f);
#pragma unroll
    for (int j = 0; j < 4; ++j) { const int c = 4 * lane + 256 * j; const f32x4 sh = *(const f32x4*)(shift + c), sc = *(const f32x4*)(scale + c);
        const f32x4 h = v[j] * rstd * (sc + 1.0f) + sh; v2u o; o.x = pk2(h[0], h[1]); o.y = pk2(h[2], h[3]); *(v2u*)(hrow + c) = o; }
}
__device__ __forceinline__ void ph_norm1_l0(const Frame& F0, const Args& a, const float* modl, bf16* H) {
    const Frame F = local_frame(F0);
    const int gw = F.bid * NWAVES + F.wave, NGW = F.G * NWAVES;
    for (int r = gw; r < TT; r += NGW) { const float* x = xrow_c(a.in[I_X], a.in[I_CTX], r); f32x4 v[4];
#pragma unroll
        for (int j = 0; j < 4; ++j) v[j] = *(const f32x4*)(x + 4 * F.lane + 256 * j);
        const float* mp = modl + (size_t)modsel(r) * 6144; norm_mod_store(v, mp, mp + 1024, H + (size_t)r * DM, F.lane); }
}
template <bool NORM>
__device__ __forceinline__ void ph_combine(const Frame& F0, float* XL, float* XC, const float* modprev, const float* modnext, const bf16* yout, const int* slotof, bf16* H, bool latent_only) {
    const Frame F = local_frame(F0);
    const int gw = F.bid * NWAVES + F.wave, NGW = F.G * NWAVES; const int nrows = latent_only ? NB * SEQL : TT;
    for (int q = gw; q < nrows; q += NGW) { const int r = latent_only ? latrow(q) : q; float* x = xrow_m(XL, XC, r);
        const int s0 = slotof[r], s1 = slotof[TT + r]; const float* gate = modprev + (size_t)modsel(r) * 6144 + 5 * 1024; f32x4 v[4];
#pragma unroll
        for (int j = 0; j < 4; ++j) { const int c = 4 * F.lane + 256 * j; const f32x4 xv = *(const f32x4*)(x + c), g = *(const f32x4*)(gate + c);
            const v2u y0 = *(const v2u*)(yout + (size_t)s0 * DM + c), y1 = *(const v2u*)(yout + (size_t)s1 * DM + c);
            f32x4 f; f[0] = bflo(y0.x) + bflo(y1.x); f[1] = bfhi(y0.x) + bfhi(y1.x); f[2] = bflo(y0.y) + bflo(y1.y); f[3] = bfhi(y0.y) + bfhi(y1.y);
            v[j] = xv + g * f; *(f32x4*)(x + c) = v[j]; }
        if constexpr (NORM) { const float* mp = modnext + (size_t)modsel(r) * 6144; norm_mod_store(v, mp, mp + 1024, H + (size_t)r * DM, F.lane); } }
}
template <int R>
__device__ __forceinline__ void ph_norm2_router(const Frame& F0, const float* XL, const float* XC, const float* modl, const float* WrT, bf16* H, int* rte, int* rtr, float* rtw, unsigned* cnt, bool latent_only) {
    const Frame F = local_frame(F0);
    const int gw = F.bid * NWAVES + F.wave, NGW = F.G * NWAVES; const int nrows = latent_only ? NB * SEQL : TT;
    LAS float* scr = (LAS float*)(F.lds + RING_OFF + F.wave * 2048);
    for (int base = gw * R; base < nrows; base += NGW * R) {
        f32x4 v[R][4]; int rows[R];
#pragma unroll
        for (int q = 0; q < R; ++q) { int qq = base + q; if (qq >= nrows) qq = nrows - 1; const int r = latent_only ? latrow(qq) : qq; rows[q] = r;
            const float* x = xrow_c(XL, XC, r);
#pragma unroll
            for (int j = 0; j < 4; ++j) v[q][j] = *(const f32x4*)(x + 4 * F.lane + 256 * j);
            float s2 = 0.f;
#pragma unroll
            for (int j = 0; j < 4; ++j) s2 += (v[q][j][0] * v[q][j][0] + v[q][j][1] * v[q][j][1]) + (v[q][j][2] * v[q][j][2] + v[q][j][3] * v[q][j][3]);
            const float rstd = 1.0f / sqrtf(wave_sum(s2) * (1.0f / DM) + 1e-6f);
            const float* mp = modl + (size_t)modsel(r) * 6144 + 3 * 1024;
#pragma unroll
            for (int j = 0; j < 4; ++j) { const int c = 4 * F.lane + 256 * j; const f32x4 sh = *(const f32x4*)(mp + c), sc = *(const f32x4*)(mp + 1024 + c);
                v[q][j] = v[q][j] * rstd * (sc + 1.0f) + sh; v2u o; o.x = pk2(v[q][j][0], v[q][j][1]); o.y = pk2(v[q][j][2], v[q][j][3]);
                if (base + q < nrows) *(v2u*)(H + (size_t)r * DM + c) = o; } }
        float lg[R];
#pragma unroll
        for (int q = 0; q < R; ++q) lg[q] = 0.f;
#pragma unroll 4
        for (int o = 0; o < 36; ++o) { f32x4 w[4];
#pragma unroll
            for (int j = 0; j < 4; ++j) w[j] = *(const f32x4*)(WrT + o * 1024 + 4 * F.lane + 256 * j);
#pragma unroll
            for (int q = 0; q < R; ++q) { float p = 0.f;
#pragma unroll
                for (int j = 0; j < 4; ++j) p += (v[q][j][0] * w[j][0] + v[q][j][1] * w[j][1]) + (v[q][j][2] * w[j][2] + v[q][j][3] * w[j][3]);
                p = wave_sum(p); lg[q] = (F.lane == o) ? p : lg[q]; } }
#pragma unroll
        for (int q = 0; q < R; ++q) if (F.lane < 36) scr[q * 40 + F.lane] = lg[q];
        LDS_WAIT(); asm volatile("" ::: "memory");
        if (F.lane < R && base + F.lane < nrows) {
            const LAS float* L = scr + F.lane * 40; int r = rows[0];
#pragma unroll
            for (int q = 1; q < R; ++q) r = (F.lane == q) ? rows[q] : r;
            int gi = 0; float gm = L[0];
#pragma unroll
            for (int j = 1; j < 4; ++j) if (L[j] > gm) { gm = L[j]; gi = j; }
            float gs = 0.f;
#pragma unroll
            for (int j = 0; j < 4; ++j) gs += expf(L[j] - gm);
            const float gwt = 1.0f / gs;
            const LAS float* E = L + 4 + 8 * gi; int i0 = 0; float v0 = E[0];
            for (int j = 1; j < 8; ++j) if (E[j] > v0) { v0 = E[j]; i0 = j; }
            int i1 = (i0 == 0) ? 1 : 0; float v1 = E[i1];
            for (int j = 0; j < 8; ++j) if (j != i0 && E[j] > v1) { v1 = E[j]; i1 = j; }
            const float tt = expf(v1 - v0), w0 = gwt / (1.0f + tt), w1 = gwt * tt / (1.0f + tt);
            const int e0 = 8 * gi + i0, e1 = 8 * gi + i1;
            const unsigned k0 = atomicAdd(cnt + e0 * 64, 1u), k1 = atomicAdd(cnt + e1 * 64, 1u);
            rte[r] = e0; rte[TT + r] = e1; rtr[r] = (int)k0; rtr[TT + r] = (int)k1; rtw[r] = w0; rtw[TT + r] = w1;
        }
        LDS_WAIT(); asm volatile("" ::: "memory");
    }
}
__device__ __forceinline__ void ph_scan_gather(const Frame& F0, unsigned* cnt, const int* rte, const int* rtr, const float* rtw, int* slotof, float* wslot, int* rttab, const bf16* H, bf16* xs, bool latent_only) {
    const Frame F = local_frame(F0);
    LAS int* offs = (LAS int*)(F.lds + RING_OFF);
    if (F.tid < NEXP) offs[64 + F.tid] = (int)((__hip_atomic_load(cnt + F.tid * 64, RLX_AGENT) + 255u) & ~255u);
    __syncthreads();
    if (F.tid == 0) { int run = 0; for (int e = 0; e < NEXP; ++e) { offs[e] = run; run += offs[64 + e]; } offs[32] = run; }
    __syncthreads();
    if (F.bid == 0) { const int nrt = offs[32] >> 8; if (F.tid == 0) rttab[0] = nrt;
        for (int t = F.tid; t < nrt; t += NWAVES * 64) { int e = 0; for (int j = 1; j < NEXP; ++j) if ((offs[j] >> 8) <= t) e = j; rttab[1 + t] = e; } }
    const int gw = F.bid * NWAVES + F.wave, NGW = F.G * NWAVES; const int nrows = latent_only ? NB * SEQL : TT;
    for (int q = gw; q < nrows; q += NGW) { const int r = latent_only ? latrow(q) : q;
        const int s0 = offs[rte[r]] + rtr[r], s1 = offs[rte[TT + r]] + rtr[TT + r];
        const v4u a0 = *(const v4u*)(H + (size_t)r * DM + 8 * F.lane), a1 = *(const v4u*)(H + (size_t)r * DM + 512 + 8 * F.lane);
        *(v4u*)(xs + (size_t)s0 * DM + 8 * F.lane) = a0; *(v4u*)(xs + (size_t)s0 * DM + 512 + 8 * F.lane) = a1;
        *(v4u*)(xs + (size_t)s1 * DM + 8 * F.lane) = a0; *(v4u*)(xs + (size_t)s1 * DM + 512 + 8 * F.lane) = a1;
        if (F.lane == 0) { slotof[r] = s0; slotof[TT + r] = s1; wslot[s0] = rtw[r]; wslot[s1] = rtw[TT + r]; } }
}
__device__ __forceinline__ void ph_bpost(const Frame& F0, const Args& a, int l, const bf16* Ob, bf16* Y, bool latent_only) {
    const Frame F = local_frame(F0);
    const float lam_init = (l == 0) ? 0.2f : (0.8f - 0.6f * 0.74081822068f);
    const float s1 = wave_sum(a.in[I_LQ1][l * 64 + F.lane] * a.in[I_LK1][l * 64 + F.lane]), s2 = wave_sum(a.in[I_LQ2][l * 64 + F.lane] * a.in[I_LK2][l * 64 + F.lane]);
    const float lam = expf(s1) - expf(s2) + lam_init, post = 1.0f - lam_init;
    const int n = F.lane >> 4, dd = (F.lane & 15) * 8;
    const f32x4 g0 = *(const f32x4*)(a.in[I_SUBLN] + l * 128 + dd), g1 = *(const f32x4*)(a.in[I_SUBLN] + l * 128 + dd + 4);
    const int gw = F.bid * NWAVES + F.wave, NGW = F.G * NWAVES; const int nrows = latent_only ? NB * SEQL : TT;
    for (int q = gw; q < nrows; q += NGW) { const int r = latent_only ? latrow(q) : q;
        const v4u o0 = *(const v4u*)(Ob + (size_t)r * OBW + (2 * n) * 128 + dd), o1 = *(const v4u*)(Ob + (size_t)r * OBW + (2 * n + 1) * 128 + dd);
        float d[8];
        d[0] = bflo(o0.x) - lam * bflo(o1.x); d[1] = bfhi(o0.x) - lam * bfhi(o1.x); d[2] = bflo(o0.y) - lam * bflo(o1.y); d[3] = bfhi(o0.y) - lam * bfhi(o1.y);
        d[4] = bflo(o0.z) - lam * bflo(o1.z); d[5] = bfhi(o0.z) - lam * bfhi(o1.z); d[6] = bflo(o0.w) - lam * bflo(o1.w); d[7] = bfhi(o0.w) - lam * bfhi(o1.w);
        float ss = 0.f;
#pragma unroll
        for (int j = 0; j < 8; ++j) ss += d[j] * d[j];
        ss += __shfl_xor(ss, 1); ss += __shfl_xor(ss, 2); ss += __shfl_xor(ss, 4); ss += __shfl_xor(ss, 8);
        const float rs = post / sqrtf(ss * (1.0f / 128.0f) + 1e-6f);
        v4u w; w.x = pk2(d[0] * rs * g0[0], d[1] * rs * g0[1]); w.y = pk2(d[2] * rs * g0[2], d[3] * rs * g0[3]); w.z = pk2(d[4] * rs * g1[0], d[5] * rs * g1[1]); w.w = pk2(d[6] * rs * g1[2], d[7] * rs * g1[3]);
        *(v4u*)(Y + (size_t)r * YW + 512 + n * 128 + dd) = w; }
}
__device__ __forceinline__ void ph_attention(const Frame& F0, const Args& a, int l, const bf16* P, bf16* Y, bf16* Ob) {
    const Frame F = local_frame(F0);
    using attn_body::AttnU; typedef attn_body::bf16 abf;
    char* shm = (char*)(F.lds + RING_OFF);
    const abf* Pb = (const abf*)P; abf* Yb = (abf*)Y; abf* Obb = (abf*)Ob;
    const float* sinkp = a.in[I_SINK] + l * 8;
    for (int L = F.bid; L < 1024; L += F.G) { const int b = L & 7, s = L >> 3, kh = s >> 6, qb = s & 63; const size_t rb = (size_t)b * TOKB;
        AttnU U; U.q = Pb + (rb + qb * 64) * PW + PC_AQ + kh * 256; U.k = Pb + rb * PW + PC_AK + kh * 64; U.v = Pb + rb * PW + PC_AV + kh * 64;
        U.o = Yb + (rb + qb * 64) * YW + kh * 256; U.opitch = YW; U.rmask = 1; U.rshift = 1; U.NT = 68; U.kbase = 0; U.jq = 0; U.sinkp = nullptr;
        attn_body::attn_unit<false, 8>(U, shm); }
    for (int L = F.bid; L < 2048; L += F.G) { const int b = L & 7, s = L >> 3, combo = s >> 4, qb = s & 15, n = combo >> 2, c = (combo >> 1) & 1, vh = combo & 1; const size_t rb = (size_t)b * TOKB;
        AttnU U; U.q = Pb + (rb + qb * 256) * PW + PC_BQ + (2 * n + c) * 64; U.k = Pb + rb * PW + PC_BK + (2 * n + c) * 64; U.v = Pb + rb * PW + PC_BV + n * 128 + vh * 64;
        U.o = Obb + (rb + qb * 256) * OBW + (2 * n + c) * 128 + vh * 64; U.opitch = OBW; U.rmask = 7; U.rshift = 3; U.NT = 68; U.kbase = 0; U.jq = 0; U.sinkp = nullptr;
        attn_body::attn_unit<false, 8>(U, shm); }
    for (int L = F.bid; L < 1024; L += F.G) { const int b = L & 7, s = L >> 3, kh = s >> 6, qb = s & 63; const size_t rb = (size_t)b * TOKB;
        AttnU U; U.q = Pb + (rb + qb * 64) * PW + PC_CQ + kh * 256; U.k = Pb + rb * PW + PC_CK + kh * 64; U.v = Pb + rb * PW + PC_CV + kh * 64;
        U.o = Yb + (rb + qb * 64) * YW + 1024 + kh * 256; U.opitch = YW; U.rmask = 1; U.rshift = 1; U.NT = 10; U.kbase = 0; U.jq = qb; U.sinkp = sinkp + kh * 4;
        attn_body::attn_unit<true, 8>(U, shm); }
    if (l == 0) {
        for (int L = F.bid; L < 256; L += F.G) { const int b = L & 7, s = L >> 3; const size_t rb = (size_t)b * TOKB; AttnU U; U.NT = 4; U.kbase = SEQL; U.jq = 0; U.sinkp = nullptr;
            if (s < 8) { const int kh = s >> 2, qb = s & 3;
                U.q = Pb + (rb + SEQL + qb * 64) * PW + PC_AQ + kh * 256; U.k = Pb + rb * PW + PC_AK + kh * 64; U.v = Pb + rb * PW + PC_AV + kh * 64;
                U.o = Yb + (rb + SEQL + qb * 64) * YW + kh * 256; U.opitch = YW; U.rmask = 1; U.rshift = 1; }
            else if (s < 24) { const int combo = s - 8, n = combo >> 2, c = (combo >> 1) & 1, vh = combo & 1;
                U.q = Pb + (rb + SEQL) * PW + PC_BQ + (2 * n + c) * 64; U.k = Pb + rb * PW + PC_BK + (2 * n + c) * 64; U.v = Pb + rb * PW + PC_BV + n * 128 + vh * 64;
                U.o = Obb + (rb + SEQL) * OBW + (2 * n + c) * 128 + vh * 64; U.opitch = OBW; U.rmask = 7; U.rshift = 3; }
            else { const int s2 = s - 24, kh = s2 >> 2, qb = s2 & 3;
                U.q = Pb + (rb + SEQL + qb * 64) * PW + PC_CQ + kh * 256; U.k = Pb + rb * PW + PC_CK + kh * 64; U.v = Pb + rb * PW + PC_CV + kh * 64;
                U.o = Yb + (rb + SEQL + qb * 64) * YW + 1024 + kh * 256; U.opitch = YW; U.rmask = 1; U.rshift = 1; U.sinkp = sinkp + kh * 4; }
            attn_body::attn_unit<false, 8>(U, shm); }
    }
}

constexpr int NPHASE = 22;
__global__ void __launch_bounds__(NWAVES * 64, 2) fwd_kernel(Args args) {
    extern __shared__ __attribute__((aligned(16))) unsigned char lds[];
    Frame F; F.lds = (LAS unsigned char*)lds; F.tid = threadIdx.x; F.lane = F.tid & 63; F.wave = __builtin_amdgcn_readfirstlane(F.tid >> 6); F.G = gridDim.x; F.bid = blockIdx.x;
    unsigned char* ws = args.ws;
    unsigned* ctl = (unsigned*)(ws + WS_CTL);
    float* MOD = (float*)(ws + WS_SMALL + SM_MOD); float* ROPE = (float*)(ws + WS_SMALL + SM_ROPE); float* WRT = (float*)(ws + WS_SMALL + SM_WRT);
    int* RTE = (int*)(ws + WS_SMALL + SM_RTE); int* RTR = (int*)(ws + WS_SMALL + SM_RTR); float* RTW = (float*)(ws + WS_SMALL + SM_RTW);
    int* SLOTOF = (int*)(ws + WS_SMALL + SM_SLOT); float* WSLOT = (float*)(ws + WS_SMALL + SM_WSLOT); int* RTTAB = (int*)(ws + WS_SMALL + SM_RTTAB);
    bf16* WINT = (bf16*)(ws + WS_WATT); bf16* WBRT = WINT + (size_t)6144 * 1024; bf16* WOT = WBRT + (size_t)3 * 1024 * 512;
    float* XCTX = (float*)(ws + WS_XCTX);
    bf16* P = (bf16*)(ws + WS_RP); bf16* MB = (bf16*)(ws + WS_RP); bf16* XS = (bf16*)(ws + WS_RP); bf16* YOUT = (bf16*)(ws + WS_RP);
    bf16* Gt = (bf16*)(ws + WS_RG); bf16* W1T = (bf16*)(ws + WS_W1T); bf16* W2T = (bf16*)(ws + WS_W2T); bf16* ACT = (bf16*)(ws + WS_ACT);
    bf16* Y = (bf16*)(ws + WS_RY); bf16* H = (bf16*)(ws + WS_RY); bf16* OB = (bf16*)(ws + WS_RO);
    for (int u = F.tid; u < (LDS_BYTES - LDSCTL_OFF) / 4; u += NWAVES * 64) ((LAS unsigned*)(F.lds + LDSCTL_OFF))[u] = 0u;
    __syncthreads();
    volatile LAS unsigned* MISC = (volatile LAS unsigned*)(F.lds + MISC_OFF);
    XcdBarrier bar; bar.bar = ctl + CW_BAR; bar.x = 0; bar.st = nullptr;
    const int lo = args.ph_lo, hi = args.ph_hi;
    if (hi - lo > 1) bar = xcd_barrier_post(ctl + CW_BAR, MISC + 8);
#ifndef SITE_MASK
#define SITE_MASK 0xFFFF
#endif
#define SITE(j) (((SITE_MASK) >> (j)) & 1)
#define IN(k) (lo <= (k) && (k) < hi)
#define SEAM(k) do { if (IN(k) && IN((k) + 1)) xcd_barrier(bar); } while (0)

    if (SITE(0) && IN(0)) { ph_prologue(F, args, MOD, ROPE); } SEAM(0);
#pragma nounroll
    for (int l = 0; l < 2; ++l) {
        const int pb = 1 + 10 * l; const float* modl = MOD + (size_t)l * 9 * 6144;
        const bool lat_only = (l == 1);
        const float* srcL = (l == 0) ? args.in[I_X] : args.out; const float* srcC = (l == 0) ? args.in[I_CTX] : XCTX;
        if (SITE(1) && IN(pb + 0)) {
            ph_conv_attn(F, args, l, WINT, WBRT, WOT, WRT);
            if (l == 0) ph_norm1_l0(F, args, modl, H);
            else ph_combine<true>(F, args.out, XCTX, MOD, modl, YOUT, SLOTOF, H, false);
        } SEAM(pb + 0);
        if (SITE(2) && IN(pb + 1)) {
            pg8::Gemm g{DM, DM, DM}; pg8::SchedGrid2 S;
            if (l == 0) S.init(F.G, F.bid, H, DM, WINT, DM, 0, 24, 0, 0, 0, 0); else S.init(F.G, F.bid, H, DM, WINT, DM, 1, 24, 0, 2, 6, 6);
            pg8::EpiProj E{P, Gt, args.in[I_AQN], ROPE};
            LAS float* gl = (LAS float*)(F.lds + LDSCTL_OFF + 512);
            if (F.tid < 384) { const int w = F.tid >> 6, d = F.tid & 63; const int which[6] = {I_AQN, I_BQN, I_CQN, I_AKN, I_BKN, I_CKN}; gl[F.tid] = args.in[which[w]][l * 64 + d]; }
            __syncthreads();
            E.gains = (const float*)gl;
            pg8::gemm_phase<pg8::EpiProj, pg8::SchedGrid2, true>(F.lds + RING_OFF, g, S, E);
        } SEAM(pb + 1);
        if (SITE(3) && IN(pb + 2)) { ph_attention(F, args, l, P, Y, OB); } SEAM(pb + 2);
        if (SITE(4) && IN(pb + 3)) { ph_bpost(F, args, l, OB, Y, lat_only); } SEAM(pb + 3);
        if (SITE(5) && IN(pb + 4)) {
            pg8::Gemm g{YW, 512, 512}; pg8::SchedMerge S; S.init(F.G, F.bid, Y, WBRT, lat_only ? 1 : 0);
            pg8::EpiMerge E{Gt, MB};
            pg8::gemm_phase<pg8::EpiMerge, pg8::SchedMerge, true>(F.lds + RING_OFF, g, S, E);
        } SEAM(pb + 4);
        if (SITE(6) && IN(pb + 5)) {
            pg8::Gemm g{DM, DM, DM}; pg8::SchedGrid2 S; S.init(F.G, F.bid, MB, DM, WOT, DM, lat_only ? 1 : 0, 4, 0, 0, 0, 0);
            pg8::EpiOut E{srcL, srcC, args.out, XCTX, modl};
            pg8::gemm_phase<pg8::EpiOut, pg8::SchedGrid2, true>(F.lds + RING_OFF, g, S, E);
        } SEAM(pb + 5);
        if (SITE(7) && IN(pb + 6)) {
            ph_conv_experts(F, args, l, W1T, W2T);
            ph_norm2_router<8>(F, args.out, XCTX, modl, WRT, H, RTE, RTR, RTW, ctl + CW_CNT + l * NEXP * 64, lat_only);
        } SEAM(pb + 6);
        if (SITE(8) && IN(pb + 7)) { ph_scan_gather(F, ctl + CW_CNT + l * NEXP * 64, RTE, RTR, RTW, SLOTOF, WSLOT, RTTAB, H, XS, lat_only); } SEAM(pb + 7);
        if (SITE(9) && IN(pb + 8)) {
            pg8::Gemm g{DM, DM, DM}; pg8::SchedMoe S; S.init(F.G, F.bid, RTTAB, XS, DM, W1T, DM);
            pg8::EpiAct E{ACT};
            pg8::gemm_phase<pg8::EpiAct, pg8::SchedMoe, true>(F.lds + RING_OFF, g, S, E);
        } SEAM(pb + 8);
        if (SITE(10) && IN(pb + 9)) {
            pg8::Gemm g{EHID, EHID, EHID}; pg8::SchedMoe S; S.init(F.G, F.bid, RTTAB, ACT, EHID, W2T, EHID);
            pg8::EpiDown E{YOUT, WSLOT};
            pg8::gemm_phase<pg8::EpiDown, pg8::SchedMoe, true>(F.lds + RING_OFF, g, S, E);
        } SEAM(pb + 9);
    }
    if (SITE(11) && IN(21)) { ph_combine<false>(F, args.out, XCTX, MOD + (size_t)9 * 6144, MOD, YOUT, SLOTOF, H, true); }
#undef IN
#undef SEAM
}

extern "C" void kernel_launch(void* const* d_in, const int* in_sizes, int n_in, void* d_out, int out_size, void* d_ws, size_t ws_size, hipStream_t stream) {
    static int grid = 0;
    if (grid == 0) {
        if (n_in != 28 || out_size != NB * SEQL * DM || ws_size < WS_END) { fprintf(stderr, "kernel_launch: unexpected problem (n_in %d out %d ws %zu need %zu); nothing launched\n", n_in, out_size, ws_size, (size_t)WS_END); grid = -1; return; }
        int dev = 0, cus = 0;
        if (hipGetDevice(&dev) != hipSuccess || hipDeviceGetAttribute(&cus, hipDeviceAttributeMultiprocessorCount, dev) != hipSuccess) { grid = -1; return; }
        if (hipFuncSetAttribute((const void*)fwd_kernel, hipFuncAttributeMaxDynamicSharedMemorySize, LDS_BYTES) != hipSuccess) { fprintf(stderr, "kernel_launch: hipFuncSetAttribute failed\n"); grid = -1; return; }
        int per_cu = 0;
        if (hipOccupancyMaxActiveBlocksPerMultiprocessor(&per_cu, (const void*)fwd_kernel, NWAVES * 64, LDS_BYTES) != hipSuccess || per_cu < 1) fprintf(stderr, "kernel_launch: occupancy query says %d per CU\n", per_cu);
        (void)hipGetLastError();
        grid = cus;
    }
    if (grid < 0) return;
    if (hipMemsetAsync((char*)d_ws + WS_CTL, 0, CTL_ZERO_BYTES, stream) != hipSuccess) return;
    Args a{};
    for (int i = 0; i < 28; ++i) a.in[i] = (const float*)d_in[i];
    a.out = (float*)d_out; a.ws = (unsigned char*)d_ws;
#if MK_MULTI
    for (int p = 0; p < NPHASE; ++p) { a.ph_lo = p; a.ph_hi = p + 1; hipLaunchKernelGGL(fwd_kernel, dim3(grid), dim3(NWAVES * 64), LDS_BYTES, stream, a); }
#else
    a.ph_lo = 0; a.ph_hi = NPHASE;
    hipLaunchKernelGGL(fwd_kernel, dim3(grid), dim3(NWAVES * 64), LDS_BYTES, stream, a);
#endif
}
```

```cpp
#include <hip/hip_runtime.h>
#include <hip/hip_bf16.h>
#include <cstdio>
#include <cstdint>
#include <cmath>

#ifndef MK_MULTI
#define MK_MULTI 0
#endif

constexpr int DM = 1024, NB = 8, SEQL = 4096, CTXL = 256, TOKB = SEQL + CTXL  , TT = NB * TOKB  ;
constexpr int RT_PER_B = TOKB / 256  , NRT = TT / 256  ;
constexpr int PW = 3072, GW = 3072, YW = 1536, OBW = 1024;
constexpr int NEXP = 32, EHID = 512, SLOT_MAX = 2 * TT + NEXP * 256  , MOE_CAP = TT;
constexpr float QSCALE = 0.125f * 1.4426950408889634f;
constexpr float LOG2E = 1.4426950408889634f;
constexpr int PC_AQ = 0, PC_BQ = 512, PC_CQ = 1024, PC_AK = 1536, PC_AV = 1664, PC_BK = 1792, PC_BV = 2304, PC_CK = 2816, PC_CV = 2944;

constexpr size_t MiB = 1u << 20;
constexpr size_t WS_CTL = 0, CTL_ZERO_BYTES = 1 * MiB;
constexpr size_t WS_SMALL = 1 * MiB;
constexpr size_t WS_WATT = 8 * MiB;
constexpr size_t WS_XCTX = 26 * MiB;
constexpr size_t WS_RP = 34 * MiB;
constexpr size_t WS_RG = 238 * MiB;
constexpr size_t WS_RY = 442 * MiB;
constexpr size_t WS_RO = 544 * MiB;
constexpr size_t WS_TOKR = 612 * MiB;
constexpr size_t WS_WR = 617 * MiB;
constexpr size_t WS_END = 622 * MiB;
constexpr size_t WS_W1T = WS_RG, WS_W2T = WS_RG + 64 * MiB, WS_ACT = WS_RG + 96 * MiB;
constexpr size_t SM_MOD = 0;
constexpr size_t SM_ROPE = 512 * 1024;
constexpr size_t SM_WRT = 640 * 1024;
constexpr size_t SM_RTE = 1 * MiB;
constexpr size_t SM_RTR = SM_RTE + 512 * 1024;
static_assert(SM_RTR + 512 * 1024 <= 7 * MiB, "small map");
constexpr int CW_BAR = 4096;
constexpr int CW_CNT = 16384;

namespace pg8 {
#define PG8_LAS __attribute__((address_space(3)))
typedef unsigned short bf16_t;
typedef short bf16x8 __attribute__((ext_vector_type(8)));
typedef float f32x4 __attribute__((ext_vector_type(4)));
typedef unsigned u32x4 __attribute__((ext_vector_type(4)));
typedef unsigned u32x2 __attribute__((ext_vector_type(2)));
constexpr int BM = 256, BK = 64, HALF = 128, HTB = HALF * BK * 2  , STAGE_BYTES = 8 * HTB, NXCD = 8, WGM = 8;

__host__ __device__ __forceinline__ int lds_byte(int r, int c) { const int st = (r >> 4) * 2 + (c >> 5), rr = r & 15, cc = c & 31, ob = rr * 64 + cc * 2; return st * 1024 + (ob ^ (((ob >> 9) & 1) << 5)); }
__host__ __device__ __forceinline__ void stage_rc(int b, int& R, int& C) { const int st = b / 1024, sb = b % 1024, swz = sb ^ (((sb >> 9) & 1) << 5); R = (st >> 1) * 16 + swz / 64; C = (st & 1) * 32 + (swz % 64) / 2; }
__host__ __device__ __forceinline__ int perm32(int rho) { const int n = rho >> 4, i = rho & 15; return 8 * (i >> 2) + 4 * n + (i & 3); }

struct Unit { const char* a; const char* b; int pm, pn, aux, rank0, nv; };
struct Gemm { int lda, ldb, K; };

typedef float f32x2_t __attribute__((ext_vector_type(2))); typedef __bf16 bf16x2_t __attribute__((ext_vector_type(2)));
__device__ __forceinline__ unsigned cvt_pk_bf16(float lo, float hi) { f32x2_t v = {lo, hi}; bf16x2_t b = __builtin_convertvector(v, bf16x2_t); return __builtin_bit_cast(unsigned, b); }
__device__ __forceinline__ float fsigmoid(float x) { return __builtin_amdgcn_rcpf(1.0f + __builtin_amdgcn_exp2f(x * -1.4426950408889634f)); }
__device__ __forceinline__ float bf_lo(unsigned u) { return __uint_as_float(u << 16); }
__device__ __forceinline__ float bf_hi(unsigned u) { return __uint_as_float(u & 0xffff0000u); }

__device__ __forceinline__ void tile_order(int wgid, int nM, int nN, int& pm, int& pn) {
    const int nwg = nM * nN;
    { const int q = nwg / NXCD, r = nwg % NXCD, xcd = wgid % NXCD, off = wgid / NXCD; wgid = (xcd < r ? xcd * (q + 1) : r * (q + 1) + (xcd - r) * q) + off; }
    const int nig = WGM * nN, gid = wgid / nig, fm = gid * WGM, gsz = (nM - fm) < WGM ? (nM - fm) : WGM;
    pm = fm + ((wgid % nig) % gsz); pn = (wgid % nig) / gsz;
}

template <class Epi, class Sched, bool ALIGN_EPI, bool GATHER = false>
__device__ __forceinline__ void gemm_phase(PG8_LAS unsigned char* lds, const Gemm g, const Sched& S, const Epi& E) {
    int tid_ = threadIdx.x; asm volatile("" : "+v"(tid_));
    const int tid = tid_, wid = __builtin_amdgcn_readfirstlane(tid >> 6), lane = tid & 63, wr = wid >> 2, wc = wid & 3, fr = lane & 15, fq = lane >> 4;
    const int K = g.K, nt = K / BK;
    unsigned voffA[2], voffB[2], voffA1[2] = {0u, 0u}, nvA0[2] = {0u, 0u}, nvA1[2] = {0u, 0u};
    int stR[2], stC[2];
#pragma unroll
    for (int i = 0; i < 2; ++i) { int R, C; stage_rc(tid * 16 + i * 8192, R, C); const int Rb = Epi::PERM ? ((R & ~31) + perm32(R & 31)) : R; stR[i] = R; stC[i] = C;
        voffA[i] = (unsigned)(R * g.lda + C) * 2u; voffB[i] = (unsigned)(Rb * g.ldb + C) * 2u; }
    const size_t kstep = (size_t)(BK * 2);
    const size_t hstepA = (size_t)HALF * g.lda * 2, hstepB = (size_t)HALF * g.ldb * 2;
    const unsigned ldsw = (unsigned)wid * 1024u;
    const int aoff = lds_byte(wr * 64 + fr, fq * 8), boff = lds_byte(wc * 32 + fr, fq * 8);
#define PG8_SA(b, h) (((b) * 2 + (h)) * HTB)
#define PG8_SB(b, h) ((4 + (b) * 2 + (h)) * HTB)
#define PG8_STAGE(bufoff, gbase, voff) do { _Pragma("unroll") for (int _i = 0; _i < 2; ++_i) \
        __builtin_amdgcn_global_load_lds((const unsigned*)((const char*)(gbase) + (voff)[_i]), (PG8_LAS unsigned*)(lds + (bufoff) + ldsw + _i * 8192), 16, 0, 0); } while (0)
#define PG8_STAGEA(bufoff, gbase, h, V0, V1) do { if constexpr (GATHER) { if (h) PG8_STAGE(bufoff, gbase, V1); else PG8_STAGE(bufoff, gbase, V0); } else { PG8_STAGE(bufoff, (gbase) + ((h) ? hstepA : 0), V0); } } while (0)
#define PG8_LDA(dst, b, h) do { _Pragma("unroll") for (int m = 0; m < 4; ++m) _Pragma("unroll") for (int k = 0; k < 2; ++k) dst[m][k] = *(const PG8_LAS bf16x8*)(lds + PG8_SA(b, h) + aoff + m * 2048 + k * 1024); } while (0)
#define PG8_LDB(dst, b, h) do { _Pragma("unroll") for (int n = 0; n < 2; ++n) _Pragma("unroll") for (int k = 0; k < 2; ++k) dst[n][k] = *(const PG8_LAS bf16x8*)(lds + PG8_SB(b, h) + boff + n * 2048 + k * 1024); } while (0)
#define PG8_MMA(ai, bj, At, Bt) do { __builtin_amdgcn_s_setprio(1); _Pragma("unroll") for (int m = 0; m < 4; ++m) _Pragma("unroll") for (int n = 0; n < 2; ++n) _Pragma("unroll") for (int k = 0; k < 2; ++k) \
        acc[ai][bj][m][n] = __builtin_amdgcn_mfma_f32_16x16x32_bf16(Bt[n][k], At[m][k], acc[ai][bj][m][n], 0, 0, 0); __builtin_amdgcn_s_setprio(0); } while (0)
#define PG8_WAIT_V(n) asm volatile("s_waitcnt vmcnt(" #n ")" ::: "memory")
#define PG8_WAIT_L(n) asm volatile("s_waitcnt lgkmcnt(" #n ")" ::: "memory")
#define PG8_BAR __builtin_amdgcn_s_barrier()
#define PG8_SCHED __builtin_amdgcn_sched_barrier(0)
    Unit cur, nxt; int ui = 0;
    if (!S.next(0, cur)) return;
    f32x4 acc[2][2][4][2];
#pragma unroll
    for (int a = 0; a < 2; ++a)
#pragma unroll
        for (int b = 0; b < 2; ++b)
#pragma unroll
            for (int m = 0; m < 4; ++m)
#pragma unroll
                for (int n = 0; n < 2; ++n) acc[a][b][m][n] = (f32x4){0.f, 0.f, 0.f, 0.f};
    bf16x8 At[4][2], B0[2][2], B1[2][2];
    const char* cA = cur.a; const char* cB = cur.b;
    if constexpr (GATHER) S.rows(cur, stR, stC, g.lda, voffA, voffA1);
    PG8_STAGE(PG8_SB(0, 0), cB, voffB); PG8_STAGE(PG8_SB(0, 1), cB + hstepB, voffB); PG8_STAGEA(PG8_SA(0, 0), cA, 0, voffA, voffA1); PG8_STAGEA(PG8_SA(0, 1), cA, 1, voffA, voffA1);
    if (wr == 1) PG8_BAR;
    PG8_WAIT_V(2); PG8_BAR;
    PG8_STAGE(PG8_SB(1, 0), cB + kstep, voffB); PG8_STAGEA(PG8_SA(1, 0), cA + kstep, 0, voffA, voffA1); PG8_STAGE(PG8_SB(1, 1), cB + hstepB + kstep, voffB);
    PG8_WAIT_V(6); PG8_BAR;
    for (;;) {
        const bool has_next = S.next(ui + 1, nxt);
        const char* nA = has_next ? nxt.a : cA; const char* nB = has_next ? nxt.b : cB;
        if constexpr (GATHER) { if (has_next) S.rows(nxt, stR, stC, g.lda, nvA0, nvA1); else { nvA0[0] = voffA[0]; nvA0[1] = voffA[1]; nvA1[0] = voffA1[0]; nvA1[1] = voffA1[1]; } }
        for (int t = 0; t < nt; t += 2) {
            const bool last = (t == nt - 2);
            unsigned sA0[2], sA1[2];
            if constexpr (GATHER) { sA0[0] = last ? nvA0[0] : voffA[0]; sA0[1] = last ? nvA0[1] : voffA[1]; sA1[0] = last ? nvA1[0] : voffA1[0]; sA1[1] = last ? nvA1[1] : voffA1[1]; }
            else { sA0[0] = voffA[0]; sA0[1] = voffA[1]; sA1[0] = 0u; sA1[1] = 0u; }
            const char* a1 = cA + (size_t)(t + 1) * kstep;
            const char* a2 = last ? nA : cA + (size_t)(t + 2) * kstep; const char* b2 = last ? nB : cB + (size_t)(t + 2) * kstep;
            const char* a3 = a2 + kstep; const char* b3 = b2 + kstep;
            PG8_LDB(B0, 0, 0); PG8_LDB(B1, 0, 1); PG8_SCHED; PG8_LDA(At, 0, 0); PG8_STAGEA(PG8_SA(1, 1), a1, 1, voffA, voffA1);
            PG8_WAIT_V(8); PG8_WAIT_L(0); PG8_BAR; PG8_MMA(0, 0, At, B0); PG8_MMA(0, 1, At, B1); PG8_BAR; PG8_SCHED;
            PG8_LDA(At, 0, 1); PG8_STAGE(PG8_SB(0, 0), b2, voffB); PG8_STAGE(PG8_SB(0, 1), b2 + hstepB, voffB); PG8_STAGEA(PG8_SA(0, 0), a2, 0, sA0, sA1);
            PG8_WAIT_V(8); PG8_WAIT_L(0); PG8_BAR; PG8_MMA(1, 0, At, B0); PG8_MMA(1, 1, At, B1); PG8_BAR; PG8_SCHED;
            PG8_LDB(B0, 1, 0); PG8_LDB(B1, 1, 1); PG8_SCHED; PG8_LDA(At, 1, 0); PG8_STAGEA(PG8_SA(0, 1), a2, 1, sA0, sA1);
            PG8_WAIT_V(8); PG8_WAIT_L(0); PG8_BAR; PG8_MMA(0, 0, At, B0); PG8_MMA(0, 1, At, B1); PG8_BAR; PG8_SCHED;
            PG8_LDA(At, 1, 1); PG8_STAGE(PG8_SB(1, 0), b3, voffB); PG8_STAGE(PG8_SB(1, 1), b3 + hstepB, voffB); PG8_STAGEA(PG8_SA(1, 0), a3, 0, sA0, sA1);
            PG8_WAIT_V(8); PG8_WAIT_L(0); PG8_BAR; PG8_MMA(1, 0, At, B0); PG8_MMA(1, 1, At, B1); PG8_BAR; PG8_SCHED;
        }
        if constexpr (ALIGN_EPI) { if (wr == 0) PG8_BAR; }
        E(acc, cur, wr, wc, fr, fq);
        if (!has_next) break;
#pragma unroll
        for (int a = 0; a < 2; ++a)
#pragma unroll
            for (int b = 0; b < 2; ++b)
#pragma unroll
                for (int m = 0; m < 4; ++m)
#pragma unroll
                    for (int n = 0; n < 2; ++n) acc[a][b][m][n] = (f32x4){0.f, 0.f, 0.f, 0.f};
        cur = nxt; cA = nA; cB = nB; ++ui;
        if constexpr (GATHER) { voffA[0] = nvA0[0]; voffA[1] = nvA0[1]; voffA1[0] = nvA1[0]; voffA1[1] = nvA1[1]; }
        if constexpr (ALIGN_EPI) { if (wr == 1) PG8_BAR; }
    }
    PG8_WAIT_V(0);
    if constexpr (!ALIGN_EPI) { if (wr == 0) PG8_BAR; }
    PG8_BAR;
#undef PG8_SA
#undef PG8_SB
#undef PG8_STAGE
#undef PG8_STAGEA
#undef PG8_LDA
#undef PG8_LDB
#undef PG8_MMA
#undef PG8_WAIT_V
#undef PG8_WAIT_L
#undef PG8_BAR
#undef PG8_SCHED
}

struct EpiProj {
    static constexpr bool PERM = true;
    bf16_t* P; bf16_t* G; const float* gains  ; const float* rope  ; int dry;
    __device__ __forceinline__ void operator()(f32x4 (&acc)[2][2][4][2], const Unit& u, int wr, int wc, int fr, int fq) const {
        if (dry == 1) { float z = acc[0][0][0][0][0] + acc[1][1][3][1][3]; asm volatile("" :: "v"(z)); return; }
        const int t = u.pn, jt = u.pm % RT_PER_B; const bool isctx = (jt == RT_PER_B - 1);
        int mode = 0; const float* gain = gains; float scale = 1.f; bf16_t* outp; int ocol;
        if (t >= 12) { mode = 2; outp = G; ocol = (t - 12) * 256 + wc * 64; }
        else { outp = P; ocol = t * 256 + wc * 64;
            if (t < 6) { mode = 1; gain = gains + (t >> 1) * 64; scale = QSCALE; }
            else if (t == 6) { if (wc < 2) { mode = 1; gain = gains + 3 * 64; } }
            else if (t <= 8) { mode = 1; gain = gains + 4 * 64; }
            else if (t == 11) { if (wc < 2) { mode = 1; gain = gains + 5 * 64; } } }
        const int rin0 = wr * 64 + fr;
        f32x4 g0a = (f32x4){1.f, 1.f, 1.f, 1.f}, g0b = g0a, g1a = g0a, g1b = g0a;
        if (mode == 1) { g0a = *(const f32x4*)(gain + 8 * fq); g0b = *(const f32x4*)(gain + 8 * fq + 4); g1a = *(const f32x4*)(gain + 32 + 8 * fq); g1b = *(const f32x4*)(gain + 36 + 8 * fq); }
#pragma unroll
        for (int ai = 0; ai < 2; ++ai)
#pragma unroll
            for (int m = 0; m < 4; ++m) {
                const int rin = rin0 + ai * HALF + m * 16;
                f32x4 a0 = acc[ai][0][m][0], a1 = acc[ai][0][m][1], b0 = acc[ai][1][m][0], b1 = acc[ai][1][m][1];
                if (mode == 1) {
                    float ss = (a0[0] * a0[0] + a0[1] * a0[1]) + (a0[2] * a0[2] + a0[3] * a0[3]);
                    ss += (a1[0] * a1[0] + a1[1] * a1[1]) + (a1[2] * a1[2] + a1[3] * a1[3]);
                    ss += (b0[0] * b0[0] + b0[1] * b0[1]) + (b0[2] * b0[2] + b0[3] * b0[3]);
                    ss += (b1[0] * b1[0] + b1[1] * b1[1]) + (b1[2] * b1[2] + b1[3] * b1[3]);
                    ss += __shfl_xor(ss, 16); ss += __shfl_xor(ss, 32);
                    const float rs = __builtin_amdgcn_rsqf(ss * (1.0f / 64.0f) + 1e-6f);
                    a0 = a0 * rs * g0a; a1 = a1 * rs * g0b; b0 = b0 * rs * g1a; b1 = b1 * rs * g1b;
                    if (!isctx) {
                        const int pos = jt * 256 + rin;
                        const int nidx = (fq < 2) ? (pos >> 6) : (pos & 63);
                        const f32x4* cs = (const f32x4*)(rope + (nidx * 16 + 8 * (fq & 1)) * 2);
                        const f32x4 c01 = cs[0], c23 = cs[1], c45 = cs[2], c67 = cs[3];
#define ROT_(x1, x2, c, s) do { const float n1_ = (x1) * (c) - (x2) * (s), n2_ = (x1) * (s) + (x2) * (c); (x1) = n1_; (x2) = n2_; } while (0)
                        ROT_(a0[0], b0[0], c01[0], c01[1]); ROT_(a0[1], b0[1], c01[2], c01[3]); ROT_(a0[2], b0[2], c23[0], c23[1]); ROT_(a0[3], b0[3], c23[2], c23[3]);
                        ROT_(a1[0], b1[0], c45[0], c45[1]); ROT_(a1[1], b1[1], c45[2], c45[3]); ROT_(a1[2], b1[2], c67[0], c67[1]); ROT_(a1[3], b1[3], c67[2], c67[3]);
#undef ROT_
                    }
                    a0 = a0 * scale; a1 = a1 * scale; b0 = b0 * scale; b1 = b1 * scale;
                } else if (mode == 2) {
#pragma unroll
                    for (int j = 0; j < 4; ++j) { a0[j] = fsigmoid(a0[j]); a1[j] = fsigmoid(a1[j]); b0[j] = fsigmoid(b0[j]); b1[j] = fsigmoid(b1[j]); }
                }
                bf16_t* rowp = outp + (size_t)(u.pm * 256 + rin) * PW + ocol + 8 * fq;
                u32x4 w0, w1;
                w0.x = cvt_pk_bf16(a0[0], a0[1]); w0.y = cvt_pk_bf16(a0[2], a0[3]); w0.z = cvt_pk_bf16(a1[0], a1[1]); w0.w = cvt_pk_bf16(a1[2], a1[3]);
                w1.x = cvt_pk_bf16(b0[0], b0[1]); w1.y = cvt_pk_bf16(b0[2], b0[3]); w1.z = cvt_pk_bf16(b1[0], b1[1]); w1.w = cvt_pk_bf16(b1[2], b1[3]);
                if (dry == 2) { asm volatile("" :: "v"(w0), "v"(w1)); } else { *(u32x4*)(rowp) = w0; *(u32x4*)(rowp + 32) = w1; }
            }
    }
};
struct EpiMerge {
    static constexpr bool PERM = true;
    const bf16_t* G; bf16_t* Mb;
    __device__ __forceinline__ void operator()(f32x4 (&acc)[2][2][4][2], const Unit& u, int wr, int wc, int fr, int fq) const {
        const int br = u.aux; const int row0 = u.pm * 256 + wr * 64 + fr, col0 = u.pn * 256 + wc * 32 + 8 * fq;
#pragma unroll
        for (int ai = 0; ai < 2; ++ai) {
            u32x4 gv[4][2];
#pragma unroll
            for (int m = 0; m < 4; ++m)
#pragma unroll
                for (int bj = 0; bj < 2; ++bj) gv[m][bj] = *(const u32x4*)(G + (size_t)(row0 + ai * HALF + m * 16) * GW + br * 1024 + col0 + bj * HALF);
#pragma unroll
            for (int m = 0; m < 4; ++m)
#pragma unroll
                for (int bj = 0; bj < 2; ++bj) { const u32x4 g = gv[m][bj];
                    acc[ai][bj][m][0] = acc[ai][bj][m][0] * (f32x4){bf_lo(g.x), bf_hi(g.x), bf_lo(g.y), bf_hi(g.y)};
                    acc[ai][bj][m][1] = acc[ai][bj][m][1] * (f32x4){bf_lo(g.z), bf_hi(g.z), bf_lo(g.w), bf_hi(g.w)}; }
            if (br > 0) {
#pragma unroll
                for (int m = 0; m < 4; ++m)
#pragma unroll
                    for (int bj = 0; bj < 2; ++bj) gv[m][bj] = *(const u32x4*)(Mb + (size_t)(row0 + ai * HALF + m * 16) * DM + col0 + bj * HALF);
#pragma unroll
                for (int m = 0; m < 4; ++m)
#pragma unroll
                    for (int bj = 0; bj < 2; ++bj) { const u32x4 g = gv[m][bj];
                        acc[ai][bj][m][0] = acc[ai][bj][m][0] + (f32x4){bf_lo(g.x), bf_hi(g.x), bf_lo(g.y), bf_hi(g.y)};
                        acc[ai][bj][m][1] = acc[ai][bj][m][1] + (f32x4){bf_lo(g.z), bf_hi(g.z), bf_lo(g.w), bf_hi(g.w)}; }
            }
#pragma unroll
            for (int m = 0; m < 4; ++m)
#pragma unroll
                for (int bj = 0; bj < 2; ++bj) { const f32x4 v0 = acc[ai][bj][m][0], v1 = acc[ai][bj][m][1];
                    u32x4 w; w.x = cvt_pk_bf16(v0[0], v0[1]); w.y = cvt_pk_bf16(v0[2], v0[3]); w.z = cvt_pk_bf16(v1[0], v1[1]); w.w = cvt_pk_bf16(v1[2], v1[3]);
                    *(u32x4*)(Mb + (size_t)(row0 + ai * HALF + m * 16) * DM + col0 + bj * HALF) = w; }
        }
    }
};
struct EpiOut {
    static constexpr bool PERM = false;
    const float* srcL; const float* srcC; float* dstL; float* dstC; const float* modl  ;
    __device__ __forceinline__ void operator()(f32x4 (&acc)[2][2][4][2], const Unit& u, int wr, int wc, int fr, int fq) const {
        const int b = u.pm / RT_PER_B, jt = u.pm % RT_PER_B; const bool isctx = (jt == RT_PER_B - 1);
        const float* gate = modl + (size_t)(isctx ? 8 : b) * 6144 + 2 * 1024;
        const int col0 = u.pn * 256 + wc * 32 + 4 * fq;
        const float* sb = isctx ? srcC + (size_t)b * CTXL * DM : srcL + ((size_t)b * SEQL + jt * 256) * DM;
        float* db = isctx ? dstC + (size_t)b * CTXL * DM : dstL + ((size_t)b * SEQL + jt * 256) * DM;
        f32x4 gv[2][2];
#pragma unroll
        for (int bj = 0; bj < 2; ++bj)
#pragma unroll
            for (int n = 0; n < 2; ++n) gv[bj][n] = *(const f32x4*)(gate + col0 + bj * HALF + n * 16);
#pragma unroll
        for (int ai = 0; ai < 2; ++ai)
#pragma unroll
            for (int mh = 0; mh < 2; ++mh) { f32x4 xv[2][2][2];
#pragma unroll
                for (int m2 = 0; m2 < 2; ++m2)
#pragma unroll
                    for (int bj = 0; bj < 2; ++bj)
#pragma unroll
                        for (int n = 0; n < 2; ++n) xv[m2][bj][n] = *(const f32x4*)(sb + (size_t)(ai * HALF + wr * 64 + (2 * mh + m2) * 16 + fr) * DM + col0 + bj * HALF + n * 16);
#pragma unroll
                for (int m2 = 0; m2 < 2; ++m2)
#pragma unroll
                    for (int bj = 0; bj < 2; ++bj)
#pragma unroll
                        for (int n = 0; n < 2; ++n) *(f32x4*)(db + (size_t)(ai * HALF + wr * 64 + (2 * mh + m2) * 16 + fr) * DM + col0 + bj * HALF + n * 16) = xv[m2][bj][n] + gv[bj][n] * acc[ai][bj][2 * mh + m2][n]; }
    }
};
struct EpiAct {
    static constexpr bool PERM = true;
    bf16_t* act;
    __device__ __forceinline__ void operator()(f32x4 (&acc)[2][2][4][2], const Unit& u, int wr, int wc, int fr, int fq) const {
        const int row0 = u.pm * 256 + wr * 64 + fr, col0 = u.pn * 128 + wc * 16 + 4 * fq;
#pragma unroll
        for (int ai = 0; ai < 2; ++ai)
#pragma unroll
            for (int m = 0; m < 4; ++m) { bf16_t* rowp = act + (size_t)(row0 + ai * HALF + m * 16) * EHID + col0;
#pragma unroll
                for (int bj = 0; bj < 2; ++bj) { const f32x4 gt = acc[ai][bj][m][0], up = acc[ai][bj][m][1]; float o[4];
#pragma unroll
                    for (int j = 0; j < 4; ++j) o[j] = gt[j] * fsigmoid(gt[j]) * up[j];
                    u32x2 w; w.x = cvt_pk_bf16(o[0], o[1]); w.y = cvt_pk_bf16(o[2], o[3]);
                    *(u32x2*)(rowp + bj * 64) = w; } }
    }
};
struct EpiDown {
    static constexpr bool PERM = true;
    bf16_t* yout; const float* wr;
    __device__ __forceinline__ void operator()(f32x4 (&acc)[2][2][4][2], const Unit& u, int wr_, int wc, int fr, int fq) const {
        const int rin0 = wr_ * 64 + fr, col0 = u.pn * 256 + wc * 32 + 8 * fq;
        const float* wp = wr + (size_t)u.aux * MOE_CAP + u.rank0;
#pragma unroll
        for (int ai = 0; ai < 2; ++ai)
#pragma unroll
            for (int m = 0; m < 4; ++m) { const int rin = rin0 + ai * HALF + m * 16; const float sc = wp[rin < u.nv ? rin : 0]; bf16_t* rowp = yout + (size_t)(u.pm * 256 + rin) * DM + col0;
#pragma unroll
                for (int bj = 0; bj < 2; ++bj) { const f32x4 v0 = acc[ai][bj][m][0] * sc, v1 = acc[ai][bj][m][1] * sc;
                    u32x4 w; w.x = cvt_pk_bf16(v0[0], v0[1]); w.y = cvt_pk_bf16(v0[2], v0[3]); w.z = cvt_pk_bf16(v1[0], v1[1]); w.w = cvt_pk_bf16(v1[2], v1[3]);
                    *(u32x4*)(rowp + bj * HALF) = w; } }
    }
};

__device__ __forceinline__ int rowsel_count(int sel) { return sel == 0 ? NRT : (sel == 1 ? NB * 16 : NB); }
__device__ __forceinline__ int rowsel_map(int sel, int q) { return sel == 0 ? q : (sel == 1 ? q + (q >> 4) : q * RT_PER_B + (RT_PER_B - 1)); }
struct SchedGrid2 {
    int G, c;
    int sel0, nN0, pn00, cnt0;
    int sel1, nN1, pn01, cnt1;
    const char* A; const char* B; size_t astep, bstep;
    __device__ __forceinline__ void init(int G_, int c_, const void* A_, int lda, const void* B_, int ldb, int s0, int n0, int p0, int s1, int n1, int p1) {
        G = G_; c = c_; A = (const char*)A_; B = (const char*)B_; astep = (size_t)256 * lda * 2; bstep = (size_t)256 * ldb * 2;
        sel0 = s0; nN0 = n0; pn00 = p0; cnt0 = rowsel_count(s0) * n0; sel1 = s1; nN1 = n1; pn01 = p1; cnt1 = n1 ? rowsel_count(s1) * n1 : 0; }
    __device__ __forceinline__ bool next(int i, Unit& u) const {
        long L = (long)i * G + c; int pm, pn;
        if (L < cnt0) { tile_order((int)L, rowsel_count(sel0), nN0, pm, pn); pm = rowsel_map(sel0, pm); pn += pn00; }
        else { L -= cnt0; if (L >= cnt1) return false; tile_order((int)L, rowsel_count(sel1), nN1, pm, pn); pm = rowsel_map(sel1, pm); pn += pn01; }
        u.pm = pm; u.pn = pn; u.aux = 0; u.rank0 = 0; u.nv = 256; u.a = A + (size_t)pm * astep; u.b = B + (size_t)pn * bstep; return true; }
};
struct SchedMerge {
    int G, c, sel, ntile; const char* Y; const char* W;
    __device__ __forceinline__ void init(int G_, int c_, const void* Y_, const void* W_, int sel_) { G = G_; c = c_; Y = (const char*)Y_; W = (const char*)W_; sel = sel_; ntile = rowsel_count(sel_) * 4; }
    __device__ __forceinline__ bool next(int i, Unit& u) const {
        const int br = i % 3; const long L = (long)(i / 3) * G + c; if (L >= ntile) return false;
        int pm, pn; tile_order((int)L, rowsel_count(sel), 4, pm, pn); pm = rowsel_map(sel, pm);
        u.pm = pm; u.pn = pn; u.aux = br; u.rank0 = 0; u.nv = 256;
        u.a = Y + ((size_t)pm * 256 * YW + br * 512) * 2; u.b = W + ((size_t)br * 1024 * 512 + (size_t)pn * 256 * 512) * 2; return true; }
};
struct SchedMoe {
    int G, c, nrt; const PG8_LAS int* offs; const int* tokr; const char* A; const char* W; size_t astep, wexp, wstep; bool gather;
    __device__ __forceinline__ void init(int G_, int c_, const PG8_LAS int* offs_, const int* tokr_, const void* A_, int lda, const void* W_, int K, bool gather_) {
        G = G_; c = c_; offs = offs_; tokr = tokr_; nrt = offs_[32] >> 8; gather = gather_;
        A = (const char*)A_; W = (const char*)W_; astep = (size_t)256 * lda * 2; wexp = (size_t)1024 * K * 2; wstep = (size_t)256 * K * 2; }
    __device__ __forceinline__ bool next(int i, Unit& u) const {
        const long L = (long)i * G + c; const int rt = (int)(L >> 2), pn = (int)(L & 3); if (rt >= nrt) return false;
        int e = 0;
        for (int j = 1; j < NEXP; ++j) if ((offs[j] >> 8) <= rt) e = j;
        e = __builtin_amdgcn_readfirstlane(e);
        const int rank0 = (rt - (offs[e] >> 8)) * 256; int nv = offs[64 + e] - rank0; nv = nv > 256 ? 256 : nv;
        u.pm = rt; u.pn = pn; u.aux = e; u.rank0 = __builtin_amdgcn_readfirstlane(rank0); u.nv = __builtin_amdgcn_readfirstlane(nv);
        u.a = gather ? A : A + (size_t)rt * astep; u.b = W + (size_t)e * wexp + (size_t)pn * wstep; return true; }
    __device__ __forceinline__ void rows(const Unit& u, const int (&R)[2], const int (&C)[2], int lda, unsigned (&v0)[2], unsigned (&v1)[2]) const {
        const int* tp = tokr + (size_t)u.aux * MOE_CAP + u.rank0;
#pragma unroll
        for (int i = 0; i < 2; ++i) { const int r0 = R[i], r1 = R[i] + HALF;
            const int t0 = tp[r0 < u.nv ? r0 : 0], t1 = tp[r1 < u.nv ? r1 : 0];
            v0[i] = (unsigned)(t0 * lda + C[i]) * 2u; v1[i] = (unsigned)(t1 * lda + C[i]) * 2u; }
    }
};
}
namespace attn_body {
using bf16=__hip_bfloat16;
using bf16x8=__attribute__((ext_vector_type(8)))short;
using s16x4=__attribute__((ext_vector_type(4)))short;
using f32x16=__attribute__((ext_vector_type(16)))float;
using u32x4=__attribute__((ext_vector_type(4)))unsigned;
constexpr int D=64,DMP=PW;
constexpr int NW=8,QBLK=32,KVBLK=64;
__device__ __forceinline__ int crow(int r,int hi){return (r&3)+8*(r>>2)+4*hi;}
#define SBAR() __builtin_amdgcn_sched_barrier(0)
constexpr int NSLOT=3, SLOTB=8192;
constexpr int LDS_K=0, LDS_V=NSLOT*SLOTB, LDS_WS=2*NSLOT*SLOTB, LDS_OST=LDS_WS+NW*64*4, LDS_BYTES=LDS_OST+NW*4096;
__device__ __forceinline__ void glds16(const void*gsrc,unsigned lds_dst){unsigned keep;
  asm volatile("s_mov_b32 %0, m0\n\ts_mov_b32 m0, %2\n\ts_nop 0\n\tglobal_load_lds_dwordx4 %1, off\n\ts_mov_b32 m0, %0":"=&s"(keep):"v"(gsrc),"s"(lds_dst):"memory");}
__device__ __forceinline__ float max3f(float a,float b,float c){float r;asm("v_max3_f32 %0, %1, %2, %3":"=v"(r):"v"(a),"v"(b),"v"(c));return r;}
__device__ __forceinline__ float max2f(float a,float b){float r;asm("v_max_f32_e32 %0, %1, %2":"=v"(r):"v"(a),"v"(b));return r;}
__device__ __forceinline__ float fadd_s(float a,float b){float r;asm("v_add_f32_e32 %0, %1, %2":"=v"(r):"v"(a),"v"(b));return r;}
__device__ __forceinline__ float fsub_s(float a,float b){float r;asm("v_sub_f32_e32 %0, %1, %2":"=v"(r):"v"(a),"v"(b));return r;}
typedef float f32x2_t __attribute__((ext_vector_type(2))); typedef __bf16 bf16x2_t __attribute__((ext_vector_type(2)));
__device__ __forceinline__ unsigned cvtpk_s(float lo,float hi){f32x2_t v={lo,hi};bf16x2_t b=__builtin_convertvector(v,bf16x2_t);return __builtin_bit_cast(unsigned,b);}
#define WAIT_BAR(N) asm volatile("s_waitcnt vmcnt(" #N ") lgkmcnt(0)\n\ts_barrier":::"memory")

__device__ __forceinline__ void qkt(f32x16&p0,f32x16&p1,const char*Kslot,const bf16x8*qr,const f32x16&negm,int r32,int hi){
  const char*kb=Kslot+hi*1024+r32*16;
  #pragma unroll
  for(int d0=0;d0<4;++d0){
    const bf16x8 b0=*reinterpret_cast<const bf16x8*>(kb+d0*2048);
    const bf16x8 b1=*reinterpret_cast<const bf16x8*>(kb+d0*2048+512);
    if(d0==0){p0=__builtin_amdgcn_mfma_f32_32x32x16_bf16(b0,qr[0],negm,0,0,0);p1=__builtin_amdgcn_mfma_f32_32x32x16_bf16(b1,qr[0],negm,0,0,0);}
    else{p0=__builtin_amdgcn_mfma_f32_32x32x16_bf16(b0,qr[d0],p0,0,0,0);p1=__builtin_amdgcn_mfma_f32_32x32x16_bf16(b1,qr[d0],p1,0,0,0);}}
}
typedef __attribute__((address_space(3))) const char* lds_cptr;
typedef short v4i16_t __attribute__((ext_vector_type(4)));
__device__ __forceinline__ void kload8(bf16x8*kf,lds_cptr kp){
  kf[0]=*(const __attribute__((address_space(3))) bf16x8*)(kp);      kf[1]=*(const __attribute__((address_space(3))) bf16x8*)(kp+512);
  kf[2]=*(const __attribute__((address_space(3))) bf16x8*)(kp+2048); kf[3]=*(const __attribute__((address_space(3))) bf16x8*)(kp+2560);
  kf[4]=*(const __attribute__((address_space(3))) bf16x8*)(kp+4096); kf[5]=*(const __attribute__((address_space(3))) bf16x8*)(kp+4608);
  kf[6]=*(const __attribute__((address_space(3))) bf16x8*)(kp+6144); kf[7]=*(const __attribute__((address_space(3))) bf16x8*)(kp+6656);
}
__device__ __forceinline__ void kload2(bf16x8*kf,lds_cptr kp,int j){ kf[2*j]=*(const __attribute__((address_space(3))) bf16x8*)(kp+j*2048); kf[2*j+1]=*(const __attribute__((address_space(3))) bf16x8*)(kp+j*2048+512); }
__device__ __forceinline__ s16x4 vtr(lds_cptr p){ return __builtin_bit_cast(s16x4,__builtin_amdgcn_ds_read_tr16_b64_v4i16((__attribute__((address_space(3))) v4i16_t*)p)); }
__device__ __forceinline__ float rowmax(const f32x16&p0,const f32x16&p1){
  float a=max3f(p0[0],p0[1],p1[0]),b=max3f(p0[2],p0[3],p1[1]);a=max3f(a,p1[2],p1[3]);
  #pragma unroll
  for(int r=4;r<16;r+=4){a=max3f(a,p0[r],p0[r+1]);b=max3f(b,p0[r+2],p0[r+3]);a=max3f(a,p1[r],p1[r+1]);b=max3f(b,p1[r+2],p1[r+3]);}
  const float m=max2f(a,b);
  auto rr=__builtin_amdgcn_permlane32_swap(__float_as_uint(m),__float_as_uint(m),false,false);
  return max2f(__uint_as_float(rr[0]),__uint_as_float(rr[1]));
}
__device__ __forceinline__ void pv(f32x16*o,int vb,bf16x8 pa0,bf16x8 pa1,bf16x8 pa2,bf16x8 pa3){
  #pragma unroll
  for(int d0=0;d0<2;++d0){s16x4 lo[4],hi[4];
    #pragma unroll
    for(int ks=0;ks<4;++ks){
      asm volatile("ds_read_b64_tr_b16 %0,%1 offset:%c2":"=&v"(lo[ks]):"v"(vb),"i"(d0*4096+ks*1024):"memory");
      asm volatile("ds_read_b64_tr_b16 %0,%1 offset:%c2":"=&v"(hi[ks]):"v"(vb),"i"(d0*4096+ks*1024+512):"memory");}
    asm volatile("s_waitcnt lgkmcnt(0)":::"memory");SBAR();
    #define PK(k) (bf16x8){lo[k][0],lo[k][1],lo[k][2],lo[k][3],hi[k][0],hi[k][1],hi[k][2],hi[k][3]}
    o[d0]=__builtin_amdgcn_mfma_f32_32x32x16_bf16(pa0,PK(0),o[d0],0,0,0);
    o[d0]=__builtin_amdgcn_mfma_f32_32x32x16_bf16(pa1,PK(1),o[d0],0,0,0);
    o[d0]=__builtin_amdgcn_mfma_f32_32x32x16_bf16(pa2,PK(2),o[d0],0,0,0);
    o[d0]=__builtin_amdgcn_mfma_f32_32x32x16_bf16(pa3,PK(3),o[d0],0,0,0);
    #undef PK
  }
}
struct AttnU { const bf16* q; const bf16* k; const bf16* v; bf16* o; const float* sinkp; int opitch, rmask, rshift, NT, kbase, jq; };
__device__ __forceinline__ int win_tile(int t,int jq,int&lo,int&hi){
  int jt; lo=-1000; hi=1000;
  if(t==0) jt=jq;
  else if(t==1){ jt=jq-1; if(jt<0){jt=jq;lo=1000;hi=-1000;} }
  else if(t==2){ jt=jq+1; if(jt>63){jt=jq;lo=1000;hi=-1000;} }
  else if(t==3){ jt=jq-2; lo=0; if(jt<0){jt=jq;lo=1000;hi=-1000;} }
  else if(t==4){ jt=jq+2; hi=0; if(jt>63){jt=jq;lo=1000;hi=-1000;} }
  else if(t<9) jt=64+(t-5);
  else { jt=67; lo=1000; hi=-1000; }
  return jt*64;
}
__device__ __forceinline__ void wmask(f32x16&p0,f32x16&p1,int lo,int hi_,int dq){
  const float NEG=-INFINITY;
  #pragma unroll
  for(int r=0;r<16;++r){const int d=(r&3)+8*(r>>2)+dq; if(d<lo||d>hi_)p0[r]=NEG; if(d+32<lo||d+32>hi_)p1[r]=NEG;}
}
template<bool WIN> __device__ __forceinline__ int krow_of(int t,int kbase,int jq){ if constexpr(WIN){int lo_,hi_;return win_tile(t,jq,lo_,hi_);} else return kbase+t*KVBLK; }
template<bool WIN,int THRL> __device__ __forceinline__ void attn_unit(const AttnU&U,char*shm){
  int tid_=threadIdx.x; asm volatile("":"+v"(tid_));
  const int tid=tid_,lane=tid&63,r32=lane&31,hi=lane>>5; const int wid=__builtin_amdgcn_readfirstlane(tid>>6);
  const int wrow=(wid&U.rmask)*QBLK, wcol=(wid>>U.rshift)*D;
  const bf16*Qw=U.q+(long)wrow*DMP+wcol;
  const bf16*Kh=U.k,*Vh=U.v;
  const unsigned lds0=(unsigned)(uintptr_t)shm;
  float*wsf=(float*)(shm+LDS_WS)+wid*64;
  const bf16*ksrc=Kh+(long)lane*DMP+wid*8;
  const bf16*vsrc=Vh+(long)(16*(wid&3)+(lane>>2))*DMP+(wid>>2)*32+(lane&3)*8;
  const unsigned kdst=lds0+LDS_K+wid*1024, vdst=lds0+LDS_V+wid*1024;
  const int NT=U.NT, kbase=U.kbase, jq=U.jq;
  #define KROW(t) krow_of<WIN>((t),kbase,jq)
  #define DMA_K(t,slot) glds16(ksrc+(long)KROW(t)*DMP,(unsigned)__builtin_amdgcn_readfirstlane(kdst+(slot)))
  #define DMA_V(t,slot) glds16(vsrc+(long)KROW(t)*DMP,(unsigned)__builtin_amdgcn_readfirstlane(vdst+(slot)))
  const int vb0=(int)(lds0+LDS_V)+((lane>>4)&1)*32+(lane&3)*8+(4*hi+((lane&15)>>2))*64;
  const char*Kbase=shm+LDS_K; bf16x8 kf[8];
  const lds_cptr shm3=(lds_cptr)shm; const lds_cptr kp0=shm3+LDS_K+hi*1024+r32*16; const lds_cptr vp0=shm3+LDS_V+((lane>>4)&1)*32+(lane&3)*8+(4*hi+((lane&15)>>2))*64;
  DMA_K(0,0);DMA_V(0,0);DMA_K(1,SLOTB);
  bf16x8 qr[4];
  #pragma unroll
  for(int d0=0;d0<4;++d0)qr[d0]=*reinterpret_cast<const bf16x8*>(&Qw[(long)r32*DMP+d0*16+hi*8]);
  float mhat=0.f,l_reg=0.f;f32x16 o[2];o[0]=f32x16{};o[1]=f32x16{};f32x16 negm=f32x16{};asm volatile("":"+v"(negm));
  const int dq=4*hi-((wid&1)*QBLK+r32);
  #define CMASK(P0,P1,t) do{ if constexpr(WIN){ int lo_,hi_; (void)win_tile((t),jq,lo_,hi_); if(lo_>-64||hi_<64) wmask(P0,P1,lo_,hi_,dq); } }while(0)
  bool resc=false;
  #define START(P0,P1) do{ const float rm=rowmax(P0,P1); resc=false; \
    { const float dl=rm; mhat=fadd_s(mhat,dl); \
      _Pragma("unroll") for(int r=0;r<16;++r){P0[r]=fsub_s(P0[r],dl);P1[r]=fsub_s(P1[r],dl);} \
      _Pragma("unroll") for(int r=0;r<16;++r)negm[r]=-mhat; asm volatile("":"+v"(negm)); } \
    _Pragma("unroll") for(int r=0;r<16;++r)P0[r]=__builtin_amdgcn_exp2f(P0[r]); }while(0)
  #define RESC() do{ if(resc){ asm volatile("s_waitcnt lgkmcnt(0)":::"memory"); \
      _Pragma("unroll") for(int d_=0;d_<2;++d_) _Pragma("unroll") for(int r=0;r<16;++r)o[d_][r]*=wsf[crow(r,hi)]; } }while(0)
  f32x16 pA0,pA1,pB0,pB1;
  int sl_prev=0,sl_cur=0,sl_next=SLOTB;
  #define ROT() do{sl_prev=sl_cur;sl_cur=sl_next;sl_next=(sl_next==(NSLOT-1)*SLOTB)?0:sl_next+SLOTB;}while(0)
  DMA_K(2,2*SLOTB);
  WAIT_BAR(3);
  qkt(pA0,pA1,Kbase,qr,negm,r32,hi);asm volatile("s_nop 15\n\ts_nop 7":"+v"(pA0),"+v"(pA1));
  START(pA0,pA1);
  _Pragma("unroll") for(int r=0;r<16;++r)pA1[r]=__builtin_amdgcn_exp2f(pA1[r]);
  WAIT_BAR(0);
  DMA_K(3,0);DMA_V(1,SLOTB);
  ROT();
  kload8(kf,kp0+sl_cur);
  WAIT_BAR(2);
  s16x4 vlo[8],vhi[8]; u32x4 pw0,pw1,pw2,pw3;
  #define PKW(P,B) cvtpk_s(P[B],P[B+1])
  #define PAF(k) __builtin_bit_cast(bf16x8,pw##k)
  #define VFR(i) (bf16x8){vlo[i][0],vlo[i][1],vlo[i][2],vlo[i][3],vhi[i][0],vhi[i][1],vhi[i][2],vhi[i][3]}
  #define PIN(x) asm volatile("":"+v"(x))
  #define MX3(a,b,c) __builtin_fmaxf(__builtin_fmaxf((a),(b)),(c))
  #define GAPA(MF,A0,A1,A2,A3,W0,W1,PW_) do{ MF; sacc+=A0; sacc+=A1; sacc+=A2; sacc+=A3; PIN(sacc); W0; W1; PIN(PW_); SBAR(); }while(0)
  #define EX(v) __builtin_amdgcn_exp2f(v)
  #define GAPB(MF,X,B) do{ MF; X[B]=EX(X[B]); X[B+1]=EX(X[B+1]); X[B+2]=EX(X[B+2]); X[B+3]=EX(X[B+3]); PIN(X); SBAR(); }while(0)
  #define VRD(i) do{ vlo[i]=vtr(vp_+(((i)>>2)*4096+((i)&3)*1024)); vhi[i]=vtr(vp_+(((i)>>2)*4096+((i)&3)*1024+512)); }while(0)
  #define KRD(G_,j) do{ if(G_){ kload2(kf,kp0+sl_next,j); SBAR(); } }while(0)
  #define STEP(C0,C1,P0,P1,t,GK,GV,GL,DOMASK) do{ SBAR(); \
    const lds_cptr vp_=vp0+sl_prev; \
    VRD(0); SBAR(); float sacc=(P0[0]+P0[1]); \
    GAPA(C0=__builtin_amdgcn_mfma_f32_32x32x16_bf16(kf[0],qr[0],negm,0,0,0), P0[2],P0[3],P0[4],P0[5],     pw0[0]=PKW(P0,0), pw0[1]=PKW(P0,2), pw0); \
    VRD(4); SBAR(); GAPA(C1=__builtin_amdgcn_mfma_f32_32x32x16_bf16(kf[1],qr[0],negm,0,0,0), P0[6],P0[7],P0[8],P0[9],     pw0[2]=PKW(P0,4), pw0[3]=PKW(P0,6), pw0); \
    VRD(1); SBAR(); GAPA(C0=__builtin_amdgcn_mfma_f32_32x32x16_bf16(kf[2],qr[1],C0,0,0,0),   P0[10],P0[11],P0[12],P0[13], pw1[0]=PKW(P0,8), pw1[1]=PKW(P0,10), pw1); \
    VRD(5); SBAR(); GAPA(C1=__builtin_amdgcn_mfma_f32_32x32x16_bf16(kf[3],qr[1],C1,0,0,0),   P0[14],P0[15],P1[0],P1[1],   pw1[2]=PKW(P0,12),pw1[3]=PKW(P0,14), pw1); \
    VRD(2); SBAR(); GAPA(C0=__builtin_amdgcn_mfma_f32_32x32x16_bf16(kf[4],qr[2],C0,0,0,0),   P1[2],P1[3],P1[4],P1[5],     pw2[0]=PKW(P1,0), pw2[1]=PKW(P1,2), pw2); \
    VRD(6); SBAR(); GAPA(C1=__builtin_amdgcn_mfma_f32_32x32x16_bf16(kf[5],qr[2],C1,0,0,0),   P1[6],P1[7],P1[8],P1[9],     pw2[2]=PKW(P1,4), pw2[3]=PKW(P1,6), pw2); \
    VRD(3); SBAR(); GAPA(C0=__builtin_amdgcn_mfma_f32_32x32x16_bf16(kf[6],qr[3],C0,0,0,0),   P1[10],P1[11],P1[12],P1[13], pw3[0]=PKW(P1,8), pw3[1]=PKW(P1,10), pw3); \
    VRD(7); SBAR(); GAPA(C1=__builtin_amdgcn_mfma_f32_32x32x16_bf16(kf[7],qr[3],C1,0,0,0),   P1[14],P1[15],0.f,0.f,       pw3[2]=PKW(P1,12),pw3[3]=PKW(P1,14), pw3); \
    l_reg+=sacc; \
    if(GK){DMA_K((t)+3,sl_cur);} if(GV){DMA_V((t)+1,sl_next);} \
    if(DOMASK){ CMASK(C0,C1,t); } \
    { float a=MX3(C0[0],C0[1],C1[0]),b=MX3(C0[2],C0[3],C1[1]); a=MX3(a,C1[2],C1[3]); \
      _Pragma("unroll") for(int r=4;r<16;r+=4){a=MX3(a,C0[r],C0[r+1]);b=MX3(b,C0[r+2],C0[r+3]);a=MX3(a,C1[r],C1[r+1]);b=MX3(b,C1[r+2],C1[r+3]);} \
      float rm=__builtin_fmaxf(a,b); { auto rr=__builtin_amdgcn_permlane32_swap(__float_as_uint(rm),__float_as_uint(rm),false,false); rm=__builtin_fmaxf(__uint_as_float(rr[0]),__uint_as_float(rr[1])); } \
      resc=false; \
      if(__builtin_expect(__any(rm>(float)THRL),0)){ const float dl=__builtin_fmaxf(rm,0.f); mhat+=dl; \
        _Pragma("unroll") for(int r=0;r<16;++r){C0[r]-=dl;C1[r]-=dl;} \
        _Pragma("unroll") for(int r=0;r<16;++r)negm[r]=-mhat; asm volatile("":"+v"(negm)); \
        const float f=__builtin_amdgcn_exp2f(-dl); l_reg*=f; if(hi==0)wsf[r32]=f; resc=true; } } \
    SBAR(); \
    GAPB(o[0]=__builtin_amdgcn_mfma_f32_32x32x16_bf16(PAF(0),VFR(0),o[0],0,0,0), C0,0); \
    GAPB(o[1]=__builtin_amdgcn_mfma_f32_32x32x16_bf16(PAF(0),VFR(4),o[1],0,0,0), C0,4); \
    KRD(GL,0); GAPB(o[0]=__builtin_amdgcn_mfma_f32_32x32x16_bf16(PAF(1),VFR(1),o[0],0,0,0), C0,8); \
    KRD(GL,1); GAPB(o[1]=__builtin_amdgcn_mfma_f32_32x32x16_bf16(PAF(1),VFR(5),o[1],0,0,0), C0,12); \
    KRD(GL,2); GAPB(o[0]=__builtin_amdgcn_mfma_f32_32x32x16_bf16(PAF(2),VFR(2),o[0],0,0,0), C1,0); \
    KRD(GL,3); GAPB(o[1]=__builtin_amdgcn_mfma_f32_32x32x16_bf16(PAF(2),VFR(6),o[1],0,0,0), C1,4); \
    GAPB(o[0]=__builtin_amdgcn_mfma_f32_32x32x16_bf16(PAF(3),VFR(3),o[0],0,0,0), C1,8); \
    GAPB(o[1]=__builtin_amdgcn_mfma_f32_32x32x16_bf16(PAF(3),VFR(7),o[1],0,0,0), C1,12); \
    }while(0)
  int t=1;
  if constexpr(!WIN){
    for(;t+5<NT;t+=2){
      STEP(pB0,pB1,pA0,pA1,t,true,true,true,false);     WAIT_BAR(2); RESC(); ROT();
      STEP(pA0,pA1,pB0,pB1,t+1,true,true,true,false);   WAIT_BAR(2); RESC(); ROT();
    }
  }
  #define ENDW(tt) do{ if((tt)+3<NT){WAIT_BAR(2);} else if((tt)+2<NT){WAIT_BAR(1);} else {WAIT_BAR(0);} }while(0)
  for(;t+1<NT;t+=2){
    STEP(pB0,pB1,pA0,pA1,t,(t+3<NT),(t+1<NT),(t+1<NT),true);       ENDW(t);   RESC(); ROT();
    STEP(pA0,pA1,pB0,pB1,t+1,(t+4<NT),(t+2<NT),(t+2<NT),true);     ENDW(t+1); RESC(); ROT();
  }
  STEP(pB0,pB1,pA0,pA1,NT-1,false,false,false,true); RESC();
  { float sacc=pB0[0]+pB0[1]; _Pragma("unroll") for(int r=2;r<16;++r)sacc+=pB0[r]; _Pragma("unroll") for(int r=0;r<16;++r)sacc+=pB1[r]; l_reg+=sacc;
    pw0=(u32x4){PKW(pB0,0),PKW(pB0,2),PKW(pB0,4),PKW(pB0,6)};pw1=(u32x4){PKW(pB0,8),PKW(pB0,10),PKW(pB0,12),PKW(pB0,14)};pw2=(u32x4){PKW(pB1,0),PKW(pB1,2),PKW(pB1,4),PKW(pB1,6)};pw3=(u32x4){PKW(pB1,8),PKW(pB1,10),PKW(pB1,12),PKW(pB1,14)};
    SBAR(); pv(o,vb0+sl_cur,PAF(0),PAF(1),PAF(2),PAF(3)); }
  #undef PKW
  #undef PAF
  #undef VFR
  #undef PIN
  #undef MX3
  #undef GAPA
  #undef GAPB
  #undef EX
  #undef VRD
  #undef KRD
  #undef STEP
  #undef ENDW
  {auto rr=__builtin_amdgcn_permlane32_swap(__float_as_uint(l_reg),__float_as_uint(l_reg),false,false);l_reg=__uint_as_float(rr[0])+__uint_as_float(rr[1]);}
  if(U.sinkp){ const float sk=U.sinkp[wid>>U.rshift]; l_reg+=__builtin_amdgcn_exp2f(sk*LOG2E-mhat); }
  if(hi==0)wsf[32+r32]=l_reg;asm volatile("s_waitcnt lgkmcnt(0)":::"memory");
  float rli[16];
  #pragma unroll
  for(int r=0;r<16;++r)rli[r]=__builtin_amdgcn_rcpf(wsf[32+crow(r,hi)]);
  bf16*Ow=U.o+(long)wrow*U.opitch+wcol;
  { bf16*stg=(bf16*)(shm+LDS_OST)+wid*2048;
    #pragma unroll
    for(int r=0;r<16;++r){const int orow=crow(r,hi);
      #pragma unroll
      for(int d0=0;d0<2;++d0)stg[orow*64+d0*32+r32]=__float2bfloat16(o[d0][r]*rli[r]);}
    asm volatile("s_waitcnt lgkmcnt(0)":::"memory");
    #pragma unroll
    for(int i=0;i<4;++i){const int row=i*8+(lane>>3),ch=lane&7; const u32x4 v=*(const u32x4*)(stg+row*64+ch*8); *(u32x4*)(Ow+(long)row*U.opitch+ch*8)=v;} }
  asm volatile("s_waitcnt lgkmcnt(0)\n\ts_barrier":::"memory");
  #undef KROW
  #undef DMA_K
  #undef DMA_V
  #undef CMASK
  #undef START
  #undef RESC
  #undef ROT
}
#undef SBAR
#undef WAIT_BAR

constexpr int B_LDS_K=0, B_SLOTV=16384, B_LDS_V=NSLOT*SLOTB, B_LDS_WS=B_LDS_V+NSLOT*B_SLOTV, B_LDS_OST=B_LDS_WS+NW*64*4, B_LDS_BYTES=B_LDS_OST+NW*4096;
#define WAIT_BAR(N) asm volatile("s_waitcnt vmcnt(" #N ") lgkmcnt(0)\n\ts_barrier":::"memory")
#define SBAR() __builtin_amdgcn_sched_barrier(0)
template<int THRL> __device__ __forceinline__ void attn_unit_b(const AttnU&U,char*shm){
  int tid_=threadIdx.x; asm volatile("":"+v"(tid_));
  const int tid=tid_,lane=tid&63,r32=lane&31,hi=lane>>5; const int wid=__builtin_amdgcn_readfirstlane(tid>>6);
  const int wrow=wid*QBLK;
  const bf16*Qw=U.q+(long)wrow*DMP;
  const unsigned lds0=(unsigned)(uintptr_t)shm;
  float*wsf=(float*)(shm+B_LDS_WS)+wid*64;
  const bf16*ksrc=U.k+(long)lane*DMP+wid*8;
  const bf16*vsrc=U.v+(long)(16*(wid&3)+(lane>>2))*DMP+(wid>>2)*32+(lane&3)*8;
  const unsigned kdst=lds0+B_LDS_K+wid*1024, vdst=lds0+B_LDS_V+wid*1024;
  const int NT=U.NT, kbase=U.kbase;
  #define DMA_K(t,slot) glds16(ksrc+(long)(kbase+(t)*KVBLK)*DMP,(unsigned)__builtin_amdgcn_readfirstlane(kdst+(slot)))
  #define DMA_V(t,slot) do{ glds16(vsrc+(long)(kbase+(t)*KVBLK)*DMP,(unsigned)__builtin_amdgcn_readfirstlane(vdst+2*(slot))); \
                            glds16(vsrc+(long)(kbase+(t)*KVBLK)*DMP+64,(unsigned)__builtin_amdgcn_readfirstlane(vdst+2*(slot)+8192)); }while(0)
  const char*Kbase=shm+B_LDS_K; bf16x8 kf[8];
  const lds_cptr shm3=(lds_cptr)shm; const lds_cptr kp0=shm3+B_LDS_K+hi*1024+r32*16; const lds_cptr vp0=shm3+B_LDS_V+((lane>>4)&1)*32+(lane&3)*8+(4*hi+((lane&15)>>2))*64;
  DMA_K(0,0);DMA_V(0,0);DMA_K(1,SLOTB);
  bf16x8 qr[4];
  #pragma unroll
  for(int d0=0;d0<4;++d0)qr[d0]=*reinterpret_cast<const bf16x8*>(&Qw[(long)r32*DMP+d0*16+hi*8]);
  float mhat=0.f,l_reg=0.f;f32x16 o[4];o[0]=f32x16{};o[1]=f32x16{};o[2]=f32x16{};o[3]=f32x16{};f32x16 negm=f32x16{};asm volatile("":"+v"(negm));
  bool resc=false;
  #define RESC() do{ if(resc){ asm volatile("s_waitcnt lgkmcnt(0)":::"memory"); \
      _Pragma("unroll") for(int d_=0;d_<4;++d_) _Pragma("unroll") for(int r=0;r<16;++r)o[d_][r]*=wsf[crow(r,hi)]; } }while(0)
  f32x16 C0,C1; u32x4 pa0,pa1,pa2,pa3,pb0,pb1,pb2,pb3;
  int sl_prev=0,sl_cur=0,sl_next=SLOTB;
  #define ROT() do{sl_prev=sl_cur;sl_cur=sl_next;sl_next=(sl_next==(NSLOT-1)*SLOTB)?0:sl_next+SLOTB;}while(0)
  #define PKW(P,B) cvtpk_s(P[B],P[B+1])
  #define EX(v) __builtin_amdgcn_exp2f(v)
  #define PIN(x) asm volatile("":"+v"(x))
  #define MX3(a,b,c) __builtin_fmaxf(__builtin_fmaxf((a),(b)),(c))
  DMA_K(2,2*SLOTB);
  WAIT_BAR(3);
  qkt(C0,C1,Kbase,qr,negm,r32,hi);asm volatile("s_nop 15\n\ts_nop 7":"+v"(C0),"+v"(C1));
  { const float rm=rowmax(C0,C1); mhat=fadd_s(mhat,rm);
    _Pragma("unroll") for(int r=0;r<16;++r){C0[r]=fsub_s(C0[r],rm);C1[r]=fsub_s(C1[r],rm);}
    _Pragma("unroll") for(int r=0;r<16;++r)negm[r]=-mhat; asm volatile("":"+v"(negm));
    _Pragma("unroll") for(int r=0;r<16;++r){C0[r]=EX(C0[r]);C1[r]=EX(C1[r]);}
    float sacc=0.f; _Pragma("unroll") for(int r=0;r<16;++r)sacc+=C0[r]; _Pragma("unroll") for(int r=0;r<16;++r)sacc+=C1[r]; l_reg+=sacc;
    pa0=(u32x4){PKW(C0,0),PKW(C0,2),PKW(C0,4),PKW(C0,6)};pa1=(u32x4){PKW(C0,8),PKW(C0,10),PKW(C0,12),PKW(C0,14)};pa2=(u32x4){PKW(C1,0),PKW(C1,2),PKW(C1,4),PKW(C1,6)};pa3=(u32x4){PKW(C1,8),PKW(C1,10),PKW(C1,12),PKW(C1,14)}; }
  WAIT_BAR(0);
  DMA_K(3,0);DMA_V(1,SLOTB);
  ROT();
  kload8(kf,kp0+sl_cur);
  WAIT_BAR(3);
  s16x4 vl0,vh0,vl1,vh1,vl2,vh2,vl3,vh3;
  #define VRDF(L,H,f) do{ L=vtr(vp_+(((f)&3)*4096+((f)>>2)*1024)); H=vtr(vp_+(((f)&3)*4096+((f)>>2)*1024+512)); }while(0)
  #define VFRF(L,H) (bf16x8){L[0],L[1],L[2],L[3],H[0],H[1],H[2],H[3]}
  #define PAFX(P,k) __builtin_bit_cast(bf16x8,P##k)
  #define KRD(G_,j) do{ if(G_){ kload2(kf,kp0+sl_next,j); SBAR(); } }while(0)
  #define GAPF(PP,PN,g,L,H,CX,ci) do{ \
    o[(g)&3]=__builtin_amdgcn_mfma_f32_32x32x16_bf16(PP,VFRF(L,H),o[(g)&3],0,0,0); \
    CX[ci]=EX(CX[ci]); CX[ci+1]=EX(CX[ci+1]); sacc+=CX[ci]; sacc+=CX[ci+1]; PN=PKW(CX,ci); PIN(sacc); PIN(PN); \
    if((g)+4<16){ VRDF(L,H,(g)+4); } SBAR(); }while(0)
  #define STEP(PP,PN,t,GK,GV,GL) do{ SBAR(); \
    C0=__builtin_amdgcn_mfma_f32_32x32x16_bf16(kf[0],qr[0],negm,0,0,0); C1=__builtin_amdgcn_mfma_f32_32x32x16_bf16(kf[1],qr[0],negm,0,0,0); \
    C0=__builtin_amdgcn_mfma_f32_32x32x16_bf16(kf[2],qr[1],C0,0,0,0);   C1=__builtin_amdgcn_mfma_f32_32x32x16_bf16(kf[3],qr[1],C1,0,0,0); \
    C0=__builtin_amdgcn_mfma_f32_32x32x16_bf16(kf[4],qr[2],C0,0,0,0);   C1=__builtin_amdgcn_mfma_f32_32x32x16_bf16(kf[5],qr[2],C1,0,0,0); \
    C0=__builtin_amdgcn_mfma_f32_32x32x16_bf16(kf[6],qr[3],C0,0,0,0);   C1=__builtin_amdgcn_mfma_f32_32x32x16_bf16(kf[7],qr[3],C1,0,0,0); \
    const lds_cptr vp_=vp0+2*sl_prev; \
    VRDF(vl0,vh0,0); VRDF(vl1,vh1,1); VRDF(vl2,vh2,2); VRDF(vl3,vh3,3); \
    if(GK){DMA_K((t)+3,sl_cur);} if(GV){DMA_V((t)+1,sl_next);} \
    SBAR(); \
    { float a=MX3(C0[0],C0[1],C1[0]),b=MX3(C0[2],C0[3],C1[1]); a=MX3(a,C1[2],C1[3]); \
      _Pragma("unroll") for(int r=4;r<16;r+=4){a=MX3(a,C0[r],C0[r+1]);b=MX3(b,C0[r+2],C0[r+3]);a=MX3(a,C1[r],C1[r+1]);b=MX3(b,C1[r+2],C1[r+3]);} \
      float rm=__builtin_fmaxf(a,b); { auto rr=__builtin_amdgcn_permlane32_swap(__float_as_uint(rm),__float_as_uint(rm),false,false); rm=__builtin_fmaxf(__uint_as_float(rr[0]),__uint_as_float(rr[1])); } \
      resc=false; \
      if(__builtin_expect(__any(rm>(float)THRL),0)){ const float dl=__builtin_fmaxf(rm,0.f); mhat+=dl; \
        _Pragma("unroll") for(int r=0;r<16;++r){C0[r]-=dl;C1[r]-=dl;} \
        _Pragma("unroll") for(int r=0;r<16;++r)negm[r]=-mhat; asm volatile("":"+v"(negm)); \
        const float f=__builtin_amdgcn_exp2f(-dl); l_reg*=f; if(hi==0)wsf[r32]=f; resc=true; } } \
    SBAR(); float sacc=0.f; \
    GAPF(PAFX(PP,0),PN##0[0],0,vl0,vh0,C0,0);  GAPF(PAFX(PP,0),PN##0[1],1,vl1,vh1,C0,2);  GAPF(PAFX(PP,0),PN##0[2],2,vl2,vh2,C0,4);  GAPF(PAFX(PP,0),PN##0[3],3,vl3,vh3,C0,6); \
    KRD(GL,0); GAPF(PAFX(PP,1),PN##1[0],4,vl0,vh0,C0,8);  KRD(GL,1); GAPF(PAFX(PP,1),PN##1[1],5,vl1,vh1,C0,10); \
    KRD(GL,2); GAPF(PAFX(PP,1),PN##1[2],6,vl2,vh2,C0,12); KRD(GL,3); GAPF(PAFX(PP,1),PN##1[3],7,vl3,vh3,C0,14); \
    GAPF(PAFX(PP,2),PN##2[0],8,vl0,vh0,C1,0);  GAPF(PAFX(PP,2),PN##2[1],9,vl1,vh1,C1,2);  GAPF(PAFX(PP,2),PN##2[2],10,vl2,vh2,C1,4); GAPF(PAFX(PP,2),PN##2[3],11,vl3,vh3,C1,6); \
    GAPF(PAFX(PP,3),PN##3[0],12,vl0,vh0,C1,8); GAPF(PAFX(PP,3),PN##3[1],13,vl1,vh1,C1,10); GAPF(PAFX(PP,3),PN##3[2],14,vl2,vh2,C1,12); GAPF(PAFX(PP,3),PN##3[3],15,vl3,vh3,C1,14); \
    l_reg+=sacc; \
    }while(0)
  int t=1;
  for(;t+5<NT;t+=2){
    STEP(pa,pb,t,true,true,true);     WAIT_BAR(3); RESC(); ROT();
    STEP(pb,pa,t+1,true,true,true);   WAIT_BAR(3); RESC(); ROT();
  }
  #define ENDW(tt) do{ if((tt)+3<NT){WAIT_BAR(3);} else if((tt)+2<NT){WAIT_BAR(2);} else {WAIT_BAR(0);} }while(0)
  for(;t+1<NT;t+=2){
    STEP(pa,pb,t,(t+3<NT),(t+1<NT),(t+1<NT));       ENDW(t);   RESC(); ROT();
    STEP(pb,pa,t+1,(t+4<NT),(t+2<NT),(t+2<NT));     ENDW(t+1); RESC(); ROT();
  }
  STEP(pa,pb,NT-1,false,false,false); RESC();
  { const lds_cptr vp_=vp0+2*sl_cur;
    #pragma unroll
    for(int ks=0;ks<4;++ks){
      #pragma unroll
      for(int db=0;db<4;++db){ s16x4 L_,H_; L_=vtr(vp_+(db*4096+ks*1024)); H_=vtr(vp_+(db*4096+ks*1024+512));
        const bf16x8 pf = ks==0?PAFX(pb,0):(ks==1?PAFX(pb,1):(ks==2?PAFX(pb,2):PAFX(pb,3)));
        o[db]=__builtin_amdgcn_mfma_f32_32x32x16_bf16(pf,VFRF(L_,H_),o[db],0,0,0); } } }
  #undef STEP
  #undef ENDW
  #undef GAPF
  #undef KRD
  #undef PAFX
  #undef VFRF
  #undef VRDF
  {auto rr=__builtin_amdgcn_permlane32_swap(__float_as_uint(l_reg),__float_as_uint(l_reg),false,false);l_reg=__uint_as_float(rr[0])+__uint_as_float(rr[1]);}
  if(hi==0)wsf[32+r32]=l_reg;asm volatile("s_waitcnt lgkmcnt(0)":::"memory");
  float rli[16];
  #pragma unroll
  for(int r=0;r<16;++r)rli[r]=__builtin_amdgcn_rcpf(wsf[32+crow(r,hi)]);
  bf16*Ow=U.o+(long)wrow*U.opitch;
  { bf16*stg=(bf16*)(shm+B_LDS_OST)+wid*2048;
    #pragma unroll
    for(int half=0;half<2;++half){
      #pragma unroll
      for(int r=0;r<16;++r){const int orow=crow(r,hi);
        #pragma unroll
        for(int d0=0;d0<2;++d0)stg[orow*64+d0*32+r32]=__float2bfloat16(o[2*half+d0][r]*rli[r]);}
      asm volatile("s_waitcnt lgkmcnt(0)":::"memory");
      #pragma unroll
      for(int i=0;i<4;++i){const int row=i*8+(lane>>3),ch=lane&7; const u32x4 v=*(const u32x4*)(stg+row*64+ch*8); *(u32x4*)(Ow+(long)row*U.opitch+half*64+ch*8)=v;}
      asm volatile("s_waitcnt lgkmcnt(0)":::"memory"); } }
  asm volatile("s_waitcnt lgkmcnt(0)\n\ts_barrier":::"memory");
  #undef DMA_K
  #undef DMA_V
  #undef RESC
  #undef ROT
  #undef PKW
  #undef EX
  #undef PIN
  #undef MX3
}
#undef SBAR
#undef WAIT_BAR
constexpr int ATTN_LDS_BYTES=(LDS_BYTES>B_LDS_BYTES?LDS_BYTES:B_LDS_BYTES);
}
constexpr int RING_OFF = 0, RING_BYTES = 135168;
constexpr int LDSCTL_OFF = RING_BYTES, MISC_OFF = LDSCTL_OFF + 320;
constexpr int LDS_BYTES = 147456;
static_assert(MISC_OFF + 128 <= LDS_BYTES, "LDS map");
constexpr int LDS_OFFS = LDSCTL_OFF + 2048;
constexpr int LDS_RTR = LDSCTL_OFF + 4608;
static_assert(LDS_RTR + 256 + 224 * 32 <= LDS_BYTES, "router records");
static_assert(attn_body::ATTN_LDS_BYTES <= RING_BYTES && pg8::STAGE_BYTES <= RING_BYTES && 8 * 16640 <= RING_BYTES, "phase scratch fits the ring region");
constexpr int NWAVES = 8;

#define GAS __attribute__((address_space(1)))
#define LAS __attribute__((address_space(3)))
typedef unsigned short bf16;
typedef unsigned v4u __attribute__((ext_vector_type(4)));
typedef unsigned v2u __attribute__((ext_vector_type(2)));
typedef float f32x4 __attribute__((ext_vector_type(4)));
typedef GAS unsigned gu32;
#define RLX_AGENT __ATOMIC_RELAXED, __HIP_MEMORY_SCOPE_AGENT
#define LDS_WAIT() asm volatile("s_waitcnt lgkmcnt(0)" ::: "memory")
#define VM_WAIT() asm volatile("s_waitcnt vmcnt(0)" ::: "memory")
__device__ __forceinline__ unsigned f2bf(float f) { unsigned u = __builtin_bit_cast(unsigned, f); return (u + 0x7fffu + ((u >> 16) & 1u)) >> 16; }
__device__ __forceinline__ unsigned pk2(float lo, float hi) { return f2bf(lo) | (f2bf(hi) << 16); }
__device__ __forceinline__ float bflo(unsigned u) { return __uint_as_float(u << 16); }
__device__ __forceinline__ float bfhi(unsigned u) { return __uint_as_float(u & 0xffff0000u); }

#define XB_TMO      128
#define XB_XCNT(j)  (256  + 64 * (j))
#define XB_XSUB(j)  (1280 + 64 * (j))
#define XB_XGEN(j)  (2304 + 64 * (j))
#define XB_TOP      3328
#define XB_TOPGEN   3392
#define XCD_BAR_WORDS 3456
#define XB_SPIN_CAP (1u << 18)
__device__ __forceinline__ unsigned xb_ld(unsigned* p)              { return __hip_atomic_load(p, __ATOMIC_RELAXED, __HIP_MEMORY_SCOPE_AGENT); }
__device__ __forceinline__ unsigned xb_add(unsigned* p, unsigned v) { return __hip_atomic_fetch_add(p, v, __ATOMIC_RELAXED, __HIP_MEMORY_SCOPE_AGENT); }
__device__ __forceinline__ unsigned xb_xcc_id() { return (unsigned)__builtin_amdgcn_s_getreg((3 << 11) | 20) & 0xFu; }
#define XB_SPIN(cond, bar) do { unsigned _sp = 0; while (cond) { __builtin_amdgcn_s_sleep(1); \
    if ((++_sp & 255u) == 0u) { if (xb_ld(&(bar)[XB_TMO])) break; if (_sp > XB_SPIN_CAP) { atomicAdd(&(bar)[XB_TMO], 1u); break; } } } } while (0)
struct XcdBarrier { unsigned* bar; unsigned x; volatile LAS unsigned* st; };
__device__ __forceinline__ XcdBarrier xcd_barrier_post(unsigned* bar, volatile LAS unsigned* st) {
    XcdBarrier b; b.bar = bar; b.x = xb_xcc_id(); b.st = st;
    if (threadIdx.x == 0) (void)xb_add(&bar[XB_XCNT(b.x)], 1u);
    return b;
}
__device__ __forceinline__ void xcd_barrier_complete(unsigned* bar, unsigned x, unsigned& nloc, unsigned& nx) {
    const unsigned G = gridDim.x * gridDim.y * gridDim.z;
    unsigned sum, cnt, mine, sp = 0u;
    for (;;) {
        sum = 0u; cnt = 0u; mine = 0u;
#pragma unroll
        for (unsigned j = 0; j < 16; ++j) { const unsigned c = xb_ld(&bar[XB_XCNT(j)]); sum += c; cnt += (c > 0u) ? 1u : 0u; mine = (j == x) ? c : mine; }
        if (sum == G) break;
        __builtin_amdgcn_s_sleep(1);
        if ((++sp & 255u) == 0u) { if (xb_ld(&bar[XB_TMO])) break; if (sp > XB_SPIN_CAP) { atomicAdd(&bar[XB_TMO], 1u); break; } }
    }
    nloc = mine > 0u ? mine : 1u; nx = cnt > 0u ? cnt : 1u;
}
__device__ __forceinline__ void xcd_barrier(const XcdBarrier& b) {
    asm volatile("s_waitcnt vmcnt(0)" ::: "memory");
    __syncthreads();
    if (threadIdx.x == 0) {
        unsigned* bar = b.bar;
        __builtin_amdgcn_s_waitcnt(0);
        unsigned nloc = b.st[0], nx = b.st[1];
        if (nloc == 0u) { xcd_barrier_complete(bar, b.x, nloc, nx); b.st[0] = nloc; b.st[1] = nx; }
        const unsigned old = xb_add(&bar[XB_XSUB(b.x)], 1u);
        const unsigned gen = old / nloc;
        if (old + 1u == (gen + 1u) * nloc) {
            __builtin_amdgcn_fence(__ATOMIC_RELEASE, "agent");
            asm volatile("s_waitcnt vmcnt(0)" ::: "memory");
            const unsigned og = xb_add(&bar[XB_TOP], 1u);
            const unsigned tg = og / nx;
            if (og + 1u == (tg + 1u) * nx) xb_add(&bar[XB_TOPGEN], 1u);
            else XB_SPIN(xb_ld(&bar[XB_TOPGEN]) == tg, bar);
            __builtin_amdgcn_fence(__ATOMIC_ACQUIRE, "agent");
            xb_add(&bar[XB_XGEN(b.x)], 1u);
            asm volatile("s_waitcnt vmcnt(0)" ::: "memory");
        } else {
            XB_SPIN(xb_ld(&bar[XB_XGEN(b.x)]) == gen, bar);
            __builtin_amdgcn_fence(__ATOMIC_ACQUIRE, "agent");
            asm volatile("s_waitcnt vmcnt(0)" ::: "memory");
        }
    }
    __syncthreads();
}

struct Args { const float* in[28]; float* out; unsigned char* ws; int ph_lo, ph_hi; };
enum { I_X = 0, I_C, I_CTX, I_CCTX, I_WADA, I_BADA, I_WIN, I_AQN, I_AKN, I_BQN, I_BKN, I_CQN, I_CKN, I_LQ1, I_LK1, I_LQ2, I_LK2, I_SUBLN, I_SINK, I_WBA, I_WBB, I_WBC, I_WOUT, I_WRG, I_WRE, I_WEG, I_WEU, I_WED };
struct Frame { LAS unsigned char* lds; int tid, lane, wave, G, bid; };

__device__ __forceinline__ Frame local_frame(const Frame& F0) { Frame F = F0; int t = F0.tid; asm volatile("" : "+v"(t)); F.tid = t; F.lane = t & 63; return F; }
template <int CTRL> __device__ __forceinline__ float dpp_f(float v) { return __int_as_float(__builtin_amdgcn_update_dpp(0, __float_as_int(v), CTRL, 0xF, 0xF, true)); }
__device__ __forceinline__ float wave_sum(float v) {
    v += dpp_f<0xB1>(v);
    v += dpp_f<0x4E>(v);
    v += dpp_f<0x141>(v);
    v += dpp_f<0x140>(v);
    { auto rr = __builtin_amdgcn_permlane16_swap(__float_as_uint(v), __float_as_uint(v), false, false); v = __uint_as_float(rr[0]) + __uint_as_float(rr[1]); }
    { auto rr = __builtin_amdgcn_permlane32_swap(__float_as_uint(v), __float_as_uint(v), false, false); v = __uint_as_float(rr[0]) + __uint_as_float(rr[1]); }
    return v;
}
__device__ __forceinline__ const float* xrow_c(const float* lat, const float* ctx, int r) { const int b = r / TOKB, i = r - b * TOKB; return i < SEQL ? lat + ((size_t)b * SEQL + i) * DM : ctx + ((size_t)b * CTXL + (i - SEQL)) * DM; }
__device__ __forceinline__ float* xrow_m(float* lat, float* ctx, int r) { const int b = r / TOKB, i = r - b * TOKB; return i < SEQL ? lat + ((size_t)b * SEQL + i) * DM : ctx + ((size_t)b * CTXL + (i - SEQL)) * DM; }
__device__ __forceinline__ int modsel(int r) { const int b = r / TOKB, i = r - b * TOKB; return i < SEQL ? b : 8; }
__device__ __forceinline__ int latrow(int q) { return (q >> 12) * TOKB + (q & 4095); }

__device__ __forceinline__ void ph_prologue(const Frame& F0, const Args& a, float* mod, float* rope) {
    const Frame F = local_frame(F0);
    LAS float* sc = (LAS float*)(F.lds + RING_OFF); LAS float* red = (LAS float*)(F.lds + RING_OFF + 40960);
    if (F.bid < 192) {
        const int l = F.bid / 96, j0 = (F.bid % 96) * 64;
        for (int idx = F.tid; idx < 9 * 1024; idx += NWAVES * 64) { const int s = idx >> 10, k = idx & 1023; const float v = s < 8 ? a.in[I_C][s * 1024 + k] : a.in[I_CCTX][k]; sc[idx] = v / (1.0f + expf(-v)); }
        __syncthreads();
        float acc[9];
#pragma unroll
        for (int s = 0; s < 9; ++s) acc[s] = 0.f;
        const float* wp = a.in[I_WADA] + ((size_t)l * 1024 + F.wave * 128) * 6144 + j0 + F.lane;
#pragma unroll 4
        for (int k = 0; k < 128; ++k) { const float w = wp[(size_t)k * 6144];
#pragma unroll
            for (int s = 0; s < 9; ++s) acc[s] += sc[s * 1024 + F.wave * 128 + k] * w; }
#pragma unroll
        for (int s = 0; s < 9; ++s) red[(F.wave * 9 + s) * 64 + F.lane] = acc[s];
        __syncthreads();
        for (int idx = F.tid; idx < 576; idx += NWAVES * 64) { const int s = idx >> 6, jl = idx & 63; float sum = a.in[I_BADA][l * 6144 + j0 + jl];
#pragma unroll
            for (int w = 0; w < 8; ++w) sum += red[(w * 9 + s) * 64 + jl];
            mod[((size_t)l * 9 + s) * 6144 + j0 + jl] = sum; }
        __syncthreads();
    }
    if (F.bid == F.G - 1) {
        for (int idx = F.tid; idx < 1024; idx += NWAVES * 64) { const int n = idx >> 4, i = idx & 15; const float fr = powf(10000.0f, -(float)i / 16.0f); const float ang = (float)n * fr;
            rope[idx * 2] = cosf(ang); rope[idx * 2 + 1] = sinf(ang); }
    }
}

template <class SrcF, class MapF>
__device__ __forceinline__ void transpose_item(const SrcF& src  , const MapF& nn_of_dr  , bf16* dst  , int ldt, LAS float* scr, int lane) {
    f32x4 v[16];
#pragma unroll
    for (int i = 0; i < 16; ++i) { const int idx = lane + 64 * i; v[i] = __builtin_nontemporal_load((const f32x4*)src(idx >> 4, idx & 15)); }
#pragma unroll
    for (int i = 0; i < 16; ++i) { const int idx = lane + 64 * i; LAS float* d = scr + (idx >> 4) * 65 + (idx & 15) * 4; d[0] = v[i][0]; d[1] = v[i][1]; d[2] = v[i][2]; d[3] = v[i][3]; }
    LDS_WAIT(); asm volatile("" ::: "memory");
    const int c = lane & 7;
#pragma unroll
    for (int j = 0; j < 8; ++j) { const int dr = (lane >> 3) + 8 * j; const LAS float* s = scr + (8 * c) * 65 + nn_of_dr(dr);
        v4u o; o.x = pk2(s[0 * 65], s[1 * 65]); o.y = pk2(s[2 * 65], s[3 * 65]); o.z = pk2(s[4 * 65], s[5 * 65]); o.w = pk2(s[6 * 65], s[7 * 65]);
        *(GAS v4u*)(dst + (size_t)dr * ldt + 8 * c) = o; }
    LDS_WAIT(); asm volatile("" ::: "memory");
}
__device__ __forceinline__ int win_origbase(int t) { return t < 6 ? t * 256 : (t < 12 ? 4608 + (t - 6) * 256 : 1536 + (t - 12) * 256); }
__device__ __forceinline__ void ph_conv_attn(const Frame& F0, const Args& a, int l, bf16* WinT, bf16* WbrT, bf16* WoT, float* WrT) {
    const Frame F = local_frame(F0);
    LAS float* scr = (LAS float*)(F.lds + RING_OFF + F.wave * 16640);
    const int gw = F.bid * NWAVES + F.wave, NGW = F.G * NWAVES;
    constexpr int I_IN = 16 * 96, I_BR = 8 * 16, I_OUT = 16 * 16, NITEMS = I_IN + 3 * I_BR + I_OUT;
    const auto ident = [](int dr) { return dr; };
    for (int it = gw; it < NITEMS; it += NGW) {
        int r = it;
        if (r < I_IN) { const int kb = r / 96, q2 = r % 96, t = q2 >> 2, bj = (q2 >> 1) & 1, wp = q2 & 1;
            const float* W = a.in[I_WIN] + (size_t)l * 1024 * 6144 + (size_t)(kb * 64) * 6144 + win_origbase(t) + bj * 32;
            transpose_item([=](int kk, int q) { return W + (size_t)kk * 6144 + (2 * wp + (q >> 3)) * 64 + 4 * (q & 7); }, ident, WinT + (size_t)(t * 256 + bj * 128 + wp * 64) * 1024 + kb * 64, 1024, scr, F.lane); continue; }
        r -= I_IN;
        if (r < 3 * I_BR) { const int br = r / I_BR, rr = r % I_BR, kb = rr / 16, q = rr % 16;
            const float* W = a.in[I_WBA + br] + (size_t)l * 512 * 1024 + (size_t)(kb * 64) * 1024 + q * 64;
            transpose_item([=](int kk, int q4) { return W + (size_t)kk * 1024 + 4 * q4; }, ident, WbrT + (size_t)br * 1024 * 512 + (size_t)(q * 64) * 512 + kb * 64, 512, scr, F.lane); continue; }
        r -= 3 * I_BR;
        { const int kb = r / 16, q = r % 16;
            const float* W = a.in[I_WOUT] + (size_t)l * 1024 * 1024 + (size_t)(kb * 64) * 1024 + q * 64;
            transpose_item([=](int kk, int q4) { return W + (size_t)kk * 1024 + 4 * q4; }, ident, WoT + (size_t)(q * 64) * 1024 + kb * 64, 1024, scr, F.lane); }
    }
    for (int idx = F.bid * NWAVES * 64 + F.tid; idx < 36 * 1024; idx += F.G * NWAVES * 64) { const int o = idx >> 10, k = idx & 1023;
        WrT[idx] = o < 4 ? a.in[I_WRG][((size_t)l * 1024 + k) * 4 + o] : a.in[I_WRE][((size_t)l * 1024 + k) * 32 + (o - 4)]; }
}
__device__ __forceinline__ void ph_conv_experts(const Frame& F0, const Args& a, int l, bf16* W1t, bf16* W2t) {
    const Frame F = local_frame(F0);
    LAS float* scr = (LAS float*)(F.lds + RING_OFF + F.wave * 16640);
    const int gw = F.bid * NWAVES + F.wave, NGW = F.G * NWAVES;
    constexpr int I_1 = 16 * 16, I_2 = 8 * 16, NITEMS = NEXP * (I_1 + I_2);
    for (int it = gw; it < NITEMS; it += NGW) {
        const int e = it / (I_1 + I_2); int r = it % (I_1 + I_2);
        if (r < I_1) { const int kb = r / 16, gq2 = r % 16, pn = gq2 >> 2, g4 = gq2 & 3, bj = g4 >> 1, wp = g4 & 1; const int hb = pn * 128 + bj * 64 + wp * 32;
            const float* Wg = a.in[I_WEG] + ((size_t)(l * NEXP + e) * 1024 + kb * 64) * EHID + hb;
            const float* Wu = a.in[I_WEU] + ((size_t)(l * NEXP + e) * 1024 + kb * 64) * EHID + hb;
            transpose_item([=](int kk, int q) { return q < 8 ? Wg + (size_t)kk * EHID + 4 * q : Wu + (size_t)kk * EHID + 4 * (q - 8); },
                           [](int dr) { return ((dr >> 2) & 1) * 32 + (dr >> 5) * 16 + ((dr >> 3) & 3) * 4 + (dr & 3); },
                           W1t + ((size_t)e * 1024 + pn * 256 + bj * 128 + wp * 64) * 1024 + kb * 64, 1024, scr, F.lane); }
        else { r -= I_1; const int kb = r / 16, q = r % 16;
            const float* W = a.in[I_WED] + ((size_t)(l * NEXP + e) * EHID + kb * 64) * 1024 + q * 64;
            transpose_item([=](int kk, int q4) { return W + (size_t)kk * 1024 + 4 * q4; }, [](int dr) { return dr; }, W2t + ((size_t)e * 1024 + q * 64) * EHID + kb * 64, EHID, scr, F.lane); }
    }
}

__device__ __forceinline__ void norm_mod_store(const f32x4 (&v)[4], const float* shift, const float* scale, bf16* hrow, int lane) {
    float s2 = 0.f;
#pragma unroll
    for (int j = 0; j < 4; ++j) s2 += (v[j][0] * v[j][0] + v[j][1] * v[j][1]) + (v[j][2] * v[j][2] + v[j][3] * v[j][3]);
    const float rstd = 1.0f / sqrtf(wave_sum(s2) * (1.0f / DM) + 1e-6f);
#pragma unroll
    for (int j = 0; j < 4; ++j) { const int c = 4 * lane + 256 * j; const f32x4 sh = *(const f32x4*)(shift + c), sc = *(const f32x4*)(scale + c);
        const f32x4 h = v[j] * rstd * (sc + 1.0f) + sh; v2u o; o.x = pk2(h[0], h[1]); o.y = pk2(h[2], h[3]); *(v2u*)(hrow + c) = o; }
}
__device__ __forceinline__ void ph_norm1_l0(const Frame& F0, const Args& a, const float* modl, bf16* H) {
    const Frame F = local_frame(F0);
    const int gw = F.bid * NWAVES + F.wave, NGW = F.G * NWAVES;
    for (int r0 = gw; r0 < TT; r0 += 2 * NGW) { const int r1 = (r0 + NGW < TT) ? r0 + NGW : r0;
        const float* x0 = xrow_c(a.in[I_X], a.in[I_CTX], r0); const float* x1 = xrow_c(a.in[I_X], a.in[I_CTX], r1); f32x4 v0[4], v1[4];
#pragma unroll
        for (int j = 0; j < 4; ++j) { v0[j] = *(const f32x4*)(x0 + 4 * F.lane + 256 * j); v1[j] = *(const f32x4*)(x1 + 4 * F.lane + 256 * j); }
        const float* mp0 = modl + (size_t)modsel(r0) * 6144; norm_mod_store(v0, mp0, mp0 + 1024, H + (size_t)r0 * DM, F.lane);
        if (r1 != r0) { const float* mp1 = modl + (size_t)modsel(r1) * 6144; norm_mod_store(v1, mp1, mp1 + 1024, H + (size_t)r1 * DM, F.lane); } }
}
template <bool NORM>
__device__ __forceinline__ void ph_combine(const Frame& F0, float* XL, float* XC, const float* modprev, const float* modnext, const bf16* yout, const int* rte, const int* rtr, bf16* H, bool latent_only, const float* RL = nullptr, const float* RC = nullptr) {
    const Frame F = local_frame(F0);
    const int gw = F.bid * NWAVES + F.wave, NGW = F.G * NWAVES; const int nrows = latent_only ? NB * SEQL : TT;
    const LAS int* offs = (const LAS int*)(F.lds + LDS_OFFS);
    for (int q0 = gw; q0 < nrows; q0 += 2 * NGW) { const int q1 = (q0 + NGW < nrows) ? q0 + NGW : q0; int rr[2]; rr[0] = latent_only ? latrow(q0) : q0; rr[1] = latent_only ? latrow(q1) : q1;
        f32x4 xv[2][4], gg[2][4]; v2u ya[2][4], yb[2][4]; float* xp[2];
#pragma unroll
        for (int k = 0; k < 2; ++k) { const int r = rr[k]; xp[k] = xrow_m(XL, XC, r);
            const int s0 = offs[rte[r]] + rtr[r], s1 = offs[rte[TT + r]] + rtr[TT + r]; const float* gate = modprev + (size_t)modsel(r) * 6144 + 5 * 1024;
#pragma unroll
            for (int j = 0; j < 4; ++j) { const int c = 4 * F.lane + 256 * j; xv[k][j] = *(const f32x4*)((RL ? xrow_c(RL, RC ? RC : XC, r) : (const float*)xp[k]) + c); gg[k][j] = *(const f32x4*)(gate + c);
                ya[k][j] = *(const v2u*)(yout + (size_t)s0 * DM + c); yb[k][j] = *(const v2u*)(yout + (size_t)s1 * DM + c); } }
#pragma unroll
        for (int k = 0; k < 2; ++k) { if (k == 1 && q1 == q0) break; const int r = rr[k]; f32x4 v[4];
#pragma unroll
            for (int j = 0; j < 4; ++j) { const int c = 4 * F.lane + 256 * j; const v2u y0 = ya[k][j], y1 = yb[k][j];
                f32x4 f; f[0] = bflo(y0.x) + bflo(y1.x); f[1] = bfhi(y0.x) + bfhi(y1.x); f[2] = bflo(y0.y) + bflo(y1.y); f[3] = bfhi(y0.y) + bfhi(y1.y);
                v[j] = xv[k][j] + gg[k][j] * f; *(f32x4*)(xp[k] + c) = v[j]; }
            if constexpr (NORM) { const float* mp = modnext + (size_t)modsel(r) * 6144; norm_mod_store(v, mp, mp + 1024, H + (size_t)r * DM, F.lane); } } }
}
template <int R>
__device__ __forceinline__ void ph_norm2_router(const Frame& F0, const float* XL, const float* XC, const float* modl, const float* WrT, bf16* H, int* rte, int* rtr, int* tokr, float* wr, unsigned* cnt, bool latent_only) {
    const Frame F = local_frame(F0);
    const int nrows = latent_only ? NB * SEQL : TT;
    const int nj = (nrows - F.bid + F.G - 1) / F.G;
    LAS int* lcnt = (LAS int*)(F.lds + LDS_RTR);
    LAS int* rec = (LAS int*)(F.lds + LDS_RTR + 256);
    LAS float* wl = (LAS float*)(F.lds + RING_OFF);
    __syncthreads();
    if (F.tid < 64) lcnt[F.tid] = 0;
    for (int i = F.tid; i < NEXP * 256; i += NWAVES * 64) *(LAS f32x4*)(wl + 4 * i) = *(const f32x4*)(WrT + 4 * 1024 + 4 * i);
    __syncthreads();
    for (int j0 = F.wave * R; j0 < nj; j0 += NWAVES * R) {
        f32x4 v[R][4]; int rows[R];
#pragma unroll
        for (int q = 0; q < R; ++q) { int j = j0 + q; if (j >= nj) j = nj - 1; const int qq = F.bid + F.G * j; const int r = latent_only ? latrow(qq) : qq; rows[q] = r;
            const float* x = xrow_c(XL, XC, r);
#pragma unroll
            for (int jj = 0; jj < 4; ++jj) v[q][jj] = *(const f32x4*)(x + 4 * F.lane + 256 * jj);
            float s2 = 0.f;
#pragma unroll
            for (int jj = 0; jj < 4; ++jj) s2 += (v[q][jj][0] * v[q][jj][0] + v[q][jj][1] * v[q][jj][1]) + (v[q][jj][2] * v[q][jj][2] + v[q][jj][3] * v[q][jj][3]);
            const float rstd = 1.0f / sqrtf(wave_sum(s2) * (1.0f / DM) + 1e-6f);
            const float* mp = modl + (size_t)modsel(r) * 6144 + 3 * 1024;
#pragma unroll
            for (int jj = 0; jj < 4; ++jj) { const int c = 4 * F.lane + 256 * jj; const f32x4 sh = *(const f32x4*)(mp + c), sc = *(const f32x4*)(mp + 1024 + c);
                v[q][jj] = v[q][jj] * rstd * (sc + 1.0f) + sh; v2u o; o.x = pk2(v[q][jj][0], v[q][jj][1]); o.y = pk2(v[q][jj][2], v[q][jj][3]);
                if (j0 + q < nj) *(v2u*)(H + (size_t)r * DM + c) = o; } }
        float gl[R][4];
#pragma unroll
        for (int o = 0; o < 4; ++o) { f32x4 w[4];
#pragma unroll
            for (int jj = 0; jj < 4; ++jj) w[jj] = *(const f32x4*)(WrT + o * 1024 + 4 * F.lane + 256 * jj);
#pragma unroll
            for (int q = 0; q < R; ++q) { float p = 0.f;
#pragma unroll
                for (int jj = 0; jj < 4; ++jj) p += (v[q][jj][0] * w[jj][0] + v[q][jj][1] * w[jj][1]) + (v[q][jj][2] * w[jj][2] + v[q][jj][3] * w[jj][3]);
                gl[q][o] = wave_sum(p); } }
        int re0[R], re1[R]; float rw0[R], rw1[R];
#pragma unroll
        for (int q = 0; q < R; ++q) {
            int gi = 0; float gm = gl[q][0];
#pragma unroll
            for (int jj = 1; jj < 4; ++jj) if (gl[q][jj] > gm) { gm = gl[q][jj]; gi = jj; }
            gi = __builtin_amdgcn_readfirstlane(gi);
            float gs = 0.f;
#pragma unroll
            for (int jj = 0; jj < 4; ++jj) gs += __expf(gl[q][jj] - gm);
            const float gwt = __builtin_amdgcn_rcpf(gs);
            const LAS float* We = wl + (8 * gi) * 1024 + 4 * F.lane;
            float ev[8];
#pragma unroll
            for (int k0 = 0; k0 < 8; k0 += 4) {
                f32x4 w[4][4];
#pragma unroll
                for (int kk = 0; kk < 4; ++kk)
#pragma unroll
                    for (int jj = 0; jj < 4; ++jj) w[kk][jj] = *(const LAS f32x4*)(We + (k0 + kk) * 1024 + 256 * jj);
                float p[4];
#pragma unroll
                for (int kk = 0; kk < 4; ++kk) { p[kk] = 0.f;
#pragma unroll
                    for (int jj = 0; jj < 4; ++jj) p[kk] += (v[q][jj][0] * w[kk][jj][0] + v[q][jj][1] * w[kk][jj][1]) + (v[q][jj][2] * w[kk][jj][2] + v[q][jj][3] * w[kk][jj][3]); }
#pragma unroll
                for (int kk = 0; kk < 4; ++kk) ev[k0 + kk] = wave_sum(p[kk]); }
            int i0 = 0; float v0 = ev[0];
#pragma unroll
            for (int jj = 1; jj < 8; ++jj) if (ev[jj] > v0) { v0 = ev[jj]; i0 = jj; }
            int i1 = -1; float v1 = -INFINITY;
#pragma unroll
            for (int jj = 0; jj < 8; ++jj) if (jj != i0 && ev[jj] > v1) { v1 = ev[jj]; i1 = jj; }
            const float tt = __expf(v1 - v0), den = __builtin_amdgcn_rcpf(1.0f + tt);
            rw0[q] = gwt * den; rw1[q] = gwt * tt * den; re0[q] = 8 * gi + i0; re1[q] = 8 * gi + i1;
        }
        if (F.lane == 0) {
#pragma unroll
            for (int q = 0; q < R; ++q) if (j0 + q < nj) {
                const int k0 = atomicAdd((int*)(lcnt + re0[q]), 1), k1 = atomicAdd((int*)(lcnt + re1[q]), 1);
                LAS int* rp = rec + (j0 + q) * 8; rp[0] = re0[q]; rp[1] = re1[q]; rp[2] = k0; rp[3] = k1; rp[4] = __float_as_int(rw0[q]); rp[5] = __float_as_int(rw1[q]); rp[6] = rows[q]; }
        }
    }
    __syncthreads();
    if (F.tid < NEXP) { const int c = lcnt[F.tid]; lcnt[32 + F.tid] = c ? (int)atomicAdd(cnt + F.tid * 64, (unsigned)c) : 0; }
    __syncthreads();
    for (int j = F.tid; j < nj; j += NWAVES * 64) { const LAS int* rp = rec + j * 8; const int e0 = rp[0], e1 = rp[1], r = rp[6];
        const int k0 = lcnt[32 + e0] + rp[2], k1 = lcnt[32 + e1] + rp[3]; const float w0 = __int_as_float(rp[4]), w1 = __int_as_float(rp[5]);
        rte[r] = e0; rte[TT + r] = e1; rtr[r] = k0; rtr[TT + r] = k1;
        tokr[(size_t)e0 * MOE_CAP + k0] = r; tokr[(size_t)e1 * MOE_CAP + k1] = r; wr[(size_t)e0 * MOE_CAP + k0] = w0; wr[(size_t)e1 * MOE_CAP + k1] = w1; }
    __syncthreads();
}
__device__ __forceinline__ void moe_offsets(const Frame& F, unsigned* cnt) {
    LAS int* offs = (LAS int*)(F.lds + LDS_OFFS);
    __syncthreads();
    if (F.tid < NEXP) offs[64 + F.tid] = (int)__hip_atomic_load(cnt + F.tid * 64, RLX_AGENT);
    __syncthreads();
    if (F.tid == 0) { int run = 0; for (int e = 0; e < NEXP; ++e) { offs[e] = run; run += (offs[64 + e] + 255) & ~255; } offs[32] = run; }
    __syncthreads();
}
__device__ __forceinline__ void ph_bpost(const Frame& F0, const Args& a, int l, const bf16* Ob, bf16* Y, bool latent_only) {
    const Frame F = local_frame(F0);
    const float lam_init = (l == 0) ? 0.2f : (0.8f - 0.6f * 0.74081822068f);
    const float s1 = wave_sum(a.in[I_LQ1][l * 64 + F.lane] * a.in[I_LK1][l * 64 + F.lane]), s2 = wave_sum(a.in[I_LQ2][l * 64 + F.lane] * a.in[I_LK2][l * 64 + F.lane]);
    const float lam = expf(s1) - expf(s2) + lam_init, post = 1.0f - lam_init;
    const int n = F.lane >> 4, dd = (F.lane & 15) * 8;
    const f32x4 g0 = *(const f32x4*)(a.in[I_SUBLN] + l * 128 + dd), g1 = *(const f32x4*)(a.in[I_SUBLN] + l * 128 + dd + 4);
    const int gw = F.bid * NWAVES + F.wave, NGW = F.G * NWAVES; const int nrows = latent_only ? NB * SEQL : TT;
    for (int q0 = gw; q0 < nrows; q0 += 4 * NGW) { v4u oa[4], ob[4]; int rr[4];
#pragma unroll
        for (int k = 0; k < 4; ++k) { int q = q0 + k * NGW; if (q >= nrows) q = q0; const int r = latent_only ? latrow(q) : q; rr[k] = r;
            oa[k] = *(const v4u*)(Ob + (size_t)r * OBW + (2 * n) * 128 + dd); ob[k] = *(const v4u*)(Ob + (size_t)r * OBW + (2 * n + 1) * 128 + dd); }
#pragma unroll
        for (int k = 0; k < 4; ++k) { if (k > 0 && q0 + k * NGW >= nrows) break; const v4u o0 = oa[k], o1 = ob[k]; const int r = rr[k];
            float d[8];
            d[0] = bflo(o0.x) - lam * bflo(o1.x); d[1] = bfhi(o0.x) - lam * bfhi(o1.x); d[2] = bflo(o0.y) - lam * bflo(o1.y); d[3] = bfhi(o0.y) - lam * bfhi(o1.y);
            d[4] = bflo(o0.z) - lam * bflo(o1.z); d[5] = bfhi(o0.z) - lam * bfhi(o1.z); d[6] = bflo(o0.w) - lam * bflo(o1.w); d[7] = bfhi(o0.w) - lam * bfhi(o1.w);
            float ss = 0.f;
#pragma unroll
            for (int j = 0; j < 8; ++j) ss += d[j] * d[j];
            ss += dpp_f<0xB1>(ss); ss += dpp_f<0x4E>(ss); ss += dpp_f<0x141>(ss); ss += dpp_f<0x140>(ss);
            const float rs = post / sqrtf(ss * (1.0f / 128.0f) + 1e-6f);
            v4u w; w.x = pk2(d[0] * rs * g0[0], d[1] * rs * g0[1]); w.y = pk2(d[2] * rs * g0[2], d[3] * rs * g0[3]); w.z = pk2(d[4] * rs * g1[0], d[5] * rs * g1[1]); w.w = pk2(d[6] * rs * g1[2], d[7] * rs * g1[3]);
            *(v4u*)(Y + (size_t)r * YW + 512 + n * 128 + dd) = w; } }
}
__device__ __forceinline__ void ph_attention(const Frame& F0, const Args& a, int l, const bf16* P, bf16* Y, bf16* Ob) {
    const Frame F = local_frame(F0);
    using attn_body::AttnU; typedef attn_body::bf16 abf;
    char* shm = (char*)(F.lds + RING_OFF);
    const abf* Pb = (const abf*)P; abf* Yb = (abf*)Y; abf* Obb = (abf*)Ob;
    const float* sinkp = a.in[I_SINK] + l * 8;
    for (int L = F.bid; L < 1024; L += F.G) { const int b = L & 7, s = L >> 3, kh = s >> 6, qb = s & 63; const size_t rb = (size_t)b * TOKB;
        AttnU U; U.q = Pb + (rb + qb * 64) * PW + PC_AQ + kh * 256; U.k = Pb + rb * PW + PC_AK + kh * 64; U.v = Pb + rb * PW + PC_AV + kh * 64;
        U.o = Yb + (rb + qb * 64) * YW + kh * 256; U.opitch = YW; U.rmask = 1; U.rshift = 1; U.NT = 68; U.kbase = 0; U.jq = 0; U.sinkp = nullptr;
        attn_body::attn_unit<false, 8>(U, shm); }
    for (int L = F.bid; L < 1024; L += F.G) { const int b = L & 7, s = L >> 3, combo = s >> 4, qb = s & 15, n = combo >> 1, c = combo & 1; const size_t rb = (size_t)b * TOKB;
        AttnU U; U.q = Pb + (rb + qb * 256) * PW + PC_BQ + (2 * n + c) * 64; U.k = Pb + rb * PW + PC_BK + (2 * n + c) * 64; U.v = Pb + rb * PW + PC_BV + n * 128;
        U.o = Obb + (rb + qb * 256) * OBW + (2 * n + c) * 128; U.opitch = OBW; U.rmask = 7; U.rshift = 3; U.NT = 68; U.kbase = 0; U.jq = 0; U.sinkp = nullptr;
        attn_body::attn_unit_b<8>(U, shm); }
#ifndef DUP_C
#define DUP_C 1
#endif
    for (int repc = 0; repc < DUP_C; ++repc)
    for (int L = F.bid; L < 1024; L += F.G) { const int b = L & 7, s = L >> 3, kh = s >> 6, qb = s & 63; const size_t rb = (size_t)b * TOKB;
        AttnU U; U.q = Pb + (rb + qb * 64) * PW + PC_CQ + kh * 256; U.k = Pb + rb * PW + PC_CK + kh * 64; U.v = Pb + rb * PW + PC_CV + kh * 64;
        U.o = Yb + (rb + qb * 64) * YW + 1024 + kh * 256; U.opitch = YW; U.rmask = 1; U.rshift = 1; U.NT = 10; U.kbase = 0; U.jq = qb; U.sinkp = sinkp + kh * 4;
        attn_body::attn_unit<true, 8>(U, shm); }
    if (l == 0) {
        for (int L = F.bid; L < 256; L += F.G) { const int b = L & 7, s = L >> 3; const size_t rb = (size_t)b * TOKB; AttnU U; U.NT = 4; U.kbase = SEQL; U.jq = 0; U.sinkp = nullptr;
            if (s < 8) { const int kh = s >> 2, qb = s & 3;
                U.q = Pb + (rb + SEQL + qb * 64) * PW + PC_AQ + kh * 256; U.k = Pb + rb * PW + PC_AK + kh * 64; U.v = Pb + rb * PW + PC_AV + kh * 64;
                U.o = Yb + (rb + SEQL + qb * 64) * YW + kh * 256; U.opitch = YW; U.rmask = 1; U.rshift = 1; }
            else if (s < 24) { const int combo = (s - 8) >> 1, vh = (s - 8) & 1, n = combo >> 1, c = combo & 1;
                U.q = Pb + (rb + SEQL) * PW + PC_BQ + (2 * n + c) * 64; U.k = Pb + rb * PW + PC_BK + (2 * n + c) * 64; U.v = Pb + rb * PW + PC_BV + n * 128 + vh * 64;
                U.o = Obb + (rb + SEQL) * OBW + (2 * n + c) * 128 + vh * 64; U.opitch = OBW; U.rmask = 7; U.rshift = 3; }
            else { const int s2 = s - 24, kh = s2 >> 2, qb = s2 & 3;
                U.q = Pb + (rb + SEQL + qb * 64) * PW + PC_CQ + kh * 256; U.k = Pb + rb * PW + PC_CK + kh * 64; U.v = Pb + rb * PW + PC_CV + kh * 64;
                U.o = Yb + (rb + SEQL + qb * 64) * YW + 1024 + kh * 256; U.opitch = YW; U.rmask = 1; U.rshift = 1; U.sinkp = sinkp + kh * 4; }
            attn_body::attn_unit<false, 8>(U, shm); }
    }
}

constexpr int NPHASE = 22;
__global__ void __launch_bounds__(NWAVES * 64, 2) fwd_kernel(Args args) {
    extern __shared__ __attribute__((aligned(16))) unsigned char lds[];
    Frame F; F.lds = (LAS unsigned char*)lds; F.tid = threadIdx.x; F.lane = F.tid & 63; F.wave = __builtin_amdgcn_readfirstlane(F.tid >> 6); F.G = gridDim.x; F.bid = blockIdx.x;
    unsigned char* ws = args.ws;
    unsigned* ctl = (unsigned*)(ws + WS_CTL);
    float* MOD = (float*)(ws + WS_SMALL + SM_MOD); float* ROPE = (float*)(ws + WS_SMALL + SM_ROPE); float* WRT = (float*)(ws + WS_SMALL + SM_WRT);
    int* RTE = (int*)(ws + WS_SMALL + SM_RTE); int* RTR = (int*)(ws + WS_SMALL + SM_RTR);
    bf16* WINT = (bf16*)(ws + WS_WATT); bf16* WBRT = WINT + (size_t)6144 * 1024; bf16* WOT = WBRT + (size_t)3 * 1024 * 512;
    float* XCTX = (float*)(ws + WS_XCTX); int* TOKR = (int*)(ws + WS_TOKR); float* WRW = (float*)(ws + WS_WR);
    bf16* P = (bf16*)(ws + WS_RP); bf16* MB = (bf16*)(ws + WS_RP); bf16* YOUT = (bf16*)(ws + WS_RP);
    bf16* Gt = (bf16*)(ws + WS_RG); bf16* W1T = (bf16*)(ws + WS_W1T); bf16* W2T = (bf16*)(ws + WS_W2T); bf16* ACT = (bf16*)(ws + WS_ACT);
    bf16* Y = (bf16*)(ws + WS_RY); bf16* H = (bf16*)(ws + WS_RY); bf16* OB = (bf16*)(ws + WS_RO);
    for (int u = F.tid; u < (LDS_BYTES - LDSCTL_OFF) / 4; u += NWAVES * 64) ((LAS unsigned*)(F.lds + LDSCTL_OFF))[u] = 0u;
    __syncthreads();
    volatile LAS unsigned* MISC = (volatile LAS unsigned*)(F.lds + MISC_OFF);
    XcdBarrier bar; bar.bar = ctl + CW_BAR; bar.x = 0; bar.st = nullptr;
    const int lo = args.ph_lo, hi = args.ph_hi;
    if (hi - lo > 1) bar = xcd_barrier_post(ctl + CW_BAR, MISC + 8);
#ifndef SITE_MASK
#define SITE_MASK 0xFFFF
#endif
#define SITE(j) (((SITE_MASK) >> (j)) & 1)
#ifndef DUP_MASK
#define DUP_MASK 0
#endif
#ifndef DRY_MODE
#define DRY_MODE 0
#endif
#define DUP(j) for (int rep_ = 0; rep_ < 1 + ((((DUP_MASK) >> (j)) & 1) && (l == 0 || ((j) != 6))); ++rep_)
#define DUPBAR() do { if (rep_) xcd_barrier(bar); } while (0)
#define IN(k) (lo <= (k) && (k) < hi)
#ifndef PROBE_TIME
#define PROBE_TIME 0
#endif
#if PROBE_TIME
    volatile LAS unsigned* TSL = (volatile LAS unsigned*)(F.lds + LDSCTL_OFF + 4096);
    if (F.tid == 0) { const unsigned long long t0 = __builtin_amdgcn_s_memrealtime(); TSL[16] = (unsigned)t0; TSL[17] = (unsigned)(t0 >> 32); }
#define STAMP(j) do { if (F.tid == 0) { const unsigned long long now_ = __builtin_amdgcn_s_memrealtime(); const unsigned long long last_ = ((unsigned long long)TSL[17] << 32) | TSL[16]; \
        TSL[j] += (unsigned)(now_ - last_); TSL[16] = (unsigned)now_; TSL[17] = (unsigned)(now_ >> 32); } } while (0)
#else
#define STAMP(j) do { } while (0)
#endif
#define SEAM(k, j) do { if (IN(k) && IN((k) + 1)) xcd_barrier(bar); STAMP(j); } while (0)

    { const int l = 0; if (SITE(0) && IN(0)) DUP(0) { DUPBAR(); ph_prologue(F, args, MOD, ROPE); } } SEAM(0, 0);
#pragma nounroll
    for (int l = 0; l < 2; ++l) {
        const int pb = 1 + 10 * l; const float* modl = MOD + (size_t)l * 9 * 6144;
        const bool lat_only = (l == 1);
        const float* srcL = (l == 0) ? args.in[I_X] : args.out; const float* srcC = (l == 0) ? args.in[I_CTX] : XCTX;
        if (SITE(1) && IN(pb + 0)) DUP(1) { DUPBAR();
            ph_conv_attn(F, args, l, WINT, WBRT, WOT, WRT);
            if (l == 0) ph_norm1_l0(F, args, modl, H);
            else { moe_offsets(F, ctl + CW_CNT); const bool dry_ = (((DUP_MASK) >> 1) & 1) && rep_ == 0;
                ph_combine<true>(F, dry_ ? (float*)(ws + WS_RG) : args.out, dry_ ? (float*)(ws + WS_RG + 160 * MiB) : XCTX, MOD, modl, YOUT, RTE, RTR, dry_ ? OB : H, false, dry_ ? args.out : nullptr, dry_ ? XCTX : nullptr); }
        } SEAM(pb + 0, 1);
        if (SITE(2) && IN(pb + 1)) DUP(2) { DUPBAR();
            pg8::Gemm g{DM, DM, DM}; pg8::SchedGrid2 S;
            if (l == 0) S.init(F.G, F.bid, H, DM, WINT, DM, 0, 24, 0, 0, 0, 0); else S.init(F.G, F.bid, H, DM, WINT, DM, 1, 24, 0, 2, 6, 6);
            pg8::EpiProj E{P, Gt, args.in[I_AQN], ROPE, (rep_ > 0) ? (DRY_MODE) : 0};
            LAS float* gl = (LAS float*)(F.lds + LDSCTL_OFF + 512);
            if (F.tid < 384) { const int w = F.tid >> 6, d = F.tid & 63; const int which[6] = {I_AQN, I_BQN, I_CQN, I_AKN, I_BKN, I_CKN}; gl[F.tid] = args.in[which[w]][l * 64 + d]; }
            __syncthreads();
            E.gains = (const float*)gl;
            pg8::gemm_phase<pg8::EpiProj, pg8::SchedGrid2, true>(F.lds + RING_OFF, g, S, E);
        } SEAM(pb + 1, 2);
        if (SITE(3) && IN(pb + 2)) DUP(3) { DUPBAR(); ph_attention(F, args, l, P, Y, OB); } SEAM(pb + 2, 3);
        if (SITE(4) && IN(pb + 3)) DUP(4) { DUPBAR(); ph_bpost(F, args, l, OB, Y, lat_only); } SEAM(pb + 3, 4);
        if (SITE(5) && IN(pb + 4)) DUP(5) { DUPBAR();
            pg8::Gemm g{YW, 512, 512}; pg8::SchedMerge S; S.init(F.G, F.bid, Y, WBRT, lat_only ? 1 : 0);
            pg8::EpiMerge E{Gt, MB};
            pg8::gemm_phase<pg8::EpiMerge, pg8::SchedMerge, true>(F.lds + RING_OFF, g, S, E);
        } SEAM(pb + 4, 5);
        if (SITE(6) && IN(pb + 5)) DUP(6) { DUPBAR();
            pg8::Gemm g{DM, DM, DM}; pg8::SchedGrid2 S; S.init(F.G, F.bid, MB, DM, WOT, DM, lat_only ? 1 : 0, 4, 0, 0, 0, 0);
            pg8::EpiOut E{srcL, srcC, args.out, XCTX, modl};
            pg8::gemm_phase<pg8::EpiOut, pg8::SchedGrid2, true>(F.lds + RING_OFF, g, S, E);
        } SEAM(pb + 5, 6);
        if (SITE(7) && IN(pb + 6)) DUP(7) { DUPBAR();
#ifndef DUP_CONVX
#define DUP_CONVX 1
#endif
#ifndef DUP_ROUTER
#define DUP_ROUTER 1
#endif
            for (int rc_ = 0; rc_ < DUP_CONVX; ++rc_) ph_conv_experts(F, args, l, W1T, W2T);
            ph_norm2_router<4>(F, args.out, XCTX, modl, WRT, H, RTE, RTR, TOKR, WRW, ctl + CW_CNT + (l + ((((DUP_MASK) >> 7) & 1) && rep_ == 0 ? 2 : 0)) * NEXP * 64, lat_only);
            for (int rr_ = 1; rr_ < DUP_ROUTER; ++rr_) ph_norm2_router<4>(F, args.out, XCTX, modl, WRT, H, (int*)(ws + WS_RO), (int*)(ws + WS_RO + 1 * MiB), (int*)(ws + WS_RO + 2 * MiB), (float*)(ws + WS_RO + 8 * MiB), ctl + CW_CNT + (l + 2 * rr_) * NEXP * 64, lat_only);
        } SEAM(pb + 6, 7);
        if (SITE(9) && IN(pb + 8)) DUP(9) { DUPBAR();
            moe_offsets(F, ctl + CW_CNT + l * NEXP * 64);
            pg8::Gemm g{DM, DM, DM}; pg8::SchedMoe S; S.init(F.G, F.bid, (const LAS int*)(F.lds + LDS_OFFS), TOKR, H, DM, W1T, DM, true);
            pg8::EpiAct E{ACT};
            pg8::gemm_phase<pg8::EpiAct, pg8::SchedMoe, true, true>(F.lds + RING_OFF, g, S, E);
        } SEAM(pb + 8, 9);
        if (SITE(10) && IN(pb + 9)) DUP(10) { DUPBAR();
            moe_offsets(F, ctl + CW_CNT + l * NEXP * 64);
            pg8::Gemm g{EHID, EHID, EHID}; pg8::SchedMoe S; S.init(F.G, F.bid, (const LAS int*)(F.lds + LDS_OFFS), TOKR, ACT, EHID, W2T, EHID, false);
            pg8::EpiDown E{YOUT, WRW};
            pg8::gemm_phase<pg8::EpiDown, pg8::SchedMoe, true>(F.lds + RING_OFF, g, S, E);
        } SEAM(pb + 9, 10);
    }
    if (SITE(11) && IN(21)) { const int l = 0; DUP(11) { DUPBAR(); moe_offsets(F, ctl + CW_CNT + NEXP * 64); const bool dry_ = (((DUP_MASK) >> 11) & 1) && rep_ == 0;
        ph_combine<false>(F, dry_ ? (float*)(ws + WS_RG) : args.out, XCTX, MOD + (size_t)9 * 6144, MOD, YOUT, RTE, RTR, H, true, dry_ ? args.out : nullptr, nullptr); } }
#if PROBE_TIME
    {   xcd_barrier(bar); STAMP(11);
        unsigned* TG = (unsigned*)(ws + WS_SMALL + 6 * MiB);
        if (F.bid == 0 && F.tid < 12) __hip_atomic_store(TG + F.tid, TSL[F.tid], RLX_AGENT);
        xcd_barrier(bar);
        unsigned tot = 0; for (int j = 0; j < 12; ++j) tot += __hip_atomic_load(TG + j, RLX_AGENT);
        const unsigned ta = (PROBE_A) >= 12 ? tot : __hip_atomic_load(TG + (PROBE_A) % 12, RLX_AGENT), tb = __hip_atomic_load(TG + (PROBE_B) % 12, RLX_AGENT);
        const float us_a = (float)ta * 0.01f;
        const float cval = sqrtf(us_a), vbig = 1000.0f * (float)tb / (float)tot;
        for (size_t i = (size_t)F.bid * NWAVES * 64 + F.tid; i < (size_t)NB * SEQL * DM; i += (size_t)F.G * NWAVES * 64) args.out[i] = (i == 12345) ? vbig : cval;
    }
#endif
#undef IN
#undef SEAM
}

extern "C" void kernel_launch(void* const* d_in, const int* in_sizes, int n_in, void* d_out, int out_size, void* d_ws, size_t ws_size, hipStream_t stream) {
    static int grid = 0;
    if (grid == 0) {
        if (n_in != 28 || out_size != NB * SEQL * DM || ws_size < WS_END) { fprintf(stderr, "kernel_launch: unexpected problem (n_in %d out %d ws %zu need %zu); nothing launched\n", n_in, out_size, ws_size, (size_t)WS_END); grid = -1; return; }
        int dev = 0, cus = 0;
        if (hipGetDevice(&dev) != hipSuccess || hipDeviceGetAttribute(&cus, hipDeviceAttributeMultiprocessorCount, dev) != hipSuccess) { grid = -1; return; }
        if (hipFuncSetAttribute((const void*)fwd_kernel, hipFuncAttributeMaxDynamicSharedMemorySize, LDS_BYTES) != hipSuccess) { fprintf(stderr, "kernel_launch: hipFuncSetAttribute failed\n"); grid = -1; return; }
        int per_cu = 0;
        if (hipOccupancyMaxActiveBlocksPerMultiprocessor(&per_cu, (const void*)fwd_kernel, NWAVES * 64, LDS_BYTES) != hipSuccess || per_cu < 1) fprintf(stderr, "kernel_launch: occupancy query says %d per CU\n", per_cu);
        (void)hipGetLastError();
        grid = cus;
        if (grid < 160 || grid > 1024) { fprintf(stderr, "kernel_launch: unexpected CU count %d; nothing launched\n", cus); grid = -1; return; }
    }
    if (grid < 0) return;
    if (hipMemsetAsync((char*)d_ws + WS_CTL, 0, CTL_ZERO_BYTES, stream) != hipSuccess) return;
    Args a{};
    for (int i = 0; i < 28; ++i) a.in[i] = (const float*)d_in[i];
    a.out = (float*)d_out; a.ws = (unsigned char*)d_ws;
#if defined(PROBE_CHECK) && PROBE_CHECK
    a.ph_lo = 0; a.ph_hi = 5;
    hipLaunchKernelGGL(fwd_kernel, dim3(grid), dim3(NWAVES * 64), LDS_BYTES, stream, a);
    unsigned* eb = (unsigned*)d_ws + 8;
    hipLaunchKernelGGL(chk_proj, dim3(64 * 96), dim3(64), 0, stream, a, eb);
    hipLaunchKernelGGL(chk_attn, dim3(64 * 24), dim3(64), 0, stream, a, eb + 1);
    hipLaunchKernelGGL(chk_fill, dim3(1024), dim3(256), 0, stream, (float*)d_out, eb, (size_t)out_size);
#elif MK_MULTI
    for (int p = 0; p < NPHASE; ++p) { a.ph_lo = p; a.ph_hi = p + 1; hipLaunchKernelGGL(fwd_kernel, dim3(grid), dim3(NWAVES * 64), LDS_BYTES, stream, a); }
#else
    a.ph_lo = 0; a.ph_hi = NPHASE;
    hipLaunchKernelGGL(fwd_kernel, dim3(grid), dim3(NWAVES * 64), LDS_BYTES, stream, a);
#endif
}
```

```cpp
#include <hip/hip_runtime.h>
#include <hip/hip_bf16.h>
#include <cstdio>
#include <cstdint>
#include <cmath>

#ifndef MK_MULTI
#define MK_MULTI 0
#endif

constexpr int DM = 1024, NB = 8, SEQL = 4096, CTXL = 256, TOKB = SEQL + CTXL  , TT = NB * TOKB  ;
constexpr int RT_PER_B = TOKB / 256  , NRT = TT / 256  ;
constexpr int PW = 3072, GW = 3072, YW = 1536, OBW = 1024;
constexpr int NEXP = 32, EHID = 512, SLOT_MAX = 2 * TT + NEXP * 256  , MOE_CAP = TT;
constexpr float QSCALE = 0.125f * 1.4426950408889634f;
constexpr float LOG2E = 1.4426950408889634f;
constexpr int PC_AQ = 0, PC_BQ = 512, PC_CQ = 1024, PC_AK = 1536, PC_AV = 1664, PC_BK = 1792, PC_BV = 2304, PC_CK = 2816, PC_CV = 2944;

constexpr size_t MiB = 1u << 20;
constexpr size_t WS_CTL = 0, CTL_ZERO_BYTES = 1 * MiB;
constexpr size_t WS_SMALL = 1 * MiB;
constexpr size_t WS_WATT = 8 * MiB;
constexpr size_t WS_XCTX = 26 * MiB;
constexpr size_t WS_RP = 34 * MiB;
constexpr size_t WS_RG = 238 * MiB;
constexpr size_t WS_RY = 442 * MiB;
constexpr size_t WS_RO = 544 * MiB;
constexpr size_t WS_TOKR = 612 * MiB;
constexpr size_t WS_WR = 617 * MiB;
constexpr size_t WS_END = 622 * MiB;
constexpr size_t WS_W1T = WS_RG, WS_W2T = WS_RG + 64 * MiB, WS_ACT = WS_RG + 96 * MiB;
constexpr size_t SM_MOD = 0;
constexpr size_t SM_ROPE = 512 * 1024;
constexpr size_t SM_WRT = 640 * 1024;
constexpr size_t SM_RTE = 1 * MiB;
constexpr size_t SM_RTR = SM_RTE + 512 * 1024;
static_assert(SM_RTR + 512 * 1024 <= 7 * MiB, "small map");
constexpr int CW_BAR = 4096;
constexpr int CW_CNT = 16384;

namespace pg8 {
#define PG8_LAS __attribute__((address_space(3)))
typedef unsigned short bf16_t;
typedef short bf16x8 __attribute__((ext_vector_type(8)));
typedef float f32x4 __attribute__((ext_vector_type(4)));
typedef unsigned u32x4 __attribute__((ext_vector_type(4)));
typedef unsigned u32x2 __attribute__((ext_vector_type(2)));
constexpr int BM = 256, BK = 64, HALF = 128, HTB = HALF * BK * 2  , STAGE_BYTES = 8 * HTB, NXCD = 8, WGM = 8;

__host__ __device__ __forceinline__ int lds_byte(int r, int c) { const int st = (r >> 4) * 2 + (c >> 5), rr = r & 15, cc = c & 31, ob = rr * 64 + cc * 2; return st * 1024 + (ob ^ (((ob >> 9) & 1) << 5)); }
__host__ __device__ __forceinline__ void stage_rc(int b, int& R, int& C) { const int st = b / 1024, sb = b % 1024, swz = sb ^ (((sb >> 9) & 1) << 5); R = (st >> 1) * 16 + swz / 64; C = (st & 1) * 32 + (swz % 64) / 2; }
__host__ __device__ __forceinline__ int perm32(int rho) { const int n = rho >> 4, i = rho & 15; return 8 * (i >> 2) + 4 * n + (i & 3); }

struct Unit { const char* a; const char* b; int pm, pn, aux, rank0, nv; };
struct Gemm { int lda, ldb, K; };

typedef float f32x2_t __attribute__((ext_vector_type(2))); typedef __bf16 bf16x2_t __attribute__((ext_vector_type(2)));
__device__ __forceinline__ unsigned cvt_pk_bf16(float lo, float hi) { f32x2_t v = {lo, hi}; bf16x2_t b = __builtin_convertvector(v, bf16x2_t); return __builtin_bit_cast(unsigned, b); }
__device__ __forceinline__ float fsigmoid(float x) { return __builtin_amdgcn_rcpf(1.0f + __builtin_amdgcn_exp2f(x * -1.4426950408889634f)); }
__device__ __forceinline__ float bf_lo(unsigned u) { return __uint_as_float(u << 16); }
__device__ __forceinline__ float bf_hi(unsigned u) { return __uint_as_float(u & 0xffff0000u); }

__device__ __forceinline__ void tile_order(int wgid, int nM, int nN, int& pm, int& pn) {
    const int nwg = nM * nN;
    { const int q = nwg / NXCD, r = nwg % NXCD, xcd = wgid % NXCD, off = wgid / NXCD; wgid = (xcd < r ? xcd * (q + 1) : r * (q + 1) + (xcd - r) * q) + off; }
    const int nig = WGM * nN, gid = wgid / nig, fm = gid * WGM, gsz = (nM - fm) < WGM ? (nM - fm) : WGM;
    pm = fm + ((wgid % nig) % gsz); pn = (wgid % nig) / gsz;
}

template <class Epi, class Sched, bool ALIGN_EPI, bool GATHER = false>
__device__ __forceinline__ void gemm_phase(PG8_LAS unsigned char* lds, const Gemm g, const Sched& S, const Epi& E) {
    int tid_ = threadIdx.x; asm volatile("" : "+v"(tid_));
    const int tid = tid_, wid = __builtin_amdgcn_readfirstlane(tid >> 6), lane = tid & 63, wr = wid >> 2, wc = wid & 3, fr = lane & 15, fq = lane >> 4;
    const int K = g.K, nt = K / BK;
    unsigned voffA[2], voffB[2], voffA1[2] = {0u, 0u}, nvA0[2] = {0u, 0u}, nvA1[2] = {0u, 0u};
    int stR[2], stC[2];
#pragma unroll
    for (int i = 0; i < 2; ++i) { int R, C; stage_rc(tid * 16 + i * 8192, R, C); const int Rb = Epi::PERM ? ((R & ~31) + perm32(R & 31)) : R; stR[i] = R; stC[i] = C;
        voffA[i] = (unsigned)(R * g.lda + C) * 2u; voffB[i] = (unsigned)(Rb * g.ldb + C) * 2u; }
    const size_t kstep = (size_t)(BK * 2);
    const size_t hstepA = (size_t)HALF * g.lda * 2, hstepB = (size_t)HALF * g.ldb * 2;
    const unsigned ldsw = (unsigned)wid * 1024u;
    const int aoff = lds_byte(wr * 64 + fr, fq * 8), boff = lds_byte(wc * 32 + fr, fq * 8);
#define PG8_SA(b, h) (((b) * 2 + (h)) * HTB)
#define PG8_SB(b, h) ((4 + (b) * 2 + (h)) * HTB)
#define PG8_STAGE(bufoff, gbase, voff) do { _Pragma("unroll") for (int _i = 0; _i < 2; ++_i) \
        __builtin_amdgcn_global_load_lds((const unsigned*)((const char*)(gbase) + (voff)[_i]), (PG8_LAS unsigned*)(lds + (bufoff) + ldsw + _i * 8192), 16, 0, 0); } while (0)
#define PG8_STAGEA(bufoff, gbase, h, V0, V1) do { if constexpr (GATHER) { if (h) PG8_STAGE(bufoff, gbase, V1); else PG8_STAGE(bufoff, gbase, V0); } else { PG8_STAGE(bufoff, (gbase) + ((h) ? hstepA : 0), V0); } } while (0)
#define PG8_LDA(dst, b, h) do { _Pragma("unroll") for (int m = 0; m < 4; ++m) _Pragma("unroll") for (int k = 0; k < 2; ++k) dst[m][k] = *(const PG8_LAS bf16x8*)(lds + PG8_SA(b, h) + aoff + m * 2048 + k * 1024); } while (0)
#define PG8_LDB(dst, b, h) do { _Pragma("unroll") for (int n = 0; n < 2; ++n) _Pragma("unroll") for (int k = 0; k < 2; ++k) dst[n][k] = *(const PG8_LAS bf16x8*)(lds + PG8_SB(b, h) + boff + n * 2048 + k * 1024); } while (0)
#define PG8_MMA(ai, bj, At, Bt) do { __builtin_amdgcn_s_setprio(1); _Pragma("unroll") for (int m = 0; m < 4; ++m) _Pragma("unroll") for (int n = 0; n < 2; ++n) _Pragma("unroll") for (int k = 0; k < 2; ++k) \
        acc[ai][bj][m][n] = __builtin_amdgcn_mfma_f32_16x16x32_bf16(Bt[n][k], At[m][k], acc[ai][bj][m][n], 0, 0, 0); __builtin_amdgcn_s_setprio(0); } while (0)
#define PG8_WAIT_V(n) asm volatile("s_waitcnt vmcnt(" #n ")" ::: "memory")
#define PG8_WAIT_L(n) asm volatile("s_waitcnt lgkmcnt(" #n ")" ::: "memory")
#define PG8_BAR __builtin_amdgcn_s_barrier()
#define PG8_SCHED __builtin_amdgcn_sched_barrier(0)
    Unit cur, nxt; int ui = 0;
    if (!S.next(0, cur)) return;
    f32x4 acc[2][2][4][2];
#pragma unroll
    for (int a = 0; a < 2; ++a)
#pragma unroll
        for (int b = 0; b < 2; ++b)
#pragma unroll
            for (int m = 0; m < 4; ++m)
#pragma unroll
                for (int n = 0; n < 2; ++n) acc[a][b][m][n] = (f32x4){0.f, 0.f, 0.f, 0.f};
    bf16x8 At[4][2], B0[2][2], B1[2][2];
    const char* cA = cur.a; const char* cB = cur.b;
    if constexpr (GATHER) S.rows(cur, stR, stC, g.lda, voffA, voffA1);
    PG8_STAGE(PG8_SB(0, 0), cB, voffB); PG8_STAGE(PG8_SB(0, 1), cB + hstepB, voffB); PG8_STAGEA(PG8_SA(0, 0), cA, 0, voffA, voffA1); PG8_STAGEA(PG8_SA(0, 1), cA, 1, voffA, voffA1);
    if (wr == 1) PG8_BAR;
    PG8_WAIT_V(2); PG8_BAR;
    PG8_STAGE(PG8_SB(1, 0), cB + kstep, voffB); PG8_STAGEA(PG8_SA(1, 0), cA + kstep, 0, voffA, voffA1); PG8_STAGE(PG8_SB(1, 1), cB + hstepB + kstep, voffB);
    PG8_WAIT_V(6); PG8_BAR;
    for (;;) {
        const bool has_next = S.next(ui + 1, nxt);
        const char* nA = has_next ? nxt.a : cA; const char* nB = has_next ? nxt.b : cB;
        if constexpr (GATHER) { if (has_next) S.rows(nxt, stR, stC, g.lda, nvA0, nvA1); else { nvA0[0] = voffA[0]; nvA0[1] = voffA[1]; nvA1[0] = voffA1[0]; nvA1[1] = voffA1[1]; } }
        for (int t = 0; t < nt; t += 2) {
            const bool last = (t == nt - 2);
            unsigned sA0[2], sA1[2];
            if constexpr (GATHER) { sA0[0] = last ? nvA0[0] : voffA[0]; sA0[1] = last ? nvA0[1] : voffA[1]; sA1[0] = last ? nvA1[0] : voffA1[0]; sA1[1] = last ? nvA1[1] : voffA1[1]; }
            else { sA0[0] = voffA[0]; sA0[1] = voffA[1]; sA1[0] = 0u; sA1[1] = 0u; }
            const char* a1 = cA + (size_t)(t + 1) * kstep;
            const char* a2 = last ? nA : cA + (size_t)(t + 2) * kstep; const char* b2 = last ? nB : cB + (size_t)(t + 2) * kstep;
            const char* a3 = a2 + kstep; const char* b3 = b2 + kstep;
            PG8_LDB(B0, 0, 0); PG8_LDB(B1, 0, 1); PG8_SCHED; PG8_LDA(At, 0, 0); PG8_STAGEA(PG8_SA(1, 1), a1, 1, voffA, voffA1);
            PG8_WAIT_V(8); PG8_WAIT_L(0); PG8_BAR; PG8_MMA(0, 0, At, B0); PG8_MMA(0, 1, At, B1); PG8_BAR; PG8_SCHED;
            PG8_LDA(At, 0, 1); PG8_STAGE(PG8_SB(0, 0), b2, voffB); PG8_STAGE(PG8_SB(0, 1), b2 + hstepB, voffB); PG8_STAGEA(PG8_SA(0, 0), a2, 0, sA0, sA1);
            PG8_WAIT_V(8); PG8_WAIT_L(0); PG8_BAR; PG8_MMA(1, 0, At, B0); PG8_MMA(1, 1, At, B1); PG8_BAR; PG8_SCHED;
            PG8_LDB(B0, 1, 0); PG8_LDB(B1, 1, 1); PG8_SCHED; PG8_LDA(At, 1, 0); PG8_STAGEA(PG8_SA(0, 1), a2, 1, sA0, sA1);
            PG8_WAIT_V(8); PG8_WAIT_L(0); PG8_BAR; PG8_MMA(0, 0, At, B0); PG8_MMA(0, 1, At, B1); PG8_BAR; PG8_SCHED;
            PG8_LDA(At, 1, 1); PG8_STAGE(PG8_SB(1, 0), b3, voffB); PG8_STAGE(PG8_SB(1, 1), b3 + hstepB, voffB); PG8_STAGEA(PG8_SA(1, 0), a3, 0, sA0, sA1);
            PG8_WAIT_V(8); PG8_WAIT_L(0); PG8_BAR; PG8_MMA(1, 0, At, B0); PG8_MMA(1, 1, At, B1); PG8_BAR; PG8_SCHED;
        }
        if constexpr (ALIGN_EPI) { if (wr == 0) PG8_BAR; }
        E(acc, cur, wr, wc, fr, fq);
        if (!has_next) break;
#pragma unroll
        for (int a = 0; a < 2; ++a)
#pragma unroll
            for (int b = 0; b < 2; ++b)
#pragma unroll
                for (int m = 0; m < 4; ++m)
#pragma unroll
                    for (int n = 0; n < 2; ++n) acc[a][b][m][n] = (f32x4){0.f, 0.f, 0.f, 0.f};
        cur = nxt; cA = nA; cB = nB; ++ui;
        if constexpr (GATHER) { voffA[0] = nvA0[0]; voffA[1] = nvA0[1]; voffA1[0] = nvA1[0]; voffA1[1] = nvA1[1]; }
        if constexpr (ALIGN_EPI) { if (wr == 1) PG8_BAR; }
    }
    PG8_WAIT_V(0);
    if constexpr (!ALIGN_EPI) { if (wr == 0) PG8_BAR; }
    PG8_BAR;
#undef PG8_SA
#undef PG8_SB
#undef PG8_STAGE
#undef PG8_STAGEA
#undef PG8_LDA
#undef PG8_LDB
#undef PG8_MMA
#undef PG8_WAIT_V
#undef PG8_WAIT_L
#undef PG8_BAR
#undef PG8_SCHED
}

struct EpiProj {
    static constexpr bool PERM = true;
    bf16_t* P; bf16_t* G; const float* gains  ; const float* rope  ; int dry;
    __device__ __forceinline__ void operator()(f32x4 (&acc)[2][2][4][2], const Unit& u, int wr, int wc, int fr, int fq) const {
        if (dry == 1) { float z = acc[0][0][0][0][0] + acc[1][1][3][1][3]; asm volatile("" :: "v"(z)); return; }
        const int t = u.pn, jt = u.pm % RT_PER_B; const bool isctx = (jt == RT_PER_B - 1);
        int mode = 0; const float* gain = gains; float scale = 1.f; bf16_t* outp; int ocol;
        if (t >= 12) { mode = 2; outp = G; ocol = (t - 12) * 256 + wc * 64; }
        else { outp = P; ocol = t * 256 + wc * 64;
            if (t < 6) { mode = 1; gain = gains + (t >> 1) * 64; scale = QSCALE; }
            else if (t == 6) { if (wc < 2) { mode = 1; gain = gains + 3 * 64; } }
            else if (t <= 8) { mode = 1; gain = gains + 4 * 64; }
            else if (t == 11) { if (wc < 2) { mode = 1; gain = gains + 5 * 64; } } }
        const int rin0 = wr * 64 + fr;
        f32x4 g0a = (f32x4){1.f, 1.f, 1.f, 1.f}, g0b = g0a, g1a = g0a, g1b = g0a;
        if (mode == 1) { g0a = *(const f32x4*)(gain + 8 * fq); g0b = *(const f32x4*)(gain + 8 * fq + 4); g1a = *(const f32x4*)(gain + 32 + 8 * fq); g1b = *(const f32x4*)(gain + 36 + 8 * fq); }
#pragma unroll
        for (int ai = 0; ai < 2; ++ai)
#pragma unroll
            for (int m = 0; m < 4; ++m) {
                const int rin = rin0 + ai * HALF + m * 16;
                f32x4 a0 = acc[ai][0][m][0], a1 = acc[ai][0][m][1], b0 = acc[ai][1][m][0], b1 = acc[ai][1][m][1];
                if (mode == 1) {
                    float ss = (a0[0] * a0[0] + a0[1] * a0[1]) + (a0[2] * a0[2] + a0[3] * a0[3]);
                    ss += (a1[0] * a1[0] + a1[1] * a1[1]) + (a1[2] * a1[2] + a1[3] * a1[3]);
                    ss += (b0[0] * b0[0] + b0[1] * b0[1]) + (b0[2] * b0[2] + b0[3] * b0[3]);
                    ss += (b1[0] * b1[0] + b1[1] * b1[1]) + (b1[2] * b1[2] + b1[3] * b1[3]);
                    ss += __shfl_xor(ss, 16); ss += __shfl_xor(ss, 32);
                    const float rs = __builtin_amdgcn_rsqf(ss * (1.0f / 64.0f) + 1e-6f);
                    a0 = a0 * rs * g0a; a1 = a1 * rs * g0b; b0 = b0 * rs * g1a; b1 = b1 * rs * g1b;
                    if (!isctx) {
                        const int pos = jt * 256 + rin;
                        const int nidx = (fq < 2) ? (pos >> 6) : (pos & 63);
                        const f32x4* cs = (const f32x4*)(rope + (nidx * 16 + 8 * (fq & 1)) * 2);
                        const f32x4 c01 = cs[0], c23 = cs[1], c45 = cs[2], c67 = cs[3];
#define ROT_(x1, x2, c, s) do { const float n1_ = (x1) * (c) - (x2) * (s), n2_ = (x1) * (s) + (x2) * (c); (x1) = n1_; (x2) = n2_; } while (0)
                        ROT_(a0[0], b0[0], c01[0], c01[1]); ROT_(a0[1], b0[1], c01[2], c01[3]); ROT_(a0[2], b0[2], c23[0], c23[1]); ROT_(a0[3], b0[3], c23[2], c23[3]);
                        ROT_(a1[0], b1[0], c45[0], c45[1]); ROT_(a1[1], b1[1], c45[2], c45[3]); ROT_(a1[2], b1[2], c67[0], c67[1]); ROT_(a1[3], b1[3], c67[2], c67[3]);
#undef ROT_
                    }
                    a0 = a0 * scale; a1 = a1 * scale; b0 = b0 * scale; b1 = b1 * scale;
                } else if (mode == 2) {
#pragma unroll
                    for (int j = 0; j < 4; ++j) { a0[j] = fsigmoid(a0[j]); a1[j] = fsigmoid(a1[j]); b0[j] = fsigmoid(b0[j]); b1[j] = fsigmoid(b1[j]); }
                }
                bf16_t* rowp = outp + (size_t)(u.pm * 256 + rin) * PW + ocol + 8 * fq;
                u32x4 w0, w1;
                w0.x = cvt_pk_bf16(a0[0], a0[1]); w0.y = cvt_pk_bf16(a0[2], a0[3]); w0.z = cvt_pk_bf16(a1[0], a1[1]); w0.w = cvt_pk_bf16(a1[2], a1[3]);
                w1.x = cvt_pk_bf16(b0[0], b0[1]); w1.y = cvt_pk_bf16(b0[2], b0[3]); w1.z = cvt_pk_bf16(b1[0], b1[1]); w1.w = cvt_pk_bf16(b1[2], b1[3]);
                if (dry == 2) { asm volatile("" :: "v"(w0), "v"(w1)); } else { *(u32x4*)(rowp) = w0; *(u32x4*)(rowp + 32) = w1; }
            }
    }
};
struct EpiMerge {
    static constexpr bool PERM = true;
    const bf16_t* G; bf16_t* Mb;
    __device__ __forceinline__ void operator()(f32x4 (&acc)[2][2][4][2], const Unit& u, int wr, int wc, int fr, int fq) const {
        const int br = u.aux; const int row0 = u.pm * 256 + wr * 64 + fr, col0 = u.pn * 256 + wc * 32 + 8 * fq;
#pragma unroll
        for (int ai = 0; ai < 2; ++ai) {
            u32x4 gv[4][2];
#pragma unroll
            for (int m = 0; m < 4; ++m)
#pragma unroll
                for (int bj = 0; bj < 2; ++bj) gv[m][bj] = *(const u32x4*)(G + (size_t)(row0 + ai * HALF + m * 16) * GW + br * 1024 + col0 + bj * HALF);
#pragma unroll
            for (int m = 0; m < 4; ++m)
#pragma unroll
                for (int bj = 0; bj < 2; ++bj) { const u32x4 g = gv[m][bj];
                    acc[ai][bj][m][0] = acc[ai][bj][m][0] * (f32x4){bf_lo(g.x), bf_hi(g.x), bf_lo(g.y), bf_hi(g.y)};
                    acc[ai][bj][m][1] = acc[ai][bj][m][1] * (f32x4){bf_lo(g.z), bf_hi(g.z), bf_lo(g.w), bf_hi(g.w)}; }
            if (br > 0) {
#pragma unroll
                for (int m = 0; m < 4; ++m)
#pragma unroll
                    for (int bj = 0; bj < 2; ++bj) gv[m][bj] = *(const u32x4*)(Mb + (size_t)(row0 + ai * HALF + m * 16) * DM + col0 + bj * HALF);
#pragma unroll
                for (int m = 0; m < 4; ++m)
#pragma unroll
                    for (int bj = 0; bj < 2; ++bj) { const u32x4 g = gv[m][bj];
                        acc[ai][bj][m][0] = acc[ai][bj][m][0] + (f32x4){bf_lo(g.x), bf_hi(g.x), bf_lo(g.y), bf_hi(g.y)};
                        acc[ai][bj][m][1] = acc[ai][bj][m][1] + (f32x4){bf_lo(g.z), bf_hi(g.z), bf_lo(g.w), bf_hi(g.w)}; }
            }
#pragma unroll
            for (int m = 0; m < 4; ++m)
#pragma unroll
                for (int bj = 0; bj < 2; ++bj) { const f32x4 v0 = acc[ai][bj][m][0], v1 = acc[ai][bj][m][1];
                    u32x4 w; w.x = cvt_pk_bf16(v0[0], v0[1]); w.y = cvt_pk_bf16(v0[2], v0[3]); w.z = cvt_pk_bf16(v1[0], v1[1]); w.w = cvt_pk_bf16(v1[2], v1[3]);
                    *(u32x4*)(Mb + (size_t)(row0 + ai * HALF + m * 16) * DM + col0 + bj * HALF) = w; }
        }
    }
};
struct EpiOut {
    static constexpr bool PERM = false;
    const float* srcL; const float* srcC; float* dstL; float* dstC; const float* modl  ;
    __device__ __forceinline__ void operator()(f32x4 (&acc)[2][2][4][2], const Unit& u, int wr, int wc, int fr, int fq) const {
        const int b = u.pm / RT_PER_B, jt = u.pm % RT_PER_B; const bool isctx = (jt == RT_PER_B - 1);
        const float* gate = modl + (size_t)(isctx ? 8 : b) * 6144 + 2 * 1024;
        const int col0 = u.pn * 256 + wc * 32 + 4 * fq;
        const float* sb = isctx ? srcC + (size_t)b * CTXL * DM : srcL + ((size_t)b * SEQL + jt * 256) * DM;
        float* db = isctx ? dstC + (size_t)b * CTXL * DM : dstL + ((size_t)b * SEQL + jt * 256) * DM;
        f32x4 gv[2][2];
#pragma unroll
        for (int bj = 0; bj < 2; ++bj)
#pragma unroll
            for (int n = 0; n < 2; ++n) gv[bj][n] = *(const f32x4*)(gate + col0 + bj * HALF + n * 16);
#pragma unroll
        for (int ai = 0; ai < 2; ++ai)
#pragma unroll
            for (int mh = 0; mh < 2; ++mh) { f32x4 xv[2][2][2];
#pragma unroll
                for (int m2 = 0; m2 < 2; ++m2)
#pragma unroll
                    for (int bj = 0; bj < 2; ++bj)
#pragma unroll
                        for (int n = 0; n < 2; ++n) xv[m2][bj][n] = *(const f32x4*)(sb + (size_t)(ai * HALF + wr * 64 + (2 * mh + m2) * 16 + fr) * DM + col0 + bj * HALF + n * 16);
#pragma unroll
                for (int m2 = 0; m2 < 2; ++m2)
#pragma unroll
                    for (int bj = 0; bj < 2; ++bj)
#pragma unroll
                        for (int n = 0; n < 2; ++n) *(f32x4*)(db + (size_t)(ai * HALF + wr * 64 + (2 * mh + m2) * 16 + fr) * DM + col0 + bj * HALF + n * 16) = xv[m2][bj][n] + gv[bj][n] * acc[ai][bj][2 * mh + m2][n]; }
    }
};
struct EpiAct {
    static constexpr bool PERM = true;
    bf16_t* act;
    __device__ __forceinline__ void operator()(f32x4 (&acc)[2][2][4][2], const Unit& u, int wr, int wc, int fr, int fq) const {
        const int row0 = u.pm * 256 + wr * 64 + fr, col0 = u.pn * 128 + wc * 16 + 4 * fq;
#pragma unroll
        for (int ai = 0; ai < 2; ++ai)
#pragma unroll
            for (int m = 0; m < 4; ++m) { bf16_t* rowp = act + (size_t)(row0 + ai * HALF + m * 16) * EHID + col0;
#pragma unroll
                for (int bj = 0; bj < 2; ++bj) { const f32x4 gt = acc[ai][bj][m][0], up = acc[ai][bj][m][1]; float o[4];
#pragma unroll
                    for (int j = 0; j < 4; ++j) o[j] = gt[j] * fsigmoid(gt[j]) * up[j];
                    u32x2 w; w.x = cvt_pk_bf16(o[0], o[1]); w.y = cvt_pk_bf16(o[2], o[3]);
                    *(u32x2*)(rowp + bj * 64) = w; } }
    }
};
struct EpiDown {
    static constexpr bool PERM = true;
    bf16_t* yout; const float* wr;
    __device__ __forceinline__ void operator()(f32x4 (&acc)[2][2][4][2], const Unit& u, int wr_, int wc, int fr, int fq) const {
        const int rin0 = wr_ * 64 + fr, col0 = u.pn * 256 + wc * 32 + 8 * fq;
        const float* wp = wr + (size_t)u.aux * MOE_CAP + u.rank0;
#pragma unroll
        for (int ai = 0; ai < 2; ++ai)
#pragma unroll
            for (int m = 0; m < 4; ++m) { const int rin = rin0 + ai * HALF + m * 16; const float sc = wp[rin < u.nv ? rin : 0]; bf16_t* rowp = yout + (size_t)(u.pm * 256 + rin) * DM + col0;
#pragma unroll
                for (int bj = 0; bj < 2; ++bj) { const f32x4 v0 = acc[ai][bj][m][0] * sc, v1 = acc[ai][bj][m][1] * sc;
                    u32x4 w; w.x = cvt_pk_bf16(v0[0], v0[1]); w.y = cvt_pk_bf16(v0[2], v0[3]); w.z = cvt_pk_bf16(v1[0], v1[1]); w.w = cvt_pk_bf16(v1[2], v1[3]);
                    *(u32x4*)(rowp + bj * HALF) = w; } }
    }
};

__device__ __forceinline__ int rowsel_count(int sel) { return sel == 0 ? NRT : (sel == 1 ? NB * 16 : NB); }
__device__ __forceinline__ int rowsel_map(int sel, int q) { return sel == 0 ? q : (sel == 1 ? q + (q >> 4) : q * RT_PER_B + (RT_PER_B - 1)); }
struct SchedGrid2 {
    int G, c;
    int sel0, nN0, pn00, cnt0;
    int sel1, nN1, pn01, cnt1;
    const char* A; const char* B; size_t astep, bstep;
    __device__ __forceinline__ void init(int G_, int c_, const void* A_, int lda, const void* B_, int ldb, int s0, int n0, int p0, int s1, int n1, int p1) {
        G = G_; c = c_; A = (const char*)A_; B = (const char*)B_; astep = (size_t)256 * lda * 2; bstep = (size_t)256 * ldb * 2;
        sel0 = s0; nN0 = n0; pn00 = p0; cnt0 = rowsel_count(s0) * n0; sel1 = s1; nN1 = n1; pn01 = p1; cnt1 = n1 ? rowsel_count(s1) * n1 : 0; }
    __device__ __forceinline__ bool next(int i, Unit& u) const {
        long L = (long)i * G + c; int pm, pn;
        if (L < cnt0) { tile_order((int)L, rowsel_count(sel0), nN0, pm, pn); pm = rowsel_map(sel0, pm); pn += pn00; }
        else { L -= cnt0; if (L >= cnt1) return false; tile_order((int)L, rowsel_count(sel1), nN1, pm, pn); pm = rowsel_map(sel1, pm); pn += pn01; }
        u.pm = pm; u.pn = pn; u.aux = 0; u.rank0 = 0; u.nv = 256; u.a = A + (size_t)pm * astep; u.b = B + (size_t)pn * bstep; return true; }
};
struct SchedMerge {
    int G, c, sel, ntile; const char* Y; const char* W;
    __device__ __forceinline__ void init(int G_, int c_, const void* Y_, const void* W_, int sel_) { G = G_; c = c_; Y = (const char*)Y_; W = (const char*)W_; sel = sel_; ntile = rowsel_count(sel_) * 4; }
    __device__ __forceinline__ bool next(int i, Unit& u) const {
        const int br = i % 3; const long L = (long)(i / 3) * G + c; if (L >= ntile) return false;
        int pm, pn; tile_order((int)L, rowsel_count(sel), 4, pm, pn); pm = rowsel_map(sel, pm);
        u.pm = pm; u.pn = pn; u.aux = br; u.rank0 = 0; u.nv = 256;
        u.a = Y + ((size_t)pm * 256 * YW + br * 512) * 2; u.b = W + ((size_t)br * 1024 * 512 + (size_t)pn * 256 * 512) * 2; return true; }
};
struct SchedMoe {
    int G, c, nrt; const PG8_LAS int* offs; const int* tokr; const char* A; const char* W; size_t astep, wexp, wstep; bool gather;
    __device__ __forceinline__ void init(int G_, int c_, const PG8_LAS int* offs_, const int* tokr_, const void* A_, int lda, const void* W_, int K, bool gather_) {
        G = G_; c = c_; offs = offs_; tokr = tokr_; nrt = offs_[32] >> 8; gather = gather_;
        A = (const char*)A_; W = (const char*)W_; astep = (size_t)256 * lda * 2; wexp = (size_t)1024 * K * 2; wstep = (size_t)256 * K * 2; }
    __device__ __forceinline__ bool next(int i, Unit& u) const {
        const long L = (long)i * G + c; const int rt = (int)(L >> 2), pn = (int)(L & 3); if (rt >= nrt) return false;
        int e = 0;
        for (int j = 1; j < NEXP; ++j) if ((offs[j] >> 8) <= rt) e = j;
        e = __builtin_amdgcn_readfirstlane(e);
        const int rank0 = (rt - (offs[e] >> 8)) * 256; int nv = offs[64 + e] - rank0; nv = nv > 256 ? 256 : nv;
        u.pm = rt; u.pn = pn; u.aux = e; u.rank0 = __builtin_amdgcn_readfirstlane(rank0); u.nv = __builtin_amdgcn_readfirstlane(nv);
        u.a = gather ? A : A + (size_t)rt * astep; u.b = W + (size_t)e * wexp + (size_t)pn * wstep; return true; }
    __device__ __forceinline__ void rows(const Unit& u, const int (&R)[2], const int (&C)[2], int lda, unsigned (&v0)[2], unsigned (&v1)[2]) const {
        const int* tp = tokr + (size_t)u.aux * MOE_CAP + u.rank0;
#pragma unroll
        for (int i = 0; i < 2; ++i) { const int r0 = R[i], r1 = R[i] + HALF;
            const int t0 = tp[r0 < u.nv ? r0 : 0], t1 = tp[r1 < u.nv ? r1 : 0];
            v0[i] = (unsigned)(t0 * lda + C[i]) * 2u; v1[i] = (unsigned)(t1 * lda + C[i]) * 2u; }
    }
};
}
namespace attn_body {
using bf16=__hip_bfloat16;
using bf16x8=__attribute__((ext_vector_type(8)))short;
using s16x4=__attribute__((ext_vector_type(4)))short;
using f32x16=__attribute__((ext_vector_type(16)))float;
using u32x4=__attribute__((ext_vector_type(4)))unsigned;
constexpr int D=64,DMP=PW;
constexpr int NW=8,QBLK=32,KVBLK=64;
__device__ __forceinline__ int crow(int r,int hi){return (r&3)+8*(r>>2)+4*hi;}
#define SBAR() __builtin_amdgcn_sched_barrier(0)
constexpr int NSLOT=3, SLOTB=8192;
constexpr int LDS_K=0, LDS_V=NSLOT*SLOTB, LDS_WS=2*NSLOT*SLOTB, LDS_OST=LDS_WS+NW*64*4, LDS_BYTES=LDS_OST+NW*4096;
__device__ __forceinline__ void glds16(const void*gsrc,unsigned lds_dst){unsigned keep;
  asm volatile("s_mov_b32 %0, m0\n\ts_mov_b32 m0, %2\n\ts_nop 0\n\tglobal_load_lds_dwordx4 %1, off\n\ts_mov_b32 m0, %0":"=&s"(keep):"v"(gsrc),"s"(lds_dst):"memory");}
__device__ __forceinline__ float max3f(float a,float b,float c){float r;asm("v_max3_f32 %0, %1, %2, %3":"=v"(r):"v"(a),"v"(b),"v"(c));return r;}
__device__ __forceinline__ float max2f(float a,float b){float r;asm("v_max_f32_e32 %0, %1, %2":"=v"(r):"v"(a),"v"(b));return r;}
__device__ __forceinline__ float fadd_s(float a,float b){float r;asm("v_add_f32_e32 %0, %1, %2":"=v"(r):"v"(a),"v"(b));return r;}
__device__ __forceinline__ float fsub_s(float a,float b){float r;asm("v_sub_f32_e32 %0, %1, %2":"=v"(r):"v"(a),"v"(b));return r;}
typedef float f32x2_t __attribute__((ext_vector_type(2))); typedef __bf16 bf16x2_t __attribute__((ext_vector_type(2)));
__device__ __forceinline__ unsigned cvtpk_s(float lo,float hi){f32x2_t v={lo,hi};bf16x2_t b=__builtin_convertvector(v,bf16x2_t);return __builtin_bit_cast(unsigned,b);}
#define WAIT_BAR(N) asm volatile("s_waitcnt vmcnt(" #N ") lgkmcnt(0)\n\ts_barrier":::"memory")

__device__ __forceinline__ void qkt(f32x16&p0,f32x16&p1,const char*Kslot,const bf16x8*qr,const f32x16&negm,int r32,int hi){
  const char*kb=Kslot+hi*1024+r32*16;
  #pragma unroll
  for(int d0=0;d0<4;++d0){
    const bf16x8 b0=*reinterpret_cast<const bf16x8*>(kb+d0*2048);
    const bf16x8 b1=*reinterpret_cast<const bf16x8*>(kb+d0*2048+512);
    if(d0==0){p0=__builtin_amdgcn_mfma_f32_32x32x16_bf16(b0,qr[0],negm,0,0,0);p1=__builtin_amdgcn_mfma_f32_32x32x16_bf16(b1,qr[0],negm,0,0,0);}
    else{p0=__builtin_amdgcn_mfma_f32_32x32x16_bf16(b0,qr[d0],p0,0,0,0);p1=__builtin_amdgcn_mfma_f32_32x32x16_bf16(b1,qr[d0],p1,0,0,0);}}
}
typedef __attribute__((address_space(3))) const char* lds_cptr;
typedef short v4i16_t __attribute__((ext_vector_type(4)));
__device__ __forceinline__ void kload8(bf16x8*kf,lds_cptr kp){
  kf[0]=*(const __attribute__((address_space(3))) bf16x8*)(kp);      kf[1]=*(const __attribute__((address_space(3))) bf16x8*)(kp+512);
  kf[2]=*(const __attribute__((address_space(3))) bf16x8*)(kp+2048); kf[3]=*(const __attribute__((address_space(3))) bf16x8*)(kp+2560);
  kf[4]=*(const __attribute__((address_space(3))) bf16x8*)(kp+4096); kf[5]=*(const __attribute__((address_space(3))) bf16x8*)(kp+4608);
  kf[6]=*(const __attribute__((address_space(3))) bf16x8*)(kp+6144); kf[7]=*(const __attribute__((address_space(3))) bf16x8*)(kp+6656);
}
__device__ __forceinline__ void kload2(bf16x8*kf,lds_cptr kp,int j){ kf[2*j]=*(const __attribute__((address_space(3))) bf16x8*)(kp+j*2048); kf[2*j+1]=*(const __attribute__((address_space(3))) bf16x8*)(kp+j*2048+512); }
__device__ __forceinline__ s16x4 vtr(lds_cptr p){ return __builtin_bit_cast(s16x4,__builtin_amdgcn_ds_read_tr16_b64_v4i16((__attribute__((address_space(3))) v4i16_t*)p)); }
__device__ __forceinline__ float rowmax(const f32x16&p0,const f32x16&p1){
  float a=max3f(p0[0],p0[1],p1[0]),b=max3f(p0[2],p0[3],p1[1]);a=max3f(a,p1[2],p1[3]);
  #pragma unroll
  for(int r=4;r<16;r+=4){a=max3f(a,p0[r],p0[r+1]);b=max3f(b,p0[r+2],p0[r+3]);a=max3f(a,p1[r],p1[r+1]);b=max3f(b,p1[r+2],p1[r+3]);}
  const float m=max2f(a,b);
  auto rr=__builtin_amdgcn_permlane32_swap(__float_as_uint(m),__float_as_uint(m),false,false);
  return max2f(__uint_as_float(rr[0]),__uint_as_float(rr[1]));
}
__device__ __forceinline__ void pv(f32x16*o,int vb,bf16x8 pa0,bf16x8 pa1,bf16x8 pa2,bf16x8 pa3){
  #pragma unroll
  for(int d0=0;d0<2;++d0){s16x4 lo[4],hi[4];
    #pragma unroll
    for(int ks=0;ks<4;++ks){
      asm volatile("ds_read_b64_tr_b16 %0,%1 offset:%c2":"=&v"(lo[ks]):"v"(vb),"i"(d0*4096+ks*1024):"memory");
      asm volatile("ds_read_b64_tr_b16 %0,%1 offset:%c2":"=&v"(hi[ks]):"v"(vb),"i"(d0*4096+ks*1024+512):"memory");}
    asm volatile("s_waitcnt lgkmcnt(0)":::"memory");SBAR();
    #define PK(k) (bf16x8){lo[k][0],lo[k][1],lo[k][2],lo[k][3],hi[k][0],hi[k][1],hi[k][2],hi[k][3]}
    o[d0]=__builtin_amdgcn_mfma_f32_32x32x16_bf16(pa0,PK(0),o[d0],0,0,0);
    o[d0]=__builtin_amdgcn_mfma_f32_32x32x16_bf16(pa1,PK(1),o[d0],0,0,0);
    o[d0]=__builtin_amdgcn_mfma_f32_32x32x16_bf16(pa2,PK(2),o[d0],0,0,0);
    o[d0]=__builtin_amdgcn_mfma_f32_32x32x16_bf16(pa3,PK(3),o[d0],0,0,0);
    #undef PK
  }
}
struct AttnU { const bf16* q; const bf16* k; const bf16* v; bf16* o; const float* sinkp; int opitch, rmask, rshift, NT, kbase, jq; float mref; };
__device__ __forceinline__ int win_tile(int t,int jq,int&lo,int&hi){
  int jt; lo=-1000; hi=1000;
  if(t==0) jt=jq;
  else if(t==1){ jt=jq-1; if(jt<0){jt=jq;lo=1000;hi=-1000;} }
  else if(t==2){ jt=jq+1; if(jt>63){jt=jq;lo=1000;hi=-1000;} }
  else if(t==3){ jt=jq-2; lo=0; if(jt<0){jt=jq;lo=1000;hi=-1000;} }
  else if(t==4){ jt=jq+2; hi=0; if(jt>63){jt=jq;lo=1000;hi=-1000;} }
  else if(t<9) jt=64+(t-5);
  else { jt=67; lo=1000; hi=-1000; }
  return jt*64;
}
__device__ __forceinline__ void wmask(f32x16&p0,f32x16&p1,int lo,int hi_,int dq){
  const float NEG=-INFINITY;
  #pragma unroll
  for(int r=0;r<16;++r){const int d=(r&3)+8*(r>>2)+dq; if(d<lo||d>hi_)p0[r]=NEG; if(d+32<lo||d+32>hi_)p1[r]=NEG;}
}
template<bool WIN> __device__ __forceinline__ int krow_of(int t,int kbase,int jq){ if constexpr(WIN){int lo_,hi_;return win_tile(t,jq,lo_,hi_);} else return kbase+t*KVBLK; }
template<bool WIN,int THRL,bool FR> __device__ __forceinline__ void attn_unit(const AttnU&U,char*shm){
  int tid_=threadIdx.x; asm volatile("":"+v"(tid_));
  const int tid=tid_,lane=tid&63,r32=lane&31,hi=lane>>5; const int wid=__builtin_amdgcn_readfirstlane(tid>>6);
  const int wrow=(wid&U.rmask)*QBLK, wcol=(wid>>U.rshift)*D;
  const bf16*Qw=U.q+(long)wrow*DMP+wcol;
  const bf16*Kh=U.k,*Vh=U.v;
  const unsigned lds0=(unsigned)(uintptr_t)shm;
  float*wsf=(float*)(shm+LDS_WS)+wid*64;
  const bf16*ksrc=Kh+(long)lane*DMP+wid*8;
  const bf16*vsrc=Vh+(long)(16*(wid&3)+(lane>>2))*DMP+(wid>>2)*32+(lane&3)*8;
  const unsigned kdst=lds0+LDS_K+wid*1024, vdst=lds0+LDS_V+wid*1024;
  const int NT=U.NT, kbase=U.kbase, jq=U.jq;
  #define KROW(t) krow_of<WIN>((t),kbase,jq)
  #define DMA_K(t,slot) glds16(ksrc+(long)KROW(t)*DMP,(unsigned)__builtin_amdgcn_readfirstlane(kdst+(slot)))
  #define DMA_V(t,slot) glds16(vsrc+(long)KROW(t)*DMP,(unsigned)__builtin_amdgcn_readfirstlane(vdst+(slot)))
  const int vb0=(int)(lds0+LDS_V)+((lane>>4)&1)*32+(lane&3)*8+(4*hi+((lane&15)>>2))*64;
  const char*Kbase=shm+LDS_K; bf16x8 kf[8];
  const lds_cptr shm3=(lds_cptr)shm; const lds_cptr kp0=shm3+LDS_K+hi*1024+r32*16; const lds_cptr vp0=shm3+LDS_V+((lane>>4)&1)*32+(lane&3)*8+(4*hi+((lane&15)>>2))*64;
  DMA_K(0,0);DMA_V(0,0);DMA_K(1,SLOTB);
  bf16x8 qr[4];
  #pragma unroll
  for(int d0=0;d0<4;++d0)qr[d0]=*reinterpret_cast<const bf16x8*>(&Qw[(long)r32*DMP+d0*16+hi*8]);
  float mhat=FR?U.mref:0.f,l_reg=0.f;f32x16 o[2];o[0]=f32x16{};o[1]=f32x16{};f32x16 negm=f32x16{};
  if constexpr(FR){ _Pragma("unroll") for(int r=0;r<16;++r)negm[r]=-mhat; }
  asm volatile("":"+v"(negm));
  const int dq=4*hi-((wid&1)*QBLK+r32);
  #define CMASK(P0,P1,t) do{ if constexpr(WIN){ int lo_,hi_; (void)win_tile((t),jq,lo_,hi_); if(lo_>-64||hi_<64) wmask(P0,P1,lo_,hi_,dq); } }while(0)
  bool resc=false;
  #define START(P0,P1) do{ if constexpr(!FR){ const float rm=rowmax(P0,P1); resc=false; \
    { const float dl=rm; mhat=fadd_s(mhat,dl); \
      _Pragma("unroll") for(int r=0;r<16;++r){P0[r]=fsub_s(P0[r],dl);P1[r]=fsub_s(P1[r],dl);} \
      _Pragma("unroll") for(int r=0;r<16;++r)negm[r]=-mhat; asm volatile("":"+v"(negm)); } } \
    _Pragma("unroll") for(int r=0;r<16;++r)P0[r]=__builtin_amdgcn_exp2f(P0[r]); }while(0)
  #define RESC() do{ if(!FR&&resc){ asm volatile("s_waitcnt lgkmcnt(0)":::"memory"); \
      _Pragma("unroll") for(int d_=0;d_<2;++d_) _Pragma("unroll") for(int r=0;r<16;++r)o[d_][r]*=wsf[crow(r,hi)]; } }while(0)
  f32x16 pA0,pA1,pB0,pB1;
  int sl_prev=0,sl_cur=0,sl_next=SLOTB;
  #define ROT() do{sl_prev=sl_cur;sl_cur=sl_next;sl_next=(sl_next==(NSLOT-1)*SLOTB)?0:sl_next+SLOTB;}while(0)
  DMA_K(2,2*SLOTB);
  WAIT_BAR(3);
  qkt(pA0,pA1,Kbase,qr,negm,r32,hi);asm volatile("s_nop 15\n\ts_nop 7":"+v"(pA0),"+v"(pA1));
  START(pA0,pA1);
  _Pragma("unroll") for(int r=0;r<16;++r)pA1[r]=__builtin_amdgcn_exp2f(pA1[r]);
  WAIT_BAR(0);
  DMA_K(3,0);DMA_V(1,SLOTB);
  ROT();
  kload8(kf,kp0+sl_cur);
  WAIT_BAR(2);
  s16x4 vlo[8],vhi[8]; u32x4 pw0,pw1,pw2,pw3;
  #define PKW(P,B) cvtpk_s(P[B],P[B+1])
  #define PAF(k) __builtin_bit_cast(bf16x8,pw##k)
  #define VFR(i) (bf16x8){vlo[i][0],vlo[i][1],vlo[i][2],vlo[i][3],vhi[i][0],vhi[i][1],vhi[i][2],vhi[i][3]}
  #define PIN(x) asm volatile("":"+v"(x))
  #define MX3(a,b,c) __builtin_fmaxf(__builtin_fmaxf((a),(b)),(c))
  #define GAPA(MF,A0,A1,A2,A3,W0,W1,PW_) do{ MF; sacc+=A0; sacc+=A1; sacc+=A2; sacc+=A3; PIN(sacc); W0; W1; PIN(PW_); SBAR(); }while(0)
  #define EX(v) __builtin_amdgcn_exp2f(v)
  #define GAPB(MF,X,B) do{ MF; X[B]=EX(X[B]); X[B+1]=EX(X[B+1]); X[B+2]=EX(X[B+2]); X[B+3]=EX(X[B+3]); PIN(X); SBAR(); }while(0)
  #define VRD(i) do{ vlo[i]=vtr(vp_+(((i)>>2)*4096+((i)&3)*1024)); vhi[i]=vtr(vp_+(((i)>>2)*4096+((i)&3)*1024+512)); }while(0)
  #define KRD(G_,j) do{ if(G_){ kload2(kf,kp0+sl_next,j); SBAR(); } }while(0)
  #define STEP(C0,C1,P0,P1,t,GK,GV,GL,DOMASK) do{ SBAR(); \
    const lds_cptr vp_=vp0+sl_prev; \
    VRD(0); SBAR(); float sacc=(P0[0]+P0[1]); \
    GAPA(C0=__builtin_amdgcn_mfma_f32_32x32x16_bf16(kf[0],qr[0],negm,0,0,0), P0[2],P0[3],P0[4],P0[5],     pw0[0]=PKW(P0,0), pw0[1]=PKW(P0,2), pw0); \
    VRD(4); SBAR(); GAPA(C1=__builtin_amdgcn_mfma_f32_32x32x16_bf16(kf[1],qr[0],negm,0,0,0), P0[6],P0[7],P0[8],P0[9],     pw0[2]=PKW(P0,4), pw0[3]=PKW(P0,6), pw0); \
    VRD(1); SBAR(); GAPA(C0=__builtin_amdgcn_mfma_f32_32x32x16_bf16(kf[2],qr[1],C0,0,0,0),   P0[10],P0[11],P0[12],P0[13], pw1[0]=PKW(P0,8), pw1[1]=PKW(P0,10), pw1); \
    VRD(5); SBAR(); GAPA(C1=__builtin_amdgcn_mfma_f32_32x32x16_bf16(kf[3],qr[1],C1,0,0,0),   P0[14],P0[15],P1[0],P1[1],   pw1[2]=PKW(P0,12),pw1[3]=PKW(P0,14), pw1); \
    VRD(2); SBAR(); GAPA(C0=__builtin_amdgcn_mfma_f32_32x32x16_bf16(kf[4],qr[2],C0,0,0,0),   P1[2],P1[3],P1[4],P1[5],     pw2[0]=PKW(P1,0), pw2[1]=PKW(P1,2), pw2); \
    VRD(6); SBAR(); GAPA(C1=__builtin_amdgcn_mfma_f32_32x32x16_bf16(kf[5],qr[2],C1,0,0,0),   P1[6],P1[7],P1[8],P1[9],     pw2[2]=PKW(P1,4), pw2[3]=PKW(P1,6), pw2); \
    VRD(3); SBAR(); GAPA(C0=__builtin_amdgcn_mfma_f32_32x32x16_bf16(kf[6],qr[3],C0,0,0,0),   P1[10],P1[11],P1[12],P1[13], pw3[0]=PKW(P1,8), pw3[1]=PKW(P1,10), pw3); \
    VRD(7); SBAR(); GAPA(C1=__builtin_amdgcn_mfma_f32_32x32x16_bf16(kf[7],qr[3],C1,0,0,0),   P1[14],P1[15],0.f,0.f,       pw3[2]=PKW(P1,12),pw3[3]=PKW(P1,14), pw3); \
    l_reg+=sacc; \
    if(GK){DMA_K((t)+3,sl_cur);} if(GV){DMA_V((t)+1,sl_next);} \
    if(DOMASK){ CMASK(C0,C1,t); } \
    if constexpr(!FR){ float a=MX3(C0[0],C0[1],C1[0]),b=MX3(C0[2],C0[3],C1[1]); a=MX3(a,C1[2],C1[3]); \
      _Pragma("unroll") for(int r=4;r<16;r+=4){a=MX3(a,C0[r],C0[r+1]);b=MX3(b,C0[r+2],C0[r+3]);a=MX3(a,C1[r],C1[r+1]);b=MX3(b,C1[r+2],C1[r+3]);} \
      float rm=__builtin_fmaxf(a,b); { auto rr=__builtin_amdgcn_permlane32_swap(__float_as_uint(rm),__float_as_uint(rm),false,false); rm=__builtin_fmaxf(__uint_as_float(rr[0]),__uint_as_float(rr[1])); } \
      resc=false; \
      if(__builtin_expect(__any(rm>(float)THRL),0)){ const float dl=__builtin_fmaxf(rm,0.f); mhat+=dl; \
        _Pragma("unroll") for(int r=0;r<16;++r){C0[r]-=dl;C1[r]-=dl;} \
        _Pragma("unroll") for(int r=0;r<16;++r)negm[r]=-mhat; asm volatile("":"+v"(negm)); \
        const float f=__builtin_amdgcn_exp2f(-dl); l_reg*=f; if(hi==0)wsf[r32]=f; resc=true; } } \
    SBAR(); \
    GAPB(o[0]=__builtin_amdgcn_mfma_f32_32x32x16_bf16(PAF(0),VFR(0),o[0],0,0,0), C0,0); \
    GAPB(o[1]=__builtin_amdgcn_mfma_f32_32x32x16_bf16(PAF(0),VFR(4),o[1],0,0,0), C0,4); \
    KRD(GL,0); GAPB(o[0]=__builtin_amdgcn_mfma_f32_32x32x16_bf16(PAF(1),VFR(1),o[0],0,0,0), C0,8); \
    KRD(GL,1); GAPB(o[1]=__builtin_amdgcn_mfma_f32_32x32x16_bf16(PAF(1),VFR(5),o[1],0,0,0), C0,12); \
    KRD(GL,2); GAPB(o[0]=__builtin_amdgcn_mfma_f32_32x32x16_bf16(PAF(2),VFR(2),o[0],0,0,0), C1,0); \
    KRD(GL,3); GAPB(o[1]=__builtin_amdgcn_mfma_f32_32x32x16_bf16(PAF(2),VFR(6),o[1],0,0,0), C1,4); \
    GAPB(o[0]=__builtin_amdgcn_mfma_f32_32x32x16_bf16(PAF(3),VFR(3),o[0],0,0,0), C1,8); \
    GAPB(o[1]=__builtin_amdgcn_mfma_f32_32x32x16_bf16(PAF(3),VFR(7),o[1],0,0,0), C1,12); \
    }while(0)
  int t=1;
  if constexpr(!WIN){
    for(;t+5<NT;t+=2){
      STEP(pB0,pB1,pA0,pA1,t,true,true,true,false);     WAIT_BAR(2); RESC(); ROT();
      STEP(pA0,pA1,pB0,pB1,t+1,true,true,true,false);   WAIT_BAR(2); RESC(); ROT();
    }
  }
  #define ENDW(tt) do{ if((tt)+3<NT){WAIT_BAR(2);} else if((tt)+2<NT){WAIT_BAR(1);} else {WAIT_BAR(0);} }while(0)
  for(;t+1<NT;t+=2){
    STEP(pB0,pB1,pA0,pA1,t,(t+3<NT),(t+1<NT),(t+1<NT),true);       ENDW(t);   RESC(); ROT();
    STEP(pA0,pA1,pB0,pB1,t+1,(t+4<NT),(t+2<NT),(t+2<NT),true);     ENDW(t+1); RESC(); ROT();
  }
  STEP(pB0,pB1,pA0,pA1,NT-1,false,false,false,true); RESC();
  { float sacc=pB0[0]+pB0[1]; _Pragma("unroll") for(int r=2;r<16;++r)sacc+=pB0[r]; _Pragma("unroll") for(int r=0;r<16;++r)sacc+=pB1[r]; l_reg+=sacc;
    pw0=(u32x4){PKW(pB0,0),PKW(pB0,2),PKW(pB0,4),PKW(pB0,6)};pw1=(u32x4){PKW(pB0,8),PKW(pB0,10),PKW(pB0,12),PKW(pB0,14)};pw2=(u32x4){PKW(pB1,0),PKW(pB1,2),PKW(pB1,4),PKW(pB1,6)};pw3=(u32x4){PKW(pB1,8),PKW(pB1,10),PKW(pB1,12),PKW(pB1,14)};
    SBAR(); pv(o,vb0+sl_cur,PAF(0),PAF(1),PAF(2),PAF(3)); }
  #undef PKW
  #undef PAF
  #undef VFR
  #undef PIN
  #undef MX3
  #undef GAPA
  #undef GAPB
  #undef EX
  #undef VRD
  #undef KRD
  #undef STEP
  #undef ENDW
  {auto rr=__builtin_amdgcn_permlane32_swap(__float_as_uint(l_reg),__float_as_uint(l_reg),false,false);l_reg=__uint_as_float(rr[0])+__uint_as_float(rr[1]);}
  if(U.sinkp){ const float sk=U.sinkp[wid>>U.rshift]; l_reg+=__builtin_amdgcn_exp2f(sk*LOG2E-mhat); }
  if(hi==0)wsf[32+r32]=l_reg;asm volatile("s_waitcnt lgkmcnt(0)":::"memory");
  float rli[16];
  #pragma unroll
  for(int r=0;r<16;++r)rli[r]=__builtin_amdgcn_rcpf(wsf[32+crow(r,hi)]);
  bf16*Ow=U.o+(long)wrow*U.opitch+wcol;
  { bf16*stg=(bf16*)(shm+LDS_OST)+wid*2048;
    #pragma unroll
    for(int r=0;r<16;++r){const int orow=crow(r,hi);
      #pragma unroll
      for(int d0=0;d0<2;++d0)stg[orow*64+d0*32+r32]=__float2bfloat16(o[d0][r]*rli[r]);}
    asm volatile("s_waitcnt lgkmcnt(0)":::"memory");
    #pragma unroll
    for(int i=0;i<4;++i){const int row=i*8+(lane>>3),ch=lane&7; const u32x4 v=*(const u32x4*)(stg+row*64+ch*8); *(u32x4*)(Ow+(long)row*U.opitch+ch*8)=v;} }
  asm volatile("s_waitcnt lgkmcnt(0)\n\ts_barrier":::"memory");
  #undef KROW
  #undef DMA_K
  #undef DMA_V
  #undef CMASK
  #undef START
  #undef RESC
  #undef ROT
}
#undef SBAR
#undef WAIT_BAR

constexpr int B_LDS_K=0, B_SLOTV=16384, B_LDS_V=NSLOT*SLOTB, B_LDS_WS=B_LDS_V+NSLOT*B_SLOTV, B_LDS_OST=B_LDS_WS+NW*64*4, B_LDS_BYTES=B_LDS_OST+NW*4096;
#define WAIT_BAR(N) asm volatile("s_waitcnt vmcnt(" #N ") lgkmcnt(0)\n\ts_barrier":::"memory")
#define SBAR() __builtin_amdgcn_sched_barrier(0)
template<int THRL,bool FR> __device__ __forceinline__ void attn_unit_b(const AttnU&U,char*shm){
  int tid_=threadIdx.x; asm volatile("":"+v"(tid_));
  const int tid=tid_,lane=tid&63,r32=lane&31,hi=lane>>5; const int wid=__builtin_amdgcn_readfirstlane(tid>>6);
  const int wrow=wid*QBLK;
  const bf16*Qw=U.q+(long)wrow*DMP;
  const unsigned lds0=(unsigned)(uintptr_t)shm;
  float*wsf=(float*)(shm+B_LDS_WS)+wid*64;
  const bf16*ksrc=U.k+(long)lane*DMP+wid*8;
  const bf16*vsrc=U.v+(long)(16*(wid&3)+(lane>>2))*DMP+(wid>>2)*32+(lane&3)*8;
  const unsigned kdst=lds0+B_LDS_K+wid*1024, vdst=lds0+B_LDS_V+wid*1024;
  const int NT=U.NT, kbase=U.kbase;
  #define DMA_K(t,slot) glds16(ksrc+(long)(kbase+(t)*KVBLK)*DMP,(unsigned)__builtin_amdgcn_readfirstlane(kdst+(slot)))
  #define DMA_V(t,slot) do{ glds16(vsrc+(long)(kbase+(t)*KVBLK)*DMP,(unsigned)__builtin_amdgcn_readfirstlane(vdst+2*(slot))); \
                            glds16(vsrc+(long)(kbase+(t)*KVBLK)*DMP+64,(unsigned)__builtin_amdgcn_readfirstlane(vdst+2*(slot)+8192)); }while(0)
  const char*Kbase=shm+B_LDS_K; bf16x8 kf[8];
  const lds_cptr shm3=(lds_cptr)shm; const lds_cptr kp0=shm3+B_LDS_K+hi*1024+r32*16; const lds_cptr vp0=shm3+B_LDS_V+((lane>>4)&1)*32+(lane&3)*8+(4*hi+((lane&15)>>2))*64;
  DMA_K(0,0);DMA_V(0,0);DMA_K(1,SLOTB);
  bf16x8 qr[4];
  #pragma unroll
  for(int d0=0;d0<4;++d0)qr[d0]=*reinterpret_cast<const bf16x8*>(&Qw[(long)r32*DMP+d0*16+hi*8]);
  float mhat=FR?U.mref:0.f,l_reg=0.f;f32x16 o[4];o[0]=f32x16{};o[1]=f32x16{};o[2]=f32x16{};o[3]=f32x16{};f32x16 negm=f32x16{};
  if constexpr(FR){ _Pragma("unroll") for(int r=0;r<16;++r)negm[r]=-mhat; }
  asm volatile("":"+v"(negm));
  bool resc=false;
  #define RESC() do{ if(!FR&&resc){ asm volatile("s_waitcnt lgkmcnt(0)":::"memory"); \
      _Pragma("unroll") for(int d_=0;d_<4;++d_) _Pragma("unroll") for(int r=0;r<16;++r)o[d_][r]*=wsf[crow(r,hi)]; } }while(0)
  f32x16 C0,C1; u32x4 pa0,pa1,pa2,pa3,pb0,pb1,pb2,pb3;
  int sl_prev=0,sl_cur=0,sl_next=SLOTB;
  #define ROT() do{sl_prev=sl_cur;sl_cur=sl_next;sl_next=(sl_next==(NSLOT-1)*SLOTB)?0:sl_next+SLOTB;}while(0)
  #define PKW(P,B) cvtpk_s(P[B],P[B+1])
  #define EX(v) __builtin_amdgcn_exp2f(v)
  #define PIN(x) asm volatile("":"+v"(x))
  #define MX3(a,b,c) __builtin_fmaxf(__builtin_fmaxf((a),(b)),(c))
  DMA_K(2,2*SLOTB);
  WAIT_BAR(3);
  qkt(C0,C1,Kbase,qr,negm,r32,hi);asm volatile("s_nop 15\n\ts_nop 7":"+v"(C0),"+v"(C1));
  { if constexpr(!FR){ const float rm=rowmax(C0,C1); mhat=fadd_s(mhat,rm);
    _Pragma("unroll") for(int r=0;r<16;++r){C0[r]=fsub_s(C0[r],rm);C1[r]=fsub_s(C1[r],rm);}
    _Pragma("unroll") for(int r=0;r<16;++r)negm[r]=-mhat; asm volatile("":"+v"(negm)); }
    _Pragma("unroll") for(int r=0;r<16;++r){C0[r]=EX(C0[r]);C1[r]=EX(C1[r]);}
    float sacc=0.f; _Pragma("unroll") for(int r=0;r<16;++r)sacc+=C0[r]; _Pragma("unroll") for(int r=0;r<16;++r)sacc+=C1[r]; l_reg+=sacc;
    pa0=(u32x4){PKW(C0,0),PKW(C0,2),PKW(C0,4),PKW(C0,6)};pa1=(u32x4){PKW(C0,8),PKW(C0,10),PKW(C0,12),PKW(C0,14)};pa2=(u32x4){PKW(C1,0),PKW(C1,2),PKW(C1,4),PKW(C1,6)};pa3=(u32x4){PKW(C1,8),PKW(C1,10),PKW(C1,12),PKW(C1,14)}; }
  WAIT_BAR(0);
  DMA_K(3,0);DMA_V(1,SLOTB);
  ROT();
  kload8(kf,kp0+sl_cur);
  WAIT_BAR(3);
  s16x4 vl0,vh0,vl1,vh1,vl2,vh2,vl3,vh3;
  #define VRDF(L,H,f) do{ L=vtr(vp_+(((f)&3)*4096+((f)>>2)*1024)); H=vtr(vp_+(((f)&3)*4096+((f)>>2)*1024+512)); }while(0)
  #define VFRF(L,H) (bf16x8){L[0],L[1],L[2],L[3],H[0],H[1],H[2],H[3]}
  #define PAFX(P,k) __builtin_bit_cast(bf16x8,P##k)
  #define KRD(G_,j) do{ if(G_){ kload2(kf,kp0+sl_next,j); SBAR(); } }while(0)
  #define GAPF(PP,PN,g,L,H,CX,ci) do{ \
    o[(g)&3]=__builtin_amdgcn_mfma_f32_32x32x16_bf16(PP,VFRF(L,H),o[(g)&3],0,0,0); \
    CX[ci]=EX(CX[ci]); CX[ci+1]=EX(CX[ci+1]); sacc+=CX[ci]; sacc+=CX[ci+1]; PN=PKW(CX,ci); PIN(sacc); PIN(PN); \
    if((g)+4<16){ VRDF(L,H,(g)+4); } SBAR(); }while(0)
  #define STEP(PP,PN,t,GK,GV,GL) do{ SBAR(); \
    C0=__builtin_amdgcn_mfma_f32_32x32x16_bf16(kf[0],qr[0],negm,0,0,0); C1=__builtin_amdgcn_mfma_f32_32x32x16_bf16(kf[1],qr[0],negm,0,0,0); \
    C0=__builtin_amdgcn_mfma_f32_32x32x16_bf16(kf[2],qr[1],C0,0,0,0);   C1=__builtin_amdgcn_mfma_f32_32x32x16_bf16(kf[3],qr[1],C1,0,0,0); \
    C0=__builtin_amdgcn_mfma_f32_32x32x16_bf16(kf[4],qr[2],C0,0,0,0);   C1=__builtin_amdgcn_mfma_f32_32x32x16_bf16(kf[5],qr[2],C1,0,0,0); \
    C0=__builtin_amdgcn_mfma_f32_32x32x16_bf16(kf[6],qr[3],C0,0,0,0);   C1=__builtin_amdgcn_mfma_f32_32x32x16_bf16(kf[7],qr[3],C1,0,0,0); \
    const lds_cptr vp_=vp0+2*sl_prev; \
    VRDF(vl0,vh0,0); VRDF(vl1,vh1,1); VRDF(vl2,vh2,2); VRDF(vl3,vh3,3); \
    if(GK){DMA_K((t)+3,sl_cur);} if(GV){DMA_V((t)+1,sl_next);} \
    SBAR(); \
    if constexpr(!FR){ float a=MX3(C0[0],C0[1],C1[0]),b=MX3(C0[2],C0[3],C1[1]); a=MX3(a,C1[2],C1[3]); \
      _Pragma("unroll") for(int r=4;r<16;r+=4){a=MX3(a,C0[r],C0[r+1]);b=MX3(b,C0[r+2],C0[r+3]);a=MX3(a,C1[r],C1[r+1]);b=MX3(b,C1[r+2],C1[r+3]);} \
      float rm=__builtin_fmaxf(a,b); { auto rr=__builtin_amdgcn_permlane32_swap(__float_as_uint(rm),__float_as_uint(rm),false,false); rm=__builtin_fmaxf(__uint_as_float(rr[0]),__uint_as_float(rr[1])); } \
      resc=false; \
      if(__builtin_expect(__any(rm>(float)THRL),0)){ const float dl=__builtin_fmaxf(rm,0.f); mhat+=dl; \
        _Pragma("unroll") for(int r=0;r<16;++r){C0[r]-=dl;C1[r]-=dl;} \
        _Pragma("unroll") for(int r=0;r<16;++r)negm[r]=-mhat; asm volatile("":"+v"(negm)); \
        const float f=__builtin_amdgcn_exp2f(-dl); l_reg*=f; if(hi==0)wsf[r32]=f; resc=true; } } \
    SBAR(); float sacc=0.f; \
    GAPF(PAFX(PP,0),PN##0[0],0,vl0,vh0,C0,0);  GAPF(PAFX(PP,0),PN##0[1],1,vl1,vh1,C0,2);  GAPF(PAFX(PP,0),PN##0[2],2,vl2,vh2,C0,4);  GAPF(PAFX(PP,0),PN##0[3],3,vl3,vh3,C0,6); \
    KRD(GL,0); GAPF(PAFX(PP,1),PN##1[0],4,vl0,vh0,C0,8);  KRD(GL,1); GAPF(PAFX(PP,1),PN##1[1],5,vl1,vh1,C0,10); \
    KRD(GL,2); GAPF(PAFX(PP,1),PN##1[2],6,vl2,vh2,C0,12); KRD(GL,3); GAPF(PAFX(PP,1),PN##1[3],7,vl3,vh3,C0,14); \
    GAPF(PAFX(PP,2),PN##2[0],8,vl0,vh0,C1,0);  GAPF(PAFX(PP,2),PN##2[1],9,vl1,vh1,C1,2);  GAPF(PAFX(PP,2),PN##2[2],10,vl2,vh2,C1,4); GAPF(PAFX(PP,2),PN##2[3],11,vl3,vh3,C1,6); \
    GAPF(PAFX(PP,3),PN##3[0],12,vl0,vh0,C1,8); GAPF(PAFX(PP,3),PN##3[1],13,vl1,vh1,C1,10); GAPF(PAFX(PP,3),PN##3[2],14,vl2,vh2,C1,12); GAPF(PAFX(PP,3),PN##3[3],15,vl3,vh3,C1,14); \
    l_reg+=sacc; \
    }while(0)
  int t=1;
  for(;t+5<NT;t+=2){
    STEP(pa,pb,t,true,true,true);     WAIT_BAR(3); RESC(); ROT();
    STEP(pb,pa,t+1,true,true,true);   WAIT_BAR(3); RESC(); ROT();
  }
  #define ENDW(tt) do{ if((tt)+3<NT){WAIT_BAR(3);} else if((tt)+2<NT){WAIT_BAR(2);} else {WAIT_BAR(0);} }while(0)
  for(;t+1<NT;t+=2){
    STEP(pa,pb,t,(t+3<NT),(t+1<NT),(t+1<NT));       ENDW(t);   RESC(); ROT();
    STEP(pb,pa,t+1,(t+4<NT),(t+2<NT),(t+2<NT));     ENDW(t+1); RESC(); ROT();
  }
  STEP(pa,pb,NT-1,false,false,false); RESC();
  { const lds_cptr vp_=vp0+2*sl_cur;
    #pragma unroll
    for(int ks=0;ks<4;++ks){
      #pragma unroll
      for(int db=0;db<4;++db){ s16x4 L_,H_; L_=vtr(vp_+(db*4096+ks*1024)); H_=vtr(vp_+(db*4096+ks*1024+512));
        const bf16x8 pf = ks==0?PAFX(pb,0):(ks==1?PAFX(pb,1):(ks==2?PAFX(pb,2):PAFX(pb,3)));
        o[db]=__builtin_amdgcn_mfma_f32_32x32x16_bf16(pf,VFRF(L_,H_),o[db],0,0,0); } } }
  #undef STEP
  #undef ENDW
  #undef GAPF
  #undef KRD
  #undef PAFX
  #undef VFRF
  #undef VRDF
  {auto rr=__builtin_amdgcn_permlane32_swap(__float_as_uint(l_reg),__float_as_uint(l_reg),false,false);l_reg=__uint_as_float(rr[0])+__uint_as_float(rr[1]);}
  if(hi==0)wsf[32+r32]=l_reg;asm volatile("s_waitcnt lgkmcnt(0)":::"memory");
  float rli[16];
  #pragma unroll
  for(int r=0;r<16;++r)rli[r]=__builtin_amdgcn_rcpf(wsf[32+crow(r,hi)]);
  bf16*Ow=U.o+(long)wrow*U.opitch;
  { bf16*stg=(bf16*)(shm+B_LDS_OST)+wid*2048;
    #pragma unroll
    for(int half=0;half<2;++half){
      #pragma unroll
      for(int r=0;r<16;++r){const int orow=crow(r,hi);
        #pragma unroll
        for(int d0=0;d0<2;++d0)stg[orow*64+d0*32+r32]=__float2bfloat16(o[2*half+d0][r]*rli[r]);}
      asm volatile("s_waitcnt lgkmcnt(0)":::"memory");
      #pragma unroll
      for(int i=0;i<4;++i){const int row=i*8+(lane>>3),ch=lane&7; const u32x4 v=*(const u32x4*)(stg+row*64+ch*8); *(u32x4*)(Ow+(long)row*U.opitch+half*64+ch*8)=v;}
      asm volatile("s_waitcnt lgkmcnt(0)":::"memory"); } }
  asm volatile("s_waitcnt lgkmcnt(0)\n\ts_barrier":::"memory");
  #undef DMA_K
  #undef DMA_V
  #undef RESC
  #undef ROT
  #undef PKW
  #undef EX
  #undef PIN
  #undef MX3
}
#undef SBAR
#undef WAIT_BAR
constexpr int ATTN_LDS_BYTES=(LDS_BYTES>B_LDS_BYTES?LDS_BYTES:B_LDS_BYTES);
}
constexpr int RING_OFF = 0, RING_BYTES = 135168;
constexpr int LDSCTL_OFF = RING_BYTES, MISC_OFF = LDSCTL_OFF + 320;
constexpr int LDS_BYTES = 147456;
static_assert(MISC_OFF + 128 <= LDS_BYTES, "LDS map");
constexpr int LDS_OFFS = LDSCTL_OFF + 2048;
constexpr int LDS_RTR = LDSCTL_OFF + 4608;
static_assert(LDS_RTR + 256 + 224 * 32 <= LDS_BYTES, "router records");
static_assert(attn_body::ATTN_LDS_BYTES <= RING_BYTES && pg8::STAGE_BYTES <= RING_BYTES && 8 * 16640 <= RING_BYTES, "phase scratch fits the ring region");
constexpr int NWAVES = 8;

#define GAS __attribute__((address_space(1)))
#define LAS __attribute__((address_space(3)))
typedef unsigned short bf16;
typedef unsigned v4u __attribute__((ext_vector_type(4)));
typedef unsigned v2u __attribute__((ext_vector_type(2)));
typedef float f32x4 __attribute__((ext_vector_type(4)));
typedef GAS unsigned gu32;
#define RLX_AGENT __ATOMIC_RELAXED, __HIP_MEMORY_SCOPE_AGENT
#define LDS_WAIT() asm volatile("s_waitcnt lgkmcnt(0)" ::: "memory")
#define VM_WAIT() asm volatile("s_waitcnt vmcnt(0)" ::: "memory")
__device__ __forceinline__ unsigned f2bf(float f) { unsigned u = __builtin_bit_cast(unsigned, f); return (u + 0x7fffu + ((u >> 16) & 1u)) >> 16; }
__device__ __forceinline__ unsigned pk2(float lo, float hi) { return f2bf(lo) | (f2bf(hi) << 16); }
__device__ __forceinline__ float bflo(unsigned u) { return __uint_as_float(u << 16); }
__device__ __forceinline__ float bfhi(unsigned u) { return __uint_as_float(u & 0xffff0000u); }

#define XB_TMO      128
#define XB_XCNT(j)  (256  + 64 * (j))
#define XB_XSUB(j)  (1280 + 64 * (j))
#define XB_XGEN(j)  (2304 + 64 * (j))
#define XB_TOP      3328
#define XB_TOPGEN   3392
#define XCD_BAR_WORDS 3456
#define XB_SPIN_CAP (1u << 18)
__device__ __forceinline__ unsigned xb_ld(unsigned* p)              { return __hip_atomic_load(p, __ATOMIC_RELAXED, __HIP_MEMORY_SCOPE_AGENT); }
__device__ __forceinline__ unsigned xb_add(unsigned* p, unsigned v) { return __hip_atomic_fetch_add(p, v, __ATOMIC_RELAXED, __HIP_MEMORY_SCOPE_AGENT); }
__device__ __forceinline__ unsigned xb_xcc_id() { return (unsigned)__builtin_amdgcn_s_getreg((3 << 11) | 20) & 0xFu; }
#define XB_SPIN(cond, bar) do { unsigned _sp = 0; while (cond) { __builtin_amdgcn_s_sleep(1); \
    if ((++_sp & 255u) == 0u) { if (xb_ld(&(bar)[XB_TMO])) break; if (_sp > XB_SPIN_CAP) { atomicAdd(&(bar)[XB_TMO], 1u); break; } } } } while (0)
struct XcdBarrier { unsigned* bar; unsigned x; volatile LAS unsigned* st; };
__device__ __forceinline__ XcdBarrier xcd_barrier_post(unsigned* bar, volatile LAS unsigned* st) {
    XcdBarrier b; b.bar = bar; b.x = xb_xcc_id(); b.st = st;
    if (threadIdx.x == 0) (void)xb_add(&bar[XB_XCNT(b.x)], 1u);
    return b;
}
__device__ __forceinline__ void xcd_barrier_complete(unsigned* bar, unsigned x, unsigned& nloc, unsigned& nx) {
    const unsigned G = gridDim.x * gridDim.y * gridDim.z;
    unsigned sum, cnt, mine, sp = 0u;
    for (;;) {
        sum = 0u; cnt = 0u; mine = 0u;
#pragma unroll
        for (unsigned j = 0; j < 16; ++j) { const unsigned c = xb_ld(&bar[XB_XCNT(j)]); sum += c; cnt += (c > 0u) ? 1u : 0u; mine = (j == x) ? c : mine; }
        if (sum == G) break;
        __builtin_amdgcn_s_sleep(1);
        if ((++sp & 255u) == 0u) { if (xb_ld(&bar[XB_TMO])) break; if (sp > XB_SPIN_CAP) { atomicAdd(&bar[XB_TMO], 1u); break; } }
    }
    nloc = mine > 0u ? mine : 1u; nx = cnt > 0u ? cnt : 1u;
}
__device__ __forceinline__ void xcd_barrier(const XcdBarrier& b) {
    asm volatile("s_waitcnt vmcnt(0)" ::: "memory");
    __syncthreads();
    if (threadIdx.x == 0) {
        unsigned* bar = b.bar;
        __builtin_amdgcn_s_waitcnt(0);
        unsigned nloc = b.st[0], nx = b.st[1];
        if (nloc == 0u) { xcd_barrier_complete(bar, b.x, nloc, nx); b.st[0] = nloc; b.st[1] = nx; }
        const unsigned old = xb_add(&bar[XB_XSUB(b.x)], 1u);
        const unsigned gen = old / nloc;
        if (old + 1u == (gen + 1u) * nloc) {
            __builtin_amdgcn_fence(__ATOMIC_RELEASE, "agent");
            asm volatile("s_waitcnt vmcnt(0)" ::: "memory");
            const unsigned og = xb_add(&bar[XB_TOP], 1u);
            const unsigned tg = og / nx;
            if (og + 1u == (tg + 1u) * nx) xb_add(&bar[XB_TOPGEN], 1u);
            else XB_SPIN(xb_ld(&bar[XB_TOPGEN]) == tg, bar);
            __builtin_amdgcn_fence(__ATOMIC_ACQUIRE, "agent");
            xb_add(&bar[XB_XGEN(b.x)], 1u);
            asm volatile("s_waitcnt vmcnt(0)" ::: "memory");
        } else {
            XB_SPIN(xb_ld(&bar[XB_XGEN(b.x)]) == gen, bar);
            __builtin_amdgcn_fence(__ATOMIC_ACQUIRE, "agent");
            asm volatile("s_waitcnt vmcnt(0)" ::: "memory");
        }
    }
    __syncthreads();
}

struct Args { const float* in[28]; float* out; unsigned char* ws; int ph_lo, ph_hi; };
enum { I_X = 0, I_C, I_CTX, I_CCTX, I_WADA, I_BADA, I_WIN, I_AQN, I_AKN, I_BQN, I_BKN, I_CQN, I_CKN, I_LQ1, I_LK1, I_LQ2, I_LK2, I_SUBLN, I_SINK, I_WBA, I_WBB, I_WBC, I_WOUT, I_WRG, I_WRE, I_WEG, I_WEU, I_WED };
struct Frame { LAS unsigned char* lds; int tid, lane, wave, G, bid; };

__device__ __forceinline__ Frame local_frame(const Frame& F0) { Frame F = F0; int t = F0.tid; asm volatile("" : "+v"(t)); F.tid = t; F.lane = t & 63; return F; }
template <int CTRL> __device__ __forceinline__ float dpp_f(float v) { return __int_as_float(__builtin_amdgcn_update_dpp(0, __float_as_int(v), CTRL, 0xF, 0xF, true)); }
__device__ __forceinline__ float wave_sum(float v) {
    v += dpp_f<0xB1>(v);
    v += dpp_f<0x4E>(v);
    v += dpp_f<0x141>(v);
    v += dpp_f<0x140>(v);
    { auto rr = __builtin_amdgcn_permlane16_swap(__float_as_uint(v), __float_as_uint(v), false, false); v = __uint_as_float(rr[0]) + __uint_as_float(rr[1]); }
    { auto rr = __builtin_amdgcn_permlane32_swap(__float_as_uint(v), __float_as_uint(v), false, false); v = __uint_as_float(rr[0]) + __uint_as_float(rr[1]); }
    return v;
}
__device__ __forceinline__ const float* xrow_c(const float* lat, const float* ctx, int r) { const int b = r / TOKB, i = r - b * TOKB; return i < SEQL ? lat + ((size_t)b * SEQL + i) * DM : ctx + ((size_t)b * CTXL + (i - SEQL)) * DM; }
__device__ __forceinline__ float* xrow_m(float* lat, float* ctx, int r) { const int b = r / TOKB, i = r - b * TOKB; return i < SEQL ? lat + ((size_t)b * SEQL + i) * DM : ctx + ((size_t)b * CTXL + (i - SEQL)) * DM; }
__device__ __forceinline__ int modsel(int r) { const int b = r / TOKB, i = r - b * TOKB; return i < SEQL ? b : 8; }
__device__ __forceinline__ int latrow(int q) { return (q >> 12) * TOKB + (q & 4095); }

__device__ __forceinline__ void ph_prologue(const Frame& F0, const Args& a, float* mod, float* rope) {
    const Frame F = local_frame(F0);
    LAS float* sc = (LAS float*)(F.lds + RING_OFF); LAS float* red = (LAS float*)(F.lds + RING_OFF + 40960);
    if (F.bid < 192) {
        const int l = F.bid / 96, j0 = (F.bid % 96) * 64;
        for (int idx = F.tid; idx < 9 * 1024; idx += NWAVES * 64) { const int s = idx >> 10, k = idx & 1023; const float v = s < 8 ? a.in[I_C][s * 1024 + k] : a.in[I_CCTX][k]; sc[idx] = v / (1.0f + expf(-v)); }
        __syncthreads();
        float acc[9];
#pragma unroll
        for (int s = 0; s < 9; ++s) acc[s] = 0.f;
        const float* wp = a.in[I_WADA] + ((size_t)l * 1024 + F.wave * 128) * 6144 + j0 + F.lane;
#pragma unroll 4
        for (int k = 0; k < 128; ++k) { const float w = wp[(size_t)k * 6144];
#pragma unroll
            for (int s = 0; s < 9; ++s) acc[s] += sc[s * 1024 + F.wave * 128 + k] * w; }
#pragma unroll
        for (int s = 0; s < 9; ++s) red[(F.wave * 9 + s) * 64 + F.lane] = acc[s];
        __syncthreads();
        for (int idx = F.tid; idx < 576; idx += NWAVES * 64) { const int s = idx >> 6, jl = idx & 63; float sum = a.in[I_BADA][l * 6144 + j0 + jl];
#pragma unroll
            for (int w = 0; w < 8; ++w) sum += red[(w * 9 + s) * 64 + jl];
            mod[((size_t)l * 9 + s) * 6144 + j0 + jl] = sum; }
        __syncthreads();
    }
    if (F.bid == F.G - 1) {
        for (int idx = F.tid; idx < 1024; idx += NWAVES * 64) { const int n = idx >> 4, i = idx & 15; const float fr = powf(10000.0f, -(float)i / 16.0f); const float ang = (float)n * fr;
            rope[idx * 2] = cosf(ang); rope[idx * 2 + 1] = sinf(ang); }
    }
}

template <class SrcF, class MapF>
__device__ __forceinline__ void transpose_item(const SrcF& src  , const MapF& nn_of_dr  , bf16* dst  , int ldt, LAS float* scr, int lane) {
    f32x4 v[16];
#pragma unroll
    for (int i = 0; i < 16; ++i) { const int idx = lane + 64 * i; v[i] = __builtin_nontemporal_load((const f32x4*)src(idx >> 4, idx & 15)); }
#pragma unroll
    for (int i = 0; i < 16; ++i) { const int idx = lane + 64 * i; LAS float* d = scr + (idx >> 4) * 65 + (idx & 15) * 4; d[0] = v[i][0]; d[1] = v[i][1]; d[2] = v[i][2]; d[3] = v[i][3]; }
    LDS_WAIT(); asm volatile("" ::: "memory");
    const int c = lane & 7;
#pragma unroll
    for (int j = 0; j < 8; ++j) { const int dr = (lane >> 3) + 8 * j; const LAS float* s = scr + (8 * c) * 65 + nn_of_dr(dr);
        v4u o; o.x = pk2(s[0 * 65], s[1 * 65]); o.y = pk2(s[2 * 65], s[3 * 65]); o.z = pk2(s[4 * 65], s[5 * 65]); o.w = pk2(s[6 * 65], s[7 * 65]);
        *(GAS v4u*)(dst + (size_t)dr * ldt + 8 * c) = o; }
    LDS_WAIT(); asm volatile("" ::: "memory");
}
__device__ __forceinline__ int win_origbase(int t) { return t < 6 ? t * 256 : (t < 12 ? 4608 + (t - 6) * 256 : 1536 + (t - 12) * 256); }
__device__ __forceinline__ void ph_conv_attn(const Frame& F0, const Args& a, int l, bf16* WinT, bf16* WbrT, bf16* WoT, float* WrT) {
    const Frame F = local_frame(F0);
    LAS float* scr = (LAS float*)(F.lds + RING_OFF + F.wave * 16640);
    const int gw = F.bid * NWAVES + F.wave, NGW = F.G * NWAVES;
    constexpr int I_IN = 16 * 96, I_BR = 8 * 16, I_OUT = 16 * 16, NITEMS = I_IN + 3 * I_BR + I_OUT;
    const auto ident = [](int dr) { return dr; };
    for (int it = gw; it < NITEMS; it += NGW) {
        int r = it;
        if (r < I_IN) { const int kb = r / 96, q2 = r % 96, t = q2 >> 2, bj = (q2 >> 1) & 1, wp = q2 & 1;
            const float* W = a.in[I_WIN] + (size_t)l * 1024 * 6144 + (size_t)(kb * 64) * 6144 + win_origbase(t) + bj * 32;
            transpose_item([=](int kk, int q) { return W + (size_t)kk * 6144 + (2 * wp + (q >> 3)) * 64 + 4 * (q & 7); }, ident, WinT + (size_t)(t * 256 + bj * 128 + wp * 64) * 1024 + kb * 64, 1024, scr, F.lane); continue; }
        r -= I_IN;
        if (r < 3 * I_BR) { const int br = r / I_BR, rr = r % I_BR, kb = rr / 16, q = rr % 16;
            const float* W = a.in[I_WBA + br] + (size_t)l * 512 * 1024 + (size_t)(kb * 64) * 1024 + q * 64;
            transpose_item([=](int kk, int q4) { return W + (size_t)kk * 1024 + 4 * q4; }, ident, WbrT + (size_t)br * 1024 * 512 + (size_t)(q * 64) * 512 + kb * 64, 512, scr, F.lane); continue; }
        r -= 3 * I_BR;
        { const int kb = r / 16, q = r % 16;
            const float* W = a.in[I_WOUT] + (size_t)l * 1024 * 1024 + (size_t)(kb * 64) * 1024 + q * 64;
            transpose_item([=](int kk, int q4) { return W + (size_t)kk * 1024 + 4 * q4; }, ident, WoT + (size_t)(q * 64) * 1024 + kb * 64, 1024, scr, F.lane); }
    }
    for (int idx = F.bid * NWAVES * 64 + F.tid; idx < 36 * 1024; idx += F.G * NWAVES * 64) { const int o = idx >> 10, k = idx & 1023;
        WrT[idx] = o < 4 ? a.in[I_WRG][((size_t)l * 1024 + k) * 4 + o] : a.in[I_WRE][((size_t)l * 1024 + k) * 32 + (o - 4)]; }
}
__device__ __forceinline__ void ph_conv_experts(const Frame& F0, const Args& a, int l, bf16* W1t, bf16* W2t) {
    const Frame F = local_frame(F0);
    LAS float* scr = (LAS float*)(F.lds + RING_OFF + F.wave * 16640);
    const int gw = F.bid * NWAVES + F.wave, NGW = F.G * NWAVES;
    constexpr int I_1 = 16 * 16, I_2 = 8 * 16, NITEMS = NEXP * (I_1 + I_2);
    for (int it = gw; it < NITEMS; it += NGW) {
        const int e = it / (I_1 + I_2); int r = it % (I_1 + I_2);
        if (r < I_1) { const int kb = r / 16, gq2 = r % 16, pn = gq2 >> 2, g4 = gq2 & 3, bj = g4 >> 1, wp = g4 & 1; const int hb = pn * 128 + bj * 64 + wp * 32;
            const float* Wg = a.in[I_WEG] + ((size_t)(l * NEXP + e) * 1024 + kb * 64) * EHID + hb;
            const float* Wu = a.in[I_WEU] + ((size_t)(l * NEXP + e) * 1024 + kb * 64) * EHID + hb;
            transpose_item([=](int kk, int q) { return q < 8 ? Wg + (size_t)kk * EHID + 4 * q : Wu + (size_t)kk * EHID + 4 * (q - 8); },
                           [](int dr) { return ((dr >> 2) & 1) * 32 + (dr >> 5) * 16 + ((dr >> 3) & 3) * 4 + (dr & 3); },
                           W1t + ((size_t)e * 1024 + pn * 256 + bj * 128 + wp * 64) * 1024 + kb * 64, 1024, scr, F.lane); }
        else { r -= I_1; const int kb = r / 16, q = r % 16;
            const float* W = a.in[I_WED] + ((size_t)(l * NEXP + e) * EHID + kb * 64) * 1024 + q * 64;
            transpose_item([=](int kk, int q4) { return W + (size_t)kk * 1024 + 4 * q4; }, [](int dr) { return dr; }, W2t + ((size_t)e * 1024 + q * 64) * EHID + kb * 64, EHID, scr, F.lane); }
    }
}

__device__ __forceinline__ void norm_mod_store(const f32x4 (&v)[4], const float* shift, const float* scale, bf16* hrow, int lane) {
    float s2 = 0.f;
#pragma unroll
    for (int j = 0; j < 4; ++j) s2 += (v[j][0] * v[j][0] + v[j][1] * v[j][1]) + (v[j][2] * v[j][2] + v[j][3] * v[j][3]);
    const float rstd = 1.0f / sqrtf(wave_sum(s2) * (1.0f / DM) + 1e-6f);
#pragma unroll
    for (int j = 0; j < 4; ++j) { const int c = 4 * lane + 256 * j; const f32x4 sh = *(const f32x4*)(shift + c), sc = *(const f32x4*)(scale + c);
        const f32x4 h = v[j] * rstd * (sc + 1.0f) + sh; v2u o; o.x = pk2(h[0], h[1]); o.y = pk2(h[2], h[3]); *(v2u*)(hrow + c) = o; }
}
__device__ __forceinline__ void ph_norm1_l0(const Frame& F0, const Args& a, const float* modl, bf16* H) {
    const Frame F = local_frame(F0);
    const int gw = F.bid * NWAVES + F.wave, NGW = F.G * NWAVES;
    for (int r0 = gw; r0 < TT; r0 += 2 * NGW) { const int r1 = (r0 + NGW < TT) ? r0 + NGW : r0;
        const float* x0 = xrow_c(a.in[I_X], a.in[I_CTX], r0); const float* x1 = xrow_c(a.in[I_X], a.in[I_CTX], r1); f32x4 v0[4], v1[4];
#pragma unroll
        for (int j = 0; j < 4; ++j) { v0[j] = *(const f32x4*)(x0 + 4 * F.lane + 256 * j); v1[j] = *(const f32x4*)(x1 + 4 * F.lane + 256 * j); }
        const float* mp0 = modl + (size_t)modsel(r0) * 6144; norm_mod_store(v0, mp0, mp0 + 1024, H + (size_t)r0 * DM, F.lane);
        if (r1 != r0) { const float* mp1 = modl + (size_t)modsel(r1) * 6144; norm_mod_store(v1, mp1, mp1 + 1024, H + (size_t)r1 * DM, F.lane); } }
}
template <bool NORM>
__device__ __forceinline__ void ph_combine(const Frame& F0, float* XL, float* XC, const float* modprev, const float* modnext, const bf16* yout, const int* rte, const int* rtr, bf16* H, bool latent_only, const float* RL = nullptr, const float* RC = nullptr) {
    const Frame F = local_frame(F0);
    const int gw = F.bid * NWAVES + F.wave, NGW = F.G * NWAVES; const int nrows = latent_only ? NB * SEQL : TT;
    const LAS int* offs = (const LAS int*)(F.lds + LDS_OFFS);
    for (int q0 = gw; q0 < nrows; q0 += 2 * NGW) { const int q1 = (q0 + NGW < nrows) ? q0 + NGW : q0; int rr[2]; rr[0] = latent_only ? latrow(q0) : q0; rr[1] = latent_only ? latrow(q1) : q1;
        f32x4 xv[2][4], gg[2][4]; v2u ya[2][4], yb[2][4]; float* xp[2];
#pragma unroll
        for (int k = 0; k < 2; ++k) { const int r = rr[k]; xp[k] = xrow_m(XL, XC, r);
            const int s0 = offs[rte[r]] + rtr[r], s1 = offs[rte[TT + r]] + rtr[TT + r]; const float* gate = modprev + (size_t)modsel(r) * 6144 + 5 * 1024;
#pragma unroll
            for (int j = 0; j < 4; ++j) { const int c = 4 * F.lane + 256 * j; xv[k][j] = *(const f32x4*)((RL ? xrow_c(RL, RC ? RC : XC, r) : (const float*)xp[k]) + c); gg[k][j] = *(const f32x4*)(gate + c);
                ya[k][j] = *(const v2u*)(yout + (size_t)s0 * DM + c); yb[k][j] = *(const v2u*)(yout + (size_t)s1 * DM + c); } }
#pragma unroll
        for (int k = 0; k < 2; ++k) { if (k == 1 && q1 == q0) break; const int r = rr[k]; f32x4 v[4];
#pragma unroll
            for (int j = 0; j < 4; ++j) { const int c = 4 * F.lane + 256 * j; const v2u y0 = ya[k][j], y1 = yb[k][j];
                f32x4 f; f[0] = bflo(y0.x) + bflo(y1.x); f[1] = bfhi(y0.x) + bfhi(y1.x); f[2] = bflo(y0.y) + bflo(y1.y); f[3] = bfhi(y0.y) + bfhi(y1.y);
                v[j] = xv[k][j] + gg[k][j] * f; *(f32x4*)(xp[k] + c) = v[j]; }
            if constexpr (NORM) { const float* mp = modnext + (size_t)modsel(r) * 6144; norm_mod_store(v, mp, mp + 1024, H + (size_t)r * DM, F.lane); } } }
}
template <int R>
__device__ __forceinline__ void ph_norm2_router(const Frame& F0, const float* XL, const float* XC, const float* modl, const float* WrT, bf16* H, int* rte, int* rtr, int* tokr, float* wr, unsigned* cnt, bool latent_only) {
    const Frame F = local_frame(F0);
    const int nrows = latent_only ? NB * SEQL : TT;
    const int nj = (nrows - F.bid + F.G - 1) / F.G;
    LAS int* lcnt = (LAS int*)(F.lds + LDS_RTR);
    LAS int* rec = (LAS int*)(F.lds + LDS_RTR + 256);
    LAS float* wl = (LAS float*)(F.lds + RING_OFF);
    __syncthreads();
    if (F.tid < 64) lcnt[F.tid] = 0;
    for (int i = F.tid; i < NEXP * 256; i += NWAVES * 64) *(LAS f32x4*)(wl + 4 * i) = *(const f32x4*)(WrT + 4 * 1024 + 4 * i);
    __syncthreads();
    for (int j0 = F.wave * R; j0 < nj; j0 += NWAVES * R) {
        f32x4 v[R][4]; int rows[R];
#pragma unroll
        for (int q = 0; q < R; ++q) { int j = j0 + q; if (j >= nj) j = nj - 1; const int qq = F.bid + F.G * j; const int r = latent_only ? latrow(qq) : qq; rows[q] = r;
            const float* x = xrow_c(XL, XC, r);
#pragma unroll
            for (int jj = 0; jj < 4; ++jj) v[q][jj] = *(const f32x4*)(x + 4 * F.lane + 256 * jj);
            float s2 = 0.f;
#pragma unroll
            for (int jj = 0; jj < 4; ++jj) s2 += (v[q][jj][0] * v[q][jj][0] + v[q][jj][1] * v[q][jj][1]) + (v[q][jj][2] * v[q][jj][2] + v[q][jj][3] * v[q][jj][3]);
            const float rstd = 1.0f / sqrtf(wave_sum(s2) * (1.0f / DM) + 1e-6f);
            const float* mp = modl + (size_t)modsel(r) * 6144 + 3 * 1024;
#pragma unroll
            for (int jj = 0; jj < 4; ++jj) { const int c = 4 * F.lane + 256 * jj; const f32x4 sh = *(const f32x4*)(mp + c), sc = *(const f32x4*)(mp + 1024 + c);
                v[q][jj] = v[q][jj] * rstd * (sc + 1.0f) + sh; v2u o; o.x = pk2(v[q][jj][0], v[q][jj][1]); o.y = pk2(v[q][jj][2], v[q][jj][3]);
                if (j0 + q < nj) *(v2u*)(H + (size_t)r * DM + c) = o; } }
        float gl[R][4];
#pragma unroll
        for (int o = 0; o < 4; ++o) { f32x4 w[4];
#pragma unroll
            for (int jj = 0; jj < 4; ++jj) w[jj] = *(const f32x4*)(WrT + o * 1024 + 4 * F.lane + 256 * jj);
#pragma unroll
            for (int q = 0; q < R; ++q) { float p = 0.f;
#pragma unroll
                for (int jj = 0; jj < 4; ++jj) p += (v[q][jj][0] * w[jj][0] + v[q][jj][1] * w[jj][1]) + (v[q][jj][2] * w[jj][2] + v[q][jj][3] * w[jj][3]);
                gl[q][o] = wave_sum(p); } }
        int re0[R], re1[R]; float rw0[R], rw1[R];
#pragma unroll
        for (int q = 0; q < R; ++q) {
            int gi = 0; float gm = gl[q][0];
#pragma unroll
            for (int jj = 1; jj < 4; ++jj) if (gl[q][jj] > gm) { gm = gl[q][jj]; gi = jj; }
            gi = __builtin_amdgcn_readfirstlane(gi);
            float gs = 0.f;
#pragma unroll
            for (int jj = 0; jj < 4; ++jj) gs += __expf(gl[q][jj] - gm);
            const float gwt = __builtin_amdgcn_rcpf(gs);
            const LAS float* We = wl + (8 * gi) * 1024 + 4 * F.lane;
            float ev[8];
#pragma unroll
            for (int k0 = 0; k0 < 8; k0 += 4) {
                f32x4 w[4][4];
#pragma unroll
                for (int kk = 0; kk < 4; ++kk)
#pragma unroll
                    for (int jj = 0; jj < 4; ++jj) w[kk][jj] = *(const LAS f32x4*)(We + (k0 + kk) * 1024 + 256 * jj);
                float p[4];
#pragma unroll
                for (int kk = 0; kk < 4; ++kk) { p[kk] = 0.f;
#pragma unroll
                    for (int jj = 0; jj < 4; ++jj) p[kk] += (v[q][jj][0] * w[kk][jj][0] + v[q][jj][1] * w[kk][jj][1]) + (v[q][jj][2] * w[kk][jj][2] + v[q][jj][3] * w[kk][jj][3]); }
#pragma unroll
                for (int kk = 0; kk < 4; ++kk) ev[k0 + kk] = wave_sum(p[kk]); }
            int i0 = 0; float v0 = ev[0];
#pragma unroll
            for (int jj = 1; jj < 8; ++jj) if (ev[jj] > v0) { v0 = ev[jj]; i0 = jj; }
            int i1 = -1; float v1 = -INFINITY;
#pragma unroll
            for (int jj = 0; jj < 8; ++jj) if (jj != i0 && ev[jj] > v1) { v1 = ev[jj]; i1 = jj; }
            const float tt = __expf(v1 - v0), den = __builtin_amdgcn_rcpf(1.0f + tt);
            rw0[q] = gwt * den; rw1[q] = gwt * tt * den; re0[q] = 8 * gi + i0; re1[q] = 8 * gi + i1;
        }
        if (F.lane == 0) {
#pragma unroll
            for (int q = 0; q < R; ++q) if (j0 + q < nj) {
                const int k0 = atomicAdd((int*)(lcnt + re0[q]), 1), k1 = atomicAdd((int*)(lcnt + re1[q]), 1);
                LAS int* rp = rec + (j0 + q) * 8; rp[0] = re0[q]; rp[1] = re1[q]; rp[2] = k0; rp[3] = k1; rp[4] = __float_as_int(rw0[q]); rp[5] = __float_as_int(rw1[q]); rp[6] = rows[q]; }
        }
    }
    __syncthreads();
    if (F.tid < NEXP) { const int c = lcnt[F.tid]; lcnt[32 + F.tid] = c ? (int)atomicAdd(cnt + F.tid * 64, (unsigned)c) : 0; }
    __syncthreads();
    for (int j = F.tid; j < nj; j += NWAVES * 64) { const LAS int* rp = rec + j * 8; const int e0 = rp[0], e1 = rp[1], r = rp[6];
        const int k0 = lcnt[32 + e0] + rp[2], k1 = lcnt[32 + e1] + rp[3]; const float w0 = __int_as_float(rp[4]), w1 = __int_as_float(rp[5]);
        rte[r] = e0; rte[TT + r] = e1; rtr[r] = k0; rtr[TT + r] = k1;
        tokr[(size_t)e0 * MOE_CAP + k0] = r; tokr[(size_t)e1 * MOE_CAP + k1] = r; wr[(size_t)e0 * MOE_CAP + k0] = w0; wr[(size_t)e1 * MOE_CAP + k1] = w1; }
    __syncthreads();
}
__device__ __forceinline__ void moe_offsets(const Frame& F, unsigned* cnt) {
    LAS int* offs = (LAS int*)(F.lds + LDS_OFFS);
    __syncthreads();
    if (F.tid < NEXP) offs[64 + F.tid] = (int)__hip_atomic_load(cnt + F.tid * 64, RLX_AGENT);
    __syncthreads();
    if (F.tid == 0) { int run = 0; for (int e = 0; e < NEXP; ++e) { offs[e] = run; run += (offs[64 + e] + 255) & ~255; } offs[32] = run; }
    __syncthreads();
}
__device__ __forceinline__ void ph_bpost(const Frame& F0, const Args& a, int l, const bf16* Ob, bf16* Y, bool latent_only) {
    const Frame F = local_frame(F0);
    const float lam_init = (l == 0) ? 0.2f : (0.8f - 0.6f * 0.74081822068f);
    const float s1 = wave_sum(a.in[I_LQ1][l * 64 + F.lane] * a.in[I_LK1][l * 64 + F.lane]), s2 = wave_sum(a.in[I_LQ2][l * 64 + F.lane] * a.in[I_LK2][l * 64 + F.lane]);
    const float lam = expf(s1) - expf(s2) + lam_init, post = 1.0f - lam_init;
    const int n = F.lane >> 4, dd = (F.lane & 15) * 8;
    const f32x4 g0 = *(const f32x4*)(a.in[I_SUBLN] + l * 128 + dd), g1 = *(const f32x4*)(a.in[I_SUBLN] + l * 128 + dd + 4);
    const int gw = F.bid * NWAVES + F.wave, NGW = F.G * NWAVES; const int nrows = latent_only ? NB * SEQL : TT;
    for (int q0 = gw; q0 < nrows; q0 += 4 * NGW) { v4u oa[4], ob[4]; int rr[4];
#pragma unroll
        for (int k = 0; k < 4; ++k) { int q = q0 + k * NGW; if (q >= nrows) q = q0; const int r = latent_only ? latrow(q) : q; rr[k] = r;
            oa[k] = *(const v4u*)(Ob + (size_t)r * OBW + (2 * n) * 128 + dd); ob[k] = *(const v4u*)(Ob + (size_t)r * OBW + (2 * n + 1) * 128 + dd); }
#pragma unroll
        for (int k = 0; k < 4; ++k) { if (k > 0 && q0 + k * NGW >= nrows) break; const v4u o0 = oa[k], o1 = ob[k]; const int r = rr[k];
            float d[8];
            d[0] = bflo(o0.x) - lam * bflo(o1.x); d[1] = bfhi(o0.x) - lam * bfhi(o1.x); d[2] = bflo(o0.y) - lam * bflo(o1.y); d[3] = bfhi(o0.y) - lam * bfhi(o1.y);
            d[4] = bflo(o0.z) - lam * bflo(o1.z); d[5] = bfhi(o0.z) - lam * bfhi(o1.z); d[6] = bflo(o0.w) - lam * bflo(o1.w); d[7] = bfhi(o0.w) - lam * bfhi(o1.w);
            float ss = 0.f;
#pragma unroll
            for (int j = 0; j < 8; ++j) ss += d[j] * d[j];
            ss += dpp_f<0xB1>(ss); ss += dpp_f<0x4E>(ss); ss += dpp_f<0x141>(ss); ss += dpp_f<0x140>(ss);
            const float rs = post / sqrtf(ss * (1.0f / 128.0f) + 1e-6f);
            v4u w; w.x = pk2(d[0] * rs * g0[0], d[1] * rs * g0[1]); w.y = pk2(d[2] * rs * g0[2], d[3] * rs * g0[3]); w.z = pk2(d[4] * rs * g1[0], d[5] * rs * g1[1]); w.w = pk2(d[6] * rs * g1[2], d[7] * rs * g1[3]);
            *(v4u*)(Y + (size_t)r * YW + 512 + n * 128 + dd) = w; } }
}
__device__ __forceinline__ void ph_attention(const Frame& F0, const Args& a, int l, const bf16* P, bf16* Y, bf16* Ob) {
    const Frame F = local_frame(F0);
    using attn_body::AttnU; typedef attn_body::bf16 abf;
    char* shm = (char*)(F.lds + RING_OFF);
    const abf* Pb = (const abf*)P; abf* Yb = (abf*)Y; abf* Obb = (abf*)Ob;
    const float* sinkp = a.in[I_SINK] + l * 8;
    float bnd[3];
    { const int gq[3] = {I_AQN, I_BQN, I_CQN}, gk[3] = {I_AKN, I_BKN, I_CKN};
#pragma unroll
      for (int t = 0; t < 3; ++t) { float mq = fabsf(a.in[gq[t]][l * 64 + F.lane]), mk = fabsf(a.in[gk[t]][l * 64 + F.lane]);
#pragma unroll
          for (int o = 1; o < 64; o <<= 1) { mq = fmaxf(mq, __shfl_xor(mq, o)); mk = fmaxf(mk, __shfl_xor(mk, o)); }
          bnd[t] = __int_as_float(__builtin_amdgcn_readfirstlane(__float_as_int(QSCALE * 64.0f * mq * mk))); } }
    const bool frA = bnd[0] <= 64.0f, frB = bnd[1] <= 64.0f, frC = bnd[2] <= 64.0f;
#define RUN_UNIT(WIN_, fr_, U_) do { if (fr_) attn_body::attn_unit<WIN_, 8, true>(U_, shm); else attn_body::attn_unit<WIN_, 8, false>(U_, shm); } while (0)
    for (int L = F.bid; L < 1024; L += F.G) { const int b = L & 7, s = L >> 3, kh = s >> 6, qb = s & 63; const size_t rb = (size_t)b * TOKB;
        AttnU U; U.q = Pb + (rb + qb * 64) * PW + PC_AQ + kh * 256; U.k = Pb + rb * PW + PC_AK + kh * 64; U.v = Pb + rb * PW + PC_AV + kh * 64;
        U.o = Yb + (rb + qb * 64) * YW + kh * 256; U.opitch = YW; U.rmask = 1; U.rshift = 1; U.NT = 68; U.kbase = 0; U.jq = 0; U.sinkp = nullptr; U.mref = bnd[0];
        RUN_UNIT(false, frA, U); }
    for (int L = F.bid; L < 1024; L += F.G) { const int b = L & 7, s = L >> 3, combo = s >> 4, qb = s & 15, n = combo >> 1, c = combo & 1; const size_t rb = (size_t)b * TOKB;
        AttnU U; U.q = Pb + (rb + qb * 256) * PW + PC_BQ + (2 * n + c) * 64; U.k = Pb + rb * PW + PC_BK + (2 * n + c) * 64; U.v = Pb + rb * PW + PC_BV + n * 128;
        U.o = Obb + (rb + qb * 256) * OBW + (2 * n + c) * 128; U.opitch = OBW; U.rmask = 7; U.rshift = 3; U.NT = 68; U.kbase = 0; U.jq = 0; U.sinkp = nullptr; U.mref = bnd[1];
        if (frB) attn_body::attn_unit_b<8, true>(U, shm); else attn_body::attn_unit_b<8, false>(U, shm); }
#ifndef DUP_C
#define DUP_C 1
#endif
    for (int repc = 0; repc < DUP_C; ++repc)
    for (int L = F.bid; L < 1024; L += F.G) { const int b = L & 7, s = L >> 3, kh = s >> 6, qb = s & 63; const size_t rb = (size_t)b * TOKB;
        AttnU U; U.q = Pb + (rb + qb * 64) * PW + PC_CQ + kh * 256; U.k = Pb + rb * PW + PC_CK + kh * 64; U.v = Pb + rb * PW + PC_CV + kh * 64;
        U.o = Yb + (rb + qb * 64) * YW + 1024 + kh * 256; U.opitch = YW; U.rmask = 1; U.rshift = 1; U.NT = 10; U.kbase = 0; U.jq = qb; U.sinkp = sinkp + kh * 4; U.mref = bnd[2];
        RUN_UNIT(true, frC, U); }
    if (l == 0) {
        for (int L = F.bid; L < 256; L += F.G) { const int b = L & 7, s = L >> 3; const size_t rb = (size_t)b * TOKB; AttnU U; U.NT = 4; U.kbase = SEQL; U.jq = 0; U.sinkp = nullptr;
            if (s < 8) { const int kh = s >> 2, qb = s & 3;
                U.q = Pb + (rb + SEQL + qb * 64) * PW + PC_AQ + kh * 256; U.k = Pb + rb * PW + PC_AK + kh * 64; U.v = Pb + rb * PW + PC_AV + kh * 64;
                U.o = Yb + (rb + SEQL + qb * 64) * YW + kh * 256; U.opitch = YW; U.rmask = 1; U.rshift = 1; }
            else if (s < 24) { const int combo = (s - 8) >> 1, vh = (s - 8) & 1, n = combo >> 1, c = combo & 1;
                U.q = Pb + (rb + SEQL) * PW + PC_BQ + (2 * n + c) * 64; U.k = Pb + rb * PW + PC_BK + (2 * n + c) * 64; U.v = Pb + rb * PW + PC_BV + n * 128 + vh * 64;
                U.o = Obb + (rb + SEQL) * OBW + (2 * n + c) * 128 + vh * 64; U.opitch = OBW; U.rmask = 7; U.rshift = 3; }
            else { const int s2 = s - 24, kh = s2 >> 2, qb = s2 & 3;
                U.q = Pb + (rb + SEQL + qb * 64) * PW + PC_CQ + kh * 256; U.k = Pb + rb * PW + PC_CK + kh * 64; U.v = Pb + rb * PW + PC_CV + kh * 64;
                U.o = Yb + (rb + SEQL + qb * 64) * YW + 1024 + kh * 256; U.opitch = YW; U.rmask = 1; U.rshift = 1; U.sinkp = sinkp + kh * 4; }
            U.mref = 0.f; attn_body::attn_unit<false, 8, false>(U, shm); }
    }
}

constexpr int NPHASE = 22;
__global__ void __launch_bounds__(NWAVES * 64, 2) fwd_kernel(Args args) {
    extern __shared__ __attribute__((aligned(16))) unsigned char lds[];
    Frame F; F.lds = (LAS unsigned char*)lds; F.tid = threadIdx.x; F.lane = F.tid & 63; F.wave = __builtin_amdgcn_readfirstlane(F.tid >> 6); F.G = gridDim.x; F.bid = blockIdx.x;
    unsigned char* ws = args.ws;
    unsigned* ctl = (unsigned*)(ws + WS_CTL);
    float* MOD = (float*)(ws + WS_SMALL + SM_MOD); float* ROPE = (float*)(ws + WS_SMALL + SM_ROPE); float* WRT = (float*)(ws + WS_SMALL + SM_WRT);
    int* RTE = (int*)(ws + WS_SMALL + SM_RTE); int* RTR = (int*)(ws + WS_SMALL + SM_RTR);
    bf16* WINT = (bf16*)(ws + WS_WATT); bf16* WBRT = WINT + (size_t)6144 * 1024; bf16* WOT = WBRT + (size_t)3 * 1024 * 512;
    float* XCTX = (float*)(ws + WS_XCTX); int* TOKR = (int*)(ws + WS_TOKR); float* WRW = (float*)(ws + WS_WR);
    bf16* P = (bf16*)(ws + WS_RP); bf16* MB = (bf16*)(ws + WS_RP); bf16* YOUT = (bf16*)(ws + WS_RP);
    bf16* Gt = (bf16*)(ws + WS_RG); bf16* W1T = (bf16*)(ws + WS_W1T); bf16* W2T = (bf16*)(ws + WS_W2T); bf16* ACT = (bf16*)(ws + WS_ACT);
    bf16* Y = (bf16*)(ws + WS_RY); bf16* H = (bf16*)(ws + WS_RY); bf16* OB = (bf16*)(ws + WS_RO);
    for (int u = F.tid; u < (LDS_BYTES - LDSCTL_OFF) / 4; u += NWAVES * 64) ((LAS unsigned*)(F.lds + LDSCTL_OFF))[u] = 0u;
    __syncthreads();
    volatile LAS unsigned* MISC = (volatile LAS unsigned*)(F.lds + MISC_OFF);
    XcdBarrier bar; bar.bar = ctl + CW_BAR; bar.x = 0; bar.st = nullptr;
    const int lo = args.ph_lo, hi = args.ph_hi;
    if (hi - lo > 1) bar = xcd_barrier_post(ctl + CW_BAR, MISC + 8);
#ifndef SITE_MASK
#define SITE_MASK 0xFFFF
#endif
#define SITE(j) (((SITE_MASK) >> (j)) & 1)
#ifndef DUP_MASK
#define DUP_MASK 0
#endif
#ifndef DRY_MODE
#define DRY_MODE 0
#endif
#define DUP(j) for (int rep_ = 0; rep_ < 1 + ((((DUP_MASK) >> (j)) & 1) && (l == 0 || ((j) != 6))); ++rep_)
#define DUPBAR() do { if (rep_) xcd_barrier(bar); } while (0)
#define IN(k) (lo <= (k) && (k) < hi)
#ifndef PROBE_TIME
#define PROBE_TIME 0
#endif
#if PROBE_TIME
    volatile LAS unsigned* TSL = (volatile LAS unsigned*)(F.lds + LDSCTL_OFF + 4096);
    if (F.tid == 0) { const unsigned long long t0 = __builtin_amdgcn_s_memrealtime(); TSL[16] = (unsigned)t0; TSL[17] = (unsigned)(t0 >> 32); }
#define STAMP(j) do { if (F.tid == 0) { const unsigned long long now_ = __builtin_amdgcn_s_memrealtime(); const unsigned long long last_ = ((unsigned long long)TSL[17] << 32) | TSL[16]; \
        TSL[j] += (unsigned)(now_ - last_); TSL[16] = (unsigned)now_; TSL[17] = (unsigned)(now_ >> 32); } } while (0)
#else
#define STAMP(j) do { } while (0)
#endif
#define SEAM(k, j) do { if (IN(k) && IN((k) + 1)) xcd_barrier(bar); STAMP(j); } while (0)

    { const int l = 0; if (SITE(0) && IN(0)) DUP(0) { DUPBAR(); ph_prologue(F, args, MOD, ROPE); } } SEAM(0, 0);
#pragma nounroll
    for (int l = 0; l < 2; ++l) {
        const int pb = 1 + 10 * l; const float* modl = MOD + (size_t)l * 9 * 6144;
        const bool lat_only = (l == 1);
        const float* srcL = (l == 0) ? args.in[I_X] : args.out; const float* srcC = (l == 0) ? args.in[I_CTX] : XCTX;
        if (SITE(1) && IN(pb + 0)) DUP(1) { DUPBAR();
            ph_conv_attn(F, args, l, WINT, WBRT, WOT, WRT);
            if (l == 0) ph_norm1_l0(F, args, modl, H);
            else { moe_offsets(F, ctl + CW_CNT); const bool dry_ = (((DUP_MASK) >> 1) & 1) && rep_ == 0;
                ph_combine<true>(F, dry_ ? (float*)(ws + WS_RG) : args.out, dry_ ? (float*)(ws + WS_RG + 160 * MiB) : XCTX, MOD, modl, YOUT, RTE, RTR, dry_ ? OB : H, false, dry_ ? args.out : nullptr, dry_ ? XCTX : nullptr); }
        } SEAM(pb + 0, 1);
        if (SITE(2) && IN(pb + 1)) DUP(2) { DUPBAR();
            pg8::Gemm g{DM, DM, DM}; pg8::SchedGrid2 S;
            if (l == 0) S.init(F.G, F.bid, H, DM, WINT, DM, 0, 24, 0, 0, 0, 0); else S.init(F.G, F.bid, H, DM, WINT, DM, 1, 24, 0, 2, 6, 6);
            pg8::EpiProj E{P, Gt, args.in[I_AQN], ROPE, (rep_ > 0) ? (DRY_MODE) : 0};
            LAS float* gl = (LAS float*)(F.lds + LDSCTL_OFF + 512);
            if (F.tid < 384) { const int w = F.tid >> 6, d = F.tid & 63; const int which[6] = {I_AQN, I_BQN, I_CQN, I_AKN, I_BKN, I_CKN}; gl[F.tid] = args.in[which[w]][l * 64 + d]; }
            __syncthreads();
            E.gains = (const float*)gl;
            pg8::gemm_phase<pg8::EpiProj, pg8::SchedGrid2, true>(F.lds + RING_OFF, g, S, E);
        } SEAM(pb + 1, 2);
        if (SITE(3) && IN(pb + 2)) DUP(3) { DUPBAR(); ph_attention(F, args, l, P, Y, OB); } SEAM(pb + 2, 3);
        if (SITE(4) && IN(pb + 3)) DUP(4) { DUPBAR(); ph_bpost(F, args, l, OB, Y, lat_only); } SEAM(pb + 3, 4);
        if (SITE(5) && IN(pb + 4)) DUP(5) { DUPBAR();
            pg8::Gemm g{YW, 512, 512}; pg8::SchedMerge S; S.init(F.G, F.bid, Y, WBRT, lat_only ? 1 : 0);
            pg8::EpiMerge E{Gt, MB};
            pg8::gemm_phase<pg8::EpiMerge, pg8::SchedMerge, true>(F.lds + RING_OFF, g, S, E);
        } SEAM(pb + 4, 5);
        if (SITE(6) && IN(pb + 5)) DUP(6) { DUPBAR();
            pg8::Gemm g{DM, DM, DM}; pg8::SchedGrid2 S; S.init(F.G, F.bid, MB, DM, WOT, DM, lat_only ? 1 : 0, 4, 0, 0, 0, 0);
            pg8::EpiOut E{srcL, srcC, args.out, XCTX, modl};
            pg8::gemm_phase<pg8::EpiOut, pg8::SchedGrid2, true>(F.lds + RING_OFF, g, S, E);
        } SEAM(pb + 5, 6);
        if (SITE(7) && IN(pb + 6)) DUP(7) { DUPBAR();
#ifndef DUP_CONVX
#define DUP_CONVX 1
#endif
#ifndef DUP_ROUTER
#define DUP_ROUTER 1
#endif
            for (int rc_ = 0; rc_ < DUP_CONVX; ++rc_) ph_conv_experts(F, args, l, W1T, W2T);
            ph_norm2_router<4>(F, args.out, XCTX, modl, WRT, H, RTE, RTR, TOKR, WRW, ctl + CW_CNT + (l + ((((DUP_MASK) >> 7) & 1) && rep_ == 0 ? 2 : 0)) * NEXP * 64, lat_only);
            for (int rr_ = 1; rr_ < DUP_ROUTER; ++rr_) ph_norm2_router<4>(F, args.out, XCTX, modl, WRT, H, (int*)(ws + WS_RO), (int*)(ws + WS_RO + 1 * MiB), (int*)(ws + WS_RO + 2 * MiB), (float*)(ws + WS_RO + 8 * MiB), ctl + CW_CNT + (l + 2 * rr_) * NEXP * 64, lat_only);
        } SEAM(pb + 6, 7);
        if (SITE(9) && IN(pb + 8)) DUP(9) { DUPBAR();
            moe_offsets(F, ctl + CW_CNT + l * NEXP * 64);
            pg8::Gemm g{DM, DM, DM}; pg8::SchedMoe S; S.init(F.G, F.bid, (const LAS int*)(F.lds + LDS_OFFS), TOKR, H, DM, W1T, DM, true);
            pg8::EpiAct E{ACT};
            pg8::gemm_phase<pg8::EpiAct, pg8::SchedMoe, true, true>(F.lds + RING_OFF, g, S, E);
        } SEAM(pb + 8, 9);
        if (SITE(10) && IN(pb + 9)) DUP(10) { DUPBAR();
            moe_offsets(F, ctl + CW_CNT + l * NEXP * 64);
            pg8::Gemm g{EHID, EHID, EHID}; pg8::SchedMoe S; S.init(F.G, F.bid, (const LAS int*)(F.lds + LDS_OFFS), TOKR, ACT, EHID, W2T, EHID, false);
            pg8::EpiDown E{YOUT, WRW};
            pg8::gemm_phase<pg8::EpiDown, pg8::SchedMoe, true>(F.lds + RING_OFF, g, S, E);
        } SEAM(pb + 9, 10);
    }
    if (SITE(11) && IN(21)) { const int l = 0; DUP(11) { DUPBAR(); moe_offsets(F, ctl + CW_CNT + NEXP * 64); const bool dry_ = (((DUP_MASK) >> 11) & 1) && rep_ == 0;
        ph_combine<false>(F, dry_ ? (float*)(ws + WS_RG) : args.out, XCTX, MOD + (size_t)9 * 6144, MOD, YOUT, RTE, RTR, H, true, dry_ ? args.out : nullptr, nullptr); } }
#if PROBE_TIME
    {   xcd_barrier(bar); STAMP(11);
        unsigned* TG = (unsigned*)(ws + WS_SMALL + 6 * MiB);
        if (F.bid == 0 && F.tid < 12) __hip_atomic_store(TG + F.tid, TSL[F.tid], RLX_AGENT);
        xcd_barrier(bar);
        unsigned tot = 0; for (int j = 0; j < 12; ++j) tot += __hip_atomic_load(TG + j, RLX_AGENT);
        const unsigned ta = (PROBE_A) >= 12 ? tot : __hip_atomic_load(TG + (PROBE_A) % 12, RLX_AGENT), tb = __hip_atomic_load(TG + (PROBE_B) % 12, RLX_AGENT);
        const float us_a = (float)ta * 0.01f;
        const float cval = sqrtf(us_a), vbig = 1000.0f * (float)tb / (float)tot;
        for (size_t i = (size_t)F.bid * NWAVES * 64 + F.tid; i < (size_t)NB * SEQL * DM; i += (size_t)F.G * NWAVES * 64) args.out[i] = (i == 12345) ? vbig : cval;
    }
#endif
#undef IN
#undef SEAM
}

extern "C" void kernel_launch(void* const* d_in, const int* in_sizes, int n_in, void* d_out, int out_size, void* d_ws, size_t ws_size, hipStream_t stream) {
    static int grid = 0;
    if (grid == 0) {
        if (n_in != 28 || out_size != NB * SEQL * DM || ws_size < WS_END) { fprintf(stderr, "kernel_launch: unexpected problem (n_in %d out %d ws %zu need %zu); nothing launched\n", n_in, out_size, ws_size, (size_t)WS_END); grid = -1; return; }
        int dev = 0, cus = 0;
        if (hipGetDevice(&dev) != hipSuccess || hipDeviceGetAttribute(&cus, hipDeviceAttributeMultiprocessorCount, dev) != hipSuccess) { grid = -1; return; }
        if (hipFuncSetAttribute((const void*)fwd_kernel, hipFuncAttributeMaxDynamicSharedMemorySize, LDS_BYTES) != hipSuccess) { fprintf(stderr, "kernel_launch: hipFuncSetAttribute failed\n"); grid = -1; return; }
        int per_cu = 0;
        if (hipOccupancyMaxActiveBlocksPerMultiprocessor(&per_cu, (const void*)fwd_kernel, NWAVES * 64, LDS_BYTES) != hipSuccess || per_cu < 1) fprintf(stderr, "kernel_launch: occupancy query says %d per CU\n", per_cu);
        (void)hipGetLastError();
        grid = cus;
        if (grid < 160 || grid > 1024) { fprintf(stderr, "kernel_launch: unexpected CU count %d; nothing launched\n", cus); grid = -1; return; }
    }
    if (grid < 0) return;
    if (hipMemsetAsync((char*)d_ws + WS_CTL, 0, CTL_ZERO_BYTES, stream) != hipSuccess) return;
    Args a{};
    for (int i = 0; i < 28; ++i) a.in[i] = (const float*)d_in[i];
    a.out = (float*)d_out; a.ws = (unsigned char*)d_ws;
#if defined(PROBE_CHECK) && PROBE_CHECK
    a.ph_lo = 0; a.ph_hi = 5;
    hipLaunchKernelGGL(fwd_kernel, dim3(grid), dim3(NWAVES * 64), LDS_BYTES, stream, a);
    unsigned* eb = (unsigned*)d_ws + 8;
    hipLaunchKernelGGL(chk_proj, dim3(64 * 96), dim3(64), 0, stream, a, eb);
    hipLaunchKernelGGL(chk_attn, dim3(64 * 24), dim3(64), 0, stream, a, eb + 1);
    hipLaunchKernelGGL(chk_fill, dim3(1024), dim3(256), 0, stream, (float*)d_out, eb, (size_t)out_size);
#elif MK_MULTI
    for (int p = 0; p < NPHASE; ++p) { a.ph_lo = p; a.ph_hi = p + 1; hipLaunchKernelGGL(fwd_kernel, dim3(grid), dim3(NWAVES * 64), LDS_BYTES, stream, a); }
#else
    a.ph_lo = 0; a.ph_hi = NPHASE;
    hipLaunchKernelGGL(fwd_kernel, dim3(grid), dim3(NWAVES * 64), LDS_BYTES, stream, a);
#endif
}
```

```cpp
#include <hip/hip_runtime.h>
#include <hip/hip_bf16.h>
#include <cstdio>
#include <cstdint>
#include <cmath>

#ifndef MK_MULTI
#define MK_MULTI 0
#endif

constexpr int DM = 1024, NB = 8, SEQL = 4096, CTXL = 256, TOKB = SEQL + CTXL  , TT = NB * TOKB  ;
constexpr int RT_PER_B = TOKB / 256  , NRT = TT / 256  ;
constexpr int PW = 3072, GW = 3072, YW = 1536, OBW = 1024;
constexpr int NEXP = 32, EHID = 512, SLOT_MAX = 2 * TT + NEXP * 256  , MOE_CAP = TT;
constexpr float QSCALE = 0.125f * 1.4426950408889634f;
constexpr float LOG2E = 1.4426950408889634f;
constexpr int PC_AQ = 0, PC_BQ = 512, PC_CQ = 1024, PC_AK = 1536, PC_AV = 1664, PC_BK = 1792, PC_BV = 2304, PC_CK = 2816, PC_CV = 2944;

constexpr size_t MiB = 1u << 20;
constexpr size_t WS_CTL = 0, CTL_ZERO_BYTES = 1 * MiB;
constexpr size_t WS_SMALL = 1 * MiB;
constexpr size_t WS_WATT = 8 * MiB;
constexpr size_t WS_XCTX = 26 * MiB;
constexpr size_t WS_RP = 34 * MiB;
constexpr size_t WS_RG = 238 * MiB;
constexpr size_t WS_RY = 442 * MiB;
constexpr size_t WS_RO = 544 * MiB;
constexpr size_t WS_TOKR = 612 * MiB;
constexpr size_t WS_WR = 617 * MiB;
constexpr size_t WS_END = 622 * MiB;
constexpr size_t WS_W1T = WS_RG, WS_W2T = WS_RG + 64 * MiB, WS_ACT = WS_RG + 96 * MiB;
constexpr size_t SM_MOD = 0;
constexpr size_t SM_ROPE = 512 * 1024;
constexpr size_t SM_WRT = 640 * 1024;
constexpr size_t SM_RTE = 1 * MiB;
constexpr size_t SM_RTR = SM_RTE + 512 * 1024;
static_assert(SM_RTR + 512 * 1024 <= 7 * MiB, "small map");
constexpr int CW_BAR = 4096;
constexpr int CW_CNT = 16384;

namespace pg8 {
#define PG8_LAS __attribute__((address_space(3)))
typedef unsigned short bf16_t;
typedef short bf16x8 __attribute__((ext_vector_type(8)));
typedef float f32x4 __attribute__((ext_vector_type(4)));
typedef unsigned u32x4 __attribute__((ext_vector_type(4)));
typedef unsigned u32x2 __attribute__((ext_vector_type(2)));
constexpr int BM = 256, BK = 64, HALF = 128, HTB = HALF * BK * 2  , STAGE_BYTES = 8 * HTB, NXCD = 8, WGM = 8;

__host__ __device__ __forceinline__ int lds_byte(int r, int c) { const int st = (r >> 4) * 2 + (c >> 5), rr = r & 15, cc = c & 31, ob = rr * 64 + cc * 2; return st * 1024 + (ob ^ (((ob >> 9) & 1) << 5)); }
__host__ __device__ __forceinline__ void stage_rc(int b, int& R, int& C) { const int st = b / 1024, sb = b % 1024, swz = sb ^ (((sb >> 9) & 1) << 5); R = (st >> 1) * 16 + swz / 64; C = (st & 1) * 32 + (swz % 64) / 2; }
__host__ __device__ __forceinline__ int perm32(int rho) { const int n = rho >> 4, i = rho & 15; return 8 * (i >> 2) + 4 * n + (i & 3); }

struct Unit { const char* a; const char* b; int pm, pn, aux, rank0, nv; };
struct Gemm { int lda, ldb, K; };

typedef float f32x2_t __attribute__((ext_vector_type(2))); typedef __bf16 bf16x2_t __attribute__((ext_vector_type(2)));
__device__ __forceinline__ unsigned cvt_pk_bf16(float lo, float hi) { f32x2_t v = {lo, hi}; bf16x2_t b = __builtin_convertvector(v, bf16x2_t); return __builtin_bit_cast(unsigned, b); }
__device__ __forceinline__ float fsigmoid(float x) { return __builtin_amdgcn_rcpf(1.0f + __builtin_amdgcn_exp2f(x * -1.4426950408889634f)); }
__device__ __forceinline__ float bf_lo(unsigned u) { return __uint_as_float(u << 16); }
__device__ __forceinline__ float bf_hi(unsigned u) { return __uint_as_float(u & 0xffff0000u); }

__device__ __forceinline__ void tile_order(int wgid, int nM, int nN, int& pm, int& pn) {
    const int nwg = nM * nN;
    { const int q = nwg / NXCD, r = nwg % NXCD, xcd = wgid % NXCD, off = wgid / NXCD; wgid = (xcd < r ? xcd * (q + 1) : r * (q + 1) + (xcd - r) * q) + off; }
    const int nig = WGM * nN, gid = wgid / nig, fm = gid * WGM, gsz = (nM - fm) < WGM ? (nM - fm) : WGM;
    pm = fm + ((wgid % nig) % gsz); pn = (wgid % nig) / gsz;
}

template <class Epi, class Sched, bool ALIGN_EPI, bool GATHER = false>
__device__ __forceinline__ void gemm_phase(PG8_LAS unsigned char* lds, const Gemm g, const Sched& S, const Epi& E) {
    int tid_ = threadIdx.x; asm volatile("" : "+v"(tid_));
    const int tid = tid_, wid = __builtin_amdgcn_readfirstlane(tid >> 6), lane = tid & 63, wr = wid >> 2, wc = wid & 3, fr = lane & 15, fq = lane >> 4;
    const int K = g.K, nt = K / BK;
    unsigned voffA[2], voffB[2], voffA1[2] = {0u, 0u}, nvA0[2] = {0u, 0u}, nvA1[2] = {0u, 0u};
    int stR[2], stC[2];
#pragma unroll
    for (int i = 0; i < 2; ++i) { int R, C; stage_rc(tid * 16 + i * 8192, R, C); const int Rb = Epi::PERM ? ((R & ~31) + perm32(R & 31)) : R; stR[i] = R; stC[i] = C;
        voffA[i] = (unsigned)(R * g.lda + C) * 2u; voffB[i] = (unsigned)(Rb * g.ldb + C) * 2u; }
    const size_t kstep = (size_t)(BK * 2);
    const size_t hstepA = (size_t)HALF * g.lda * 2, hstepB = (size_t)HALF * g.ldb * 2;
    const unsigned ldsw = (unsigned)wid * 1024u;
    const int aoff = lds_byte(wr * 64 + fr, fq * 8), boff = lds_byte(wc * 32 + fr, fq * 8);
#define PG8_SA(b, h) (((b) * 2 + (h)) * HTB)
#define PG8_SB(b, h) ((4 + (b) * 2 + (h)) * HTB)
#define PG8_STAGE(bufoff, gbase, voff) do { _Pragma("unroll") for (int _i = 0; _i < 2; ++_i) \
        __builtin_amdgcn_global_load_lds((const unsigned*)((const char*)(gbase) + (voff)[_i]), (PG8_LAS unsigned*)(lds + (bufoff) + ldsw + _i * 8192), 16, 0, 0); } while (0)
#define PG8_STAGEA(bufoff, gbase, h, V0, V1) do { if constexpr (GATHER) { if (h) PG8_STAGE(bufoff, gbase, V1); else PG8_STAGE(bufoff, gbase, V0); } else { PG8_STAGE(bufoff, (gbase) + ((h) ? hstepA : 0), V0); } } while (0)
#define PG8_LDA(dst, b, h) do { _Pragma("unroll") for (int m = 0; m < 4; ++m) _Pragma("unroll") for (int k = 0; k < 2; ++k) dst[m][k] = *(const PG8_LAS bf16x8*)(lds + PG8_SA(b, h) + aoff + m * 2048 + k * 1024); } while (0)
#define PG8_LDB(dst, b, h) do { _Pragma("unroll") for (int n = 0; n < 2; ++n) _Pragma("unroll") for (int k = 0; k < 2; ++k) dst[n][k] = *(const PG8_LAS bf16x8*)(lds + PG8_SB(b, h) + boff + n * 2048 + k * 1024); } while (0)
#define PG8_MMA(ai, bj, At, Bt) do { __builtin_amdgcn_s_setprio(1); _Pragma("unroll") for (int m = 0; m < 4; ++m) _Pragma("unroll") for (int n = 0; n < 2; ++n) _Pragma("unroll") for (int k = 0; k < 2; ++k) \
        acc[ai][bj][m][n] = __builtin_amdgcn_mfma_f32_16x16x32_bf16(Bt[n][k], At[m][k], acc[ai][bj][m][n], 0, 0, 0); __builtin_amdgcn_s_setprio(0); } while (0)
#define PG8_WAIT_V(n) asm volatile("s_waitcnt vmcnt(" #n ")" ::: "memory")
#define PG8_WAIT_L(n) asm volatile("s_waitcnt lgkmcnt(" #n ")" ::: "memory")
#define PG8_BAR __builtin_amdgcn_s_barrier()
#define PG8_SCHED __builtin_amdgcn_sched_barrier(0)
    Unit cur, nxt; int ui = 0;
    if (!S.next(0, cur)) return;
    f32x4 acc[2][2][4][2];
#pragma unroll
    for (int a = 0; a < 2; ++a)
#pragma unroll
        for (int b = 0; b < 2; ++b)
#pragma unroll
            for (int m = 0; m < 4; ++m)
#pragma unroll
                for (int n = 0; n < 2; ++n) acc[a][b][m][n] = (f32x4){0.f, 0.f, 0.f, 0.f};
    bf16x8 At[4][2], B0[2][2], B1[2][2];
    const char* cA = cur.a; const char* cB = cur.b;
    if constexpr (GATHER) S.rows(cur, stR, stC, g.lda, voffA, voffA1);
    PG8_STAGE(PG8_SB(0, 0), cB, voffB); PG8_STAGE(PG8_SB(0, 1), cB + hstepB, voffB); PG8_STAGEA(PG8_SA(0, 0), cA, 0, voffA, voffA1); PG8_STAGEA(PG8_SA(0, 1), cA, 1, voffA, voffA1);
    if (wr == 1) PG8_BAR;
    PG8_WAIT_V(2); PG8_BAR;
    PG8_STAGE(PG8_SB(1, 0), cB + kstep, voffB); PG8_STAGEA(PG8_SA(1, 0), cA + kstep, 0, voffA, voffA1); PG8_STAGE(PG8_SB(1, 1), cB + hstepB + kstep, voffB);
    PG8_WAIT_V(6); PG8_BAR;
    for (;;) {
        const bool has_next = S.next(ui + 1, nxt);
        const char* nA = has_next ? nxt.a : cA; const char* nB = has_next ? nxt.b : cB;
        if constexpr (GATHER) { if (has_next) S.rows(nxt, stR, stC, g.lda, nvA0, nvA1); else { nvA0[0] = voffA[0]; nvA0[1] = voffA[1]; nvA1[0] = voffA1[0]; nvA1[1] = voffA1[1]; } }
        for (int t = 0; t < nt; t += 2) {
            const bool last = (t == nt - 2);
            unsigned sA0[2], sA1[2];
            if constexpr (GATHER) { sA0[0] = last ? nvA0[0] : voffA[0]; sA0[1] = last ? nvA0[1] : voffA[1]; sA1[0] = last ? nvA1[0] : voffA1[0]; sA1[1] = last ? nvA1[1] : voffA1[1]; }
            else { sA0[0] = voffA[0]; sA0[1] = voffA[1]; sA1[0] = 0u; sA1[1] = 0u; }
            const char* a1 = cA + (size_t)(t + 1) * kstep;
            const char* a2 = last ? nA : cA + (size_t)(t + 2) * kstep; const char* b2 = last ? nB : cB + (size_t)(t + 2) * kstep;
            const char* a3 = a2 + kstep; const char* b3 = b2 + kstep;
            PG8_LDB(B0, 0, 0); PG8_LDB(B1, 0, 1); PG8_SCHED; PG8_LDA(At, 0, 0); PG8_STAGEA(PG8_SA(1, 1), a1, 1, voffA, voffA1);
            PG8_WAIT_V(8); PG8_WAIT_L(0); PG8_BAR; PG8_MMA(0, 0, At, B0); PG8_MMA(0, 1, At, B1); PG8_BAR; PG8_SCHED;
            PG8_LDA(At, 0, 1); PG8_STAGE(PG8_SB(0, 0), b2, voffB); PG8_STAGE(PG8_SB(0, 1), b2 + hstepB, voffB); PG8_STAGEA(PG8_SA(0, 0), a2, 0, sA0, sA1);
            PG8_WAIT_V(8); PG8_WAIT_L(0); PG8_BAR; PG8_MMA(1, 0, At, B0); PG8_MMA(1, 1, At, B1); PG8_BAR; PG8_SCHED;
            PG8_LDB(B0, 1, 0); PG8_LDB(B1, 1, 1); PG8_SCHED; PG8_LDA(At, 1, 0); PG8_STAGEA(PG8_SA(0, 1), a2, 1, sA0, sA1);
            PG8_WAIT_V(8); PG8_WAIT_L(0); PG8_BAR; PG8_MMA(0, 0, At, B0); PG8_MMA(0, 1, At, B1); PG8_BAR; PG8_SCHED;
            PG8_LDA(At, 1, 1); PG8_STAGE(PG8_SB(1, 0), b3, voffB); PG8_STAGE(PG8_SB(1, 1), b3 + hstepB, voffB); PG8_STAGEA(PG8_SA(1, 0), a3, 0, sA0, sA1);
            PG8_WAIT_V(8); PG8_WAIT_L(0); PG8_BAR; PG8_MMA(1, 0, At, B0); PG8_MMA(1, 1, At, B1); PG8_BAR; PG8_SCHED;
        }
        if constexpr (ALIGN_EPI) { if (wr == 0) PG8_BAR; }
        E(acc, cur, wr, wc, fr, fq);
        if (!has_next) break;
#pragma unroll
        for (int a = 0; a < 2; ++a)
#pragma unroll
            for (int b = 0; b < 2; ++b)
#pragma unroll
                for (int m = 0; m < 4; ++m)
#pragma unroll
                    for (int n = 0; n < 2; ++n) acc[a][b][m][n] = (f32x4){0.f, 0.f, 0.f, 0.f};
        cur = nxt; cA = nA; cB = nB; ++ui;
        if constexpr (GATHER) { voffA[0] = nvA0[0]; voffA[1] = nvA0[1]; voffA1[0] = nvA1[0]; voffA1[1] = nvA1[1]; }
        if constexpr (ALIGN_EPI) { if (wr == 1) PG8_BAR; }
    }
    PG8_WAIT_V(0);
    if constexpr (!ALIGN_EPI) { if (wr == 0) PG8_BAR; }
    PG8_BAR;
#undef PG8_SA
#undef PG8_SB
#undef PG8_STAGE
#undef PG8_STAGEA
#undef PG8_LDA
#undef PG8_LDB
#undef PG8_MMA
#undef PG8_WAIT_V
#undef PG8_WAIT_L
#undef PG8_BAR
#undef PG8_SCHED
}

struct EpiProj {
    static constexpr bool PERM = true;
    bf16_t* P; bf16_t* G; const float* gains  ; const float* rope  ; int dry;
    __device__ __forceinline__ void operator()(f32x4 (&acc)[2][2][4][2], const Unit& u, int wr, int wc, int fr, int fq) const {
        if (dry == 1) { float z = acc[0][0][0][0][0] + acc[1][1][3][1][3]; asm volatile("" :: "v"(z)); return; }
        const int t = u.pn, jt = u.pm % RT_PER_B; const bool isctx = (jt == RT_PER_B - 1);
        int mode = 0; const float* gain = gains; float scale = 1.f; bf16_t* outp; int ocol;
        if (t >= 12) { mode = 2; outp = G; ocol = (t - 12) * 256 + wc * 64; }
        else { outp = P; ocol = t * 256 + wc * 64;
            if (t < 6) { mode = 1; gain = gains + (t >> 1) * 64; scale = QSCALE; }
            else if (t == 6) { if (wc < 2) { mode = 1; gain = gains + 3 * 64; } }
            else if (t <= 8) { mode = 1; gain = gains + 4 * 64; }
            else if (t == 11) { if (wc < 2) { mode = 1; gain = gains + 5 * 64; } } }
        const int rin0 = wr * 64 + fr;
        f32x4 g0a = (f32x4){1.f, 1.f, 1.f, 1.f}, g0b = g0a, g1a = g0a, g1b = g0a;
        if (mode == 1) { g0a = *(const f32x4*)(gain + 8 * fq); g0b = *(const f32x4*)(gain + 8 * fq + 4); g1a = *(const f32x4*)(gain + 32 + 8 * fq); g1b = *(const f32x4*)(gain + 36 + 8 * fq); }
#pragma unroll
        for (int ai = 0; ai < 2; ++ai)
#pragma unroll
            for (int m = 0; m < 4; ++m) {
                const int rin = rin0 + ai * HALF + m * 16;
                f32x4 a0 = acc[ai][0][m][0], a1 = acc[ai][0][m][1], b0 = acc[ai][1][m][0], b1 = acc[ai][1][m][1];
                if (mode == 1) {
                    float ss = (a0[0] * a0[0] + a0[1] * a0[1]) + (a0[2] * a0[2] + a0[3] * a0[3]);
                    ss += (a1[0] * a1[0] + a1[1] * a1[1]) + (a1[2] * a1[2] + a1[3] * a1[3]);
                    ss += (b0[0] * b0[0] + b0[1] * b0[1]) + (b0[2] * b0[2] + b0[3] * b0[3]);
                    ss += (b1[0] * b1[0] + b1[1] * b1[1]) + (b1[2] * b1[2] + b1[3] * b1[3]);
                    ss += __shfl_xor(ss, 16); ss += __shfl_xor(ss, 32);
                    const float rs = __builtin_amdgcn_rsqf(ss * (1.0f / 64.0f) + 1e-6f);
                    a0 = a0 * rs * g0a; a1 = a1 * rs * g0b; b0 = b0 * rs * g1a; b1 = b1 * rs * g1b;
                    if (!isctx) {
                        const int pos = jt * 256 + rin;
                        const int nidx = (fq < 2) ? (pos >> 6) : (pos & 63);
                        const f32x4* cs = (const f32x4*)(rope + (nidx * 16 + 8 * (fq & 1)) * 2);
                        const f32x4 c01 = cs[0], c23 = cs[1], c45 = cs[2], c67 = cs[3];
#define ROT_(x1, x2, c, s) do { const float n1_ = (x1) * (c) - (x2) * (s), n2_ = (x1) * (s) + (x2) * (c); (x1) = n1_; (x2) = n2_; } while (0)
                        ROT_(a0[0], b0[0], c01[0], c01[1]); ROT_(a0[1], b0[1], c01[2], c01[3]); ROT_(a0[2], b0[2], c23[0], c23[1]); ROT_(a0[3], b0[3], c23[2], c23[3]);
                        ROT_(a1[0], b1[0], c45[0], c45[1]); ROT_(a1[1], b1[1], c45[2], c45[3]); ROT_(a1[2], b1[2], c67[0], c67[1]); ROT_(a1[3], b1[3], c67[2], c67[3]);
#undef ROT_
                    }
                    a0 = a0 * scale; a1 = a1 * scale; b0 = b0 * scale; b1 = b1 * scale;
                } else if (mode == 2) {
#pragma unroll
                    for (int j = 0; j < 4; ++j) { a0[j] = fsigmoid(a0[j]); a1[j] = fsigmoid(a1[j]); b0[j] = fsigmoid(b0[j]); b1[j] = fsigmoid(b1[j]); }
                }
                bf16_t* rowp = outp + (size_t)(u.pm * 256 + rin) * PW + ocol + 8 * fq;
                u32x4 w0, w1;
                w0.x = cvt_pk_bf16(a0[0], a0[1]); w0.y = cvt_pk_bf16(a0[2], a0[3]); w0.z = cvt_pk_bf16(a1[0], a1[1]); w0.w = cvt_pk_bf16(a1[2], a1[3]);
                w1.x = cvt_pk_bf16(b0[0], b0[1]); w1.y = cvt_pk_bf16(b0[2], b0[3]); w1.z = cvt_pk_bf16(b1[0], b1[1]); w1.w = cvt_pk_bf16(b1[2], b1[3]);
                if (dry == 2) { asm volatile("" :: "v"(w0), "v"(w1)); } else { *(u32x4*)(rowp) = w0; *(u32x4*)(rowp + 32) = w1; }
            }
    }
};
struct EpiMerge {
    static constexpr bool PERM = true;
    const bf16_t* G; bf16_t* Mb;
    __device__ __forceinline__ void operator()(f32x4 (&acc)[2][2][4][2], const Unit& u, int wr, int wc, int fr, int fq) const {
        const int br = u.aux; const int row0 = u.pm * 256 + wr * 64 + fr, col0 = u.pn * 256 + wc * 32 + 8 * fq;
#pragma unroll
        for (int ai = 0; ai < 2; ++ai) {
            u32x4 gv[4][2];
#pragma unroll
            for (int m = 0; m < 4; ++m)
#pragma unroll
                for (int bj = 0; bj < 2; ++bj) gv[m][bj] = *(const u32x4*)(G + (size_t)(row0 + ai * HALF + m * 16) * GW + br * 1024 + col0 + bj * HALF);
#pragma unroll
            for (int m = 0; m < 4; ++m)
#pragma unroll
                for (int bj = 0; bj < 2; ++bj) { const u32x4 g = gv[m][bj];
                    acc[ai][bj][m][0] = acc[ai][bj][m][0] * (f32x4){bf_lo(g.x), bf_hi(g.x), bf_lo(g.y), bf_hi(g.y)};
                    acc[ai][bj][m][1] = acc[ai][bj][m][1] * (f32x4){bf_lo(g.z), bf_hi(g.z), bf_lo(g.w), bf_hi(g.w)}; }
            if (br > 0) {
#pragma unroll
                for (int m = 0; m < 4; ++m)
#pragma unroll
                    for (int bj = 0; bj < 2; ++bj) gv[m][bj] = *(const u32x4*)(Mb + (size_t)(row0 + ai * HALF + m * 16) * DM + col0 + bj * HALF);
#pragma unroll
                for (int m = 0; m < 4; ++m)
#pragma unroll
                    for (int bj = 0; bj < 2; ++bj) { const u32x4 g = gv[m][bj];
                        acc[ai][bj][m][0] = acc[ai][bj][m][0] + (f32x4){bf_lo(g.x), bf_hi(g.x), bf_lo(g.y), bf_hi(g.y)};
                        acc[ai][bj][m][1] = acc[ai][bj][m][1] + (f32x4){bf_lo(g.z), bf_hi(g.z), bf_lo(g.w), bf_hi(g.w)}; }
            }
#pragma unroll
            for (int m = 0; m < 4; ++m)
#pragma unroll
                for (int bj = 0; bj < 2; ++bj) { const f32x4 v0 = acc[ai][bj][m][0], v1 = acc[ai][bj][m][1];
                    u32x4 w; w.x = cvt_pk_bf16(v0[0], v0[1]); w.y = cvt_pk_bf16(v0[2], v0[3]); w.z = cvt_pk_bf16(v1[0], v1[1]); w.w = cvt_pk_bf16(v1[2], v1[3]);
                    *(u32x4*)(Mb + (size_t)(row0 + ai * HALF + m * 16) * DM + col0 + bj * HALF) = w; }
        }
    }
};
struct EpiOut {
    static constexpr bool PERM = false;
    const float* srcL; const float* srcC; float* dstL; float* dstC; const float* modl  ;
    __device__ __forceinline__ void operator()(f32x4 (&acc)[2][2][4][2], const Unit& u, int wr, int wc, int fr, int fq) const {
        const int b = u.pm / RT_PER_B, jt = u.pm % RT_PER_B; const bool isctx = (jt == RT_PER_B - 1);
        const float* gate = modl + (size_t)(isctx ? 8 : b) * 6144 + 2 * 1024;
        const int col0 = u.pn * 256 + wc * 32 + 4 * fq;
        const float* sb = isctx ? srcC + (size_t)b * CTXL * DM : srcL + ((size_t)b * SEQL + jt * 256) * DM;
        float* db = isctx ? dstC + (size_t)b * CTXL * DM : dstL + ((size_t)b * SEQL + jt * 256) * DM;
        f32x4 gv[2][2];
#pragma unroll
        for (int bj = 0; bj < 2; ++bj)
#pragma unroll
            for (int n = 0; n < 2; ++n) gv[bj][n] = *(const f32x4*)(gate + col0 + bj * HALF + n * 16);
#pragma unroll
        for (int ai = 0; ai < 2; ++ai)
#pragma unroll
            for (int mh = 0; mh < 2; ++mh) { f32x4 xv[2][2][2];
#pragma unroll
                for (int m2 = 0; m2 < 2; ++m2)
#pragma unroll
                    for (int bj = 0; bj < 2; ++bj)
#pragma unroll
                        for (int n = 0; n < 2; ++n) xv[m2][bj][n] = *(const f32x4*)(sb + (size_t)(ai * HALF + wr * 64 + (2 * mh + m2) * 16 + fr) * DM + col0 + bj * HALF + n * 16);
#pragma unroll
                for (int m2 = 0; m2 < 2; ++m2)
#pragma unroll
                    for (int bj = 0; bj < 2; ++bj)
#pragma unroll
                        for (int n = 0; n < 2; ++n) *(f32x4*)(db + (size_t)(ai * HALF + wr * 64 + (2 * mh + m2) * 16 + fr) * DM + col0 + bj * HALF + n * 16) = xv[m2][bj][n] + gv[bj][n] * acc[ai][bj][2 * mh + m2][n]; }
    }
};
struct EpiAct {
    static constexpr bool PERM = true;
    bf16_t* act;
    __device__ __forceinline__ void operator()(f32x4 (&acc)[2][2][4][2], const Unit& u, int wr, int wc, int fr, int fq) const {
        const int row0 = u.pm * 256 + wr * 64 + fr, col0 = u.pn * 128 + wc * 16 + 4 * fq;
#pragma unroll
        for (int ai = 0; ai < 2; ++ai)
#pragma unroll
            for (int m = 0; m < 4; ++m) { bf16_t* rowp = act + (size_t)(row0 + ai * HALF + m * 16) * EHID + col0;
#pragma unroll
                for (int bj = 0; bj < 2; ++bj) { const f32x4 gt = acc[ai][bj][m][0], up = acc[ai][bj][m][1]; float o[4];
#pragma unroll
                    for (int j = 0; j < 4; ++j) o[j] = gt[j] * fsigmoid(gt[j]) * up[j];
                    u32x2 w; w.x = cvt_pk_bf16(o[0], o[1]); w.y = cvt_pk_bf16(o[2], o[3]);
                    *(u32x2*)(rowp + bj * 64) = w; } }
    }
};
struct EpiDown {
    static constexpr bool PERM = true;
    bf16_t* yout; const float* wr;
    __device__ __forceinline__ void operator()(f32x4 (&acc)[2][2][4][2], const Unit& u, int wr_, int wc, int fr, int fq) const {
        const int rin0 = wr_ * 64 + fr, col0 = u.pn * 256 + wc * 32 + 8 * fq;
        const float* wp = wr + (size_t)u.aux * MOE_CAP + u.rank0;
#pragma unroll
        for (int ai = 0; ai < 2; ++ai)
#pragma unroll
            for (int m = 0; m < 4; ++m) { const int rin = rin0 + ai * HALF + m * 16; const float sc = wp[rin < u.nv ? rin : 0]; bf16_t* rowp = yout + (size_t)(u.pm * 256 + rin) * DM + col0;
#pragma unroll
                for (int bj = 0; bj < 2; ++bj) { const f32x4 v0 = acc[ai][bj][m][0] * sc, v1 = acc[ai][bj][m][1] * sc;
                    u32x4 w; w.x = cvt_pk_bf16(v0[0], v0[1]); w.y = cvt_pk_bf16(v0[2], v0[3]); w.z = cvt_pk_bf16(v1[0], v1[1]); w.w = cvt_pk_bf16(v1[2], v1[3]);
                    *(u32x4*)(rowp + bj * HALF) = w; } }
    }
};

__device__ __forceinline__ int rowsel_count(int sel) { return sel == 0 ? NRT : (sel == 1 ? NB * 16 : NB); }
__device__ __forceinline__ int rowsel_map(int sel, int q) { return sel == 0 ? q : (sel == 1 ? q + (q >> 4) : q * RT_PER_B + (RT_PER_B - 1)); }
struct SchedGrid2 {
    int G, c;
    int sel0, nN0, pn00, cnt0;
    int sel1, nN1, pn01, cnt1;
    const char* A; const char* B; size_t astep, bstep;
    __device__ __forceinline__ void init(int G_, int c_, const void* A_, int lda, const void* B_, int ldb, int s0, int n0, int p0, int s1, int n1, int p1) {
        G = G_; c = c_; A = (const char*)A_; B = (const char*)B_; astep = (size_t)256 * lda * 2; bstep = (size_t)256 * ldb * 2;
        sel0 = s0; nN0 = n0; pn00 = p0; cnt0 = rowsel_count(s0) * n0; sel1 = s1; nN1 = n1; pn01 = p1; cnt1 = n1 ? rowsel_count(s1) * n1 : 0; }
    __device__ __forceinline__ bool next(int i, Unit& u) const {
        long L = (long)i * G + c; int pm, pn;
        if (L < cnt0) { tile_order((int)L, rowsel_count(sel0), nN0, pm, pn); pm = rowsel_map(sel0, pm); pn += pn00; }
        else { L -= cnt0; if (L >= cnt1) return false; tile_order((int)L, rowsel_count(sel1), nN1, pm, pn); pm = rowsel_map(sel1, pm); pn += pn01; }
        u.pm = pm; u.pn = pn; u.aux = 0; u.rank0 = 0; u.nv = 256; u.a = A + (size_t)pm * astep; u.b = B + (size_t)pn * bstep; return true; }
};
struct SchedMerge {
    int G, c, sel, ntile; const char* Y; const char* W;
    __device__ __forceinline__ void init(int G_, int c_, const void* Y_, const void* W_, int sel_) { G = G_; c = c_; Y = (const char*)Y_; W = (const char*)W_; sel = sel_; ntile = rowsel_count(sel_) * 4; }
    __device__ __forceinline__ bool next(int i, Unit& u) const {
        const int br = i % 3; const long L = (long)(i / 3) * G + c; if (L >= ntile) return false;
        int pm, pn; tile_order((int)L, rowsel_count(sel), 4, pm, pn); pm = rowsel_map(sel, pm);
        u.pm = pm; u.pn = pn; u.aux = br; u.rank0 = 0; u.nv = 256;
        u.a = Y + ((size_t)pm * 256 * YW + br * 512) * 2; u.b = W + ((size_t)br * 1024 * 512 + (size_t)pn * 256 * 512) * 2; return true; }
};
struct SchedMoe {
    int G, c, nrt; const PG8_LAS int* offs; const int* tokr; const char* A; const char* W; size_t astep, wexp, wstep; bool gather;
    __device__ __forceinline__ void init(int G_, int c_, const PG8_LAS int* offs_, const int* tokr_, const void* A_, int lda, const void* W_, int K, bool gather_) {
        G = G_; c = c_; offs = offs_; tokr = tokr_; nrt = offs_[32] >> 8; gather = gather_;
        A = (const char*)A_; W = (const char*)W_; astep = (size_t)256 * lda * 2; wexp = (size_t)1024 * K * 2; wstep = (size_t)256 * K * 2; }
    __device__ __forceinline__ bool next(int i, Unit& u) const {
        const long L = (long)i * G + c; const int rt = (int)(L >> 2), pn = (int)(L & 3); if (rt >= nrt) return false;
        int e = 0;
        for (int j = 1; j < NEXP; ++j) if ((offs[j] >> 8) <= rt) e = j;
        e = __builtin_amdgcn_readfirstlane(e);
        const int rank0 = (rt - (offs[e] >> 8)) * 256; int nv = offs[64 + e] - rank0; nv = nv > 256 ? 256 : nv;
        u.pm = rt; u.pn = pn; u.aux = e; u.rank0 = __builtin_amdgcn_readfirstlane(rank0); u.nv = __builtin_amdgcn_readfirstlane(nv);
        u.a = gather ? A : A + (size_t)rt * astep; u.b = W + (size_t)e * wexp + (size_t)pn * wstep; return true; }
    __device__ __forceinline__ void rows(const Unit& u, const int (&R)[2], const int (&C)[2], int lda, unsigned (&v0)[2], unsigned (&v1)[2]) const {
        const int* tp = tokr + (size_t)u.aux * MOE_CAP + u.rank0;
#pragma unroll
        for (int i = 0; i < 2; ++i) { const int r0 = R[i], r1 = R[i] + HALF;
            const int t0 = tp[r0 < u.nv ? r0 : 0], t1 = tp[r1 < u.nv ? r1 : 0];
            v0[i] = (unsigned)(t0 * lda + C[i]) * 2u; v1[i] = (unsigned)(t1 * lda + C[i]) * 2u; }
    }
};
}
namespace attn_body {
using bf16=__hip_bfloat16;
using bf16x8=__attribute__((ext_vector_type(8)))short;
using s16x4=__attribute__((ext_vector_type(4)))short;
using f32x16=__attribute__((ext_vector_type(16)))float;
using u32x4=__attribute__((ext_vector_type(4)))unsigned;
constexpr int D=64,DMP=PW;
constexpr int NW=8,QBLK=32,KVBLK=64;
__device__ __forceinline__ int crow(int r,int hi){return (r&3)+8*(r>>2)+4*hi;}
#define SBAR() __builtin_amdgcn_sched_barrier(0)
constexpr int NSLOT=3, SLOTB=8192;
constexpr int LDS_K=0, LDS_V=NSLOT*SLOTB, LDS_WS=2*NSLOT*SLOTB, LDS_OST=LDS_WS+NW*64*4, LDS_BYTES=LDS_OST+NW*4096;
__device__ __forceinline__ void glds16(const void*gsrc,unsigned lds_dst){unsigned keep;
  asm volatile("s_mov_b32 %0, m0\n\ts_mov_b32 m0, %2\n\ts_nop 0\n\tglobal_load_lds_dwordx4 %1, off\n\ts_mov_b32 m0, %0":"=&s"(keep):"v"(gsrc),"s"(lds_dst):"memory");}
__device__ __forceinline__ float max3f(float a,float b,float c){float r;asm("v_max3_f32 %0, %1, %2, %3":"=v"(r):"v"(a),"v"(b),"v"(c));return r;}
__device__ __forceinline__ float max2f(float a,float b){float r;asm("v_max_f32_e32 %0, %1, %2":"=v"(r):"v"(a),"v"(b));return r;}
__device__ __forceinline__ float fadd_s(float a,float b){float r;asm("v_add_f32_e32 %0, %1, %2":"=v"(r):"v"(a),"v"(b));return r;}
__device__ __forceinline__ float fsub_s(float a,float b){float r;asm("v_sub_f32_e32 %0, %1, %2":"=v"(r):"v"(a),"v"(b));return r;}
typedef float f32x2_t __attribute__((ext_vector_type(2))); typedef __bf16 bf16x2_t __attribute__((ext_vector_type(2)));
__device__ __forceinline__ unsigned cvtpk_s(float lo,float hi){f32x2_t v={lo,hi};bf16x2_t b=__builtin_convertvector(v,bf16x2_t);return __builtin_bit_cast(unsigned,b);}
#define WAIT_BAR(N) asm volatile("s_waitcnt vmcnt(" #N ") lgkmcnt(0)\n\ts_barrier":::"memory")

__device__ __forceinline__ void qkt(f32x16&p0,f32x16&p1,const char*Kslot,const bf16x8*qr,const f32x16&negm,int r32,int hi){
  const char*kb=Kslot+hi*1024+r32*16;
  #pragma unroll
  for(int d0=0;d0<4;++d0){
    const bf16x8 b0=*reinterpret_cast<const bf16x8*>(kb+d0*2048);
    const bf16x8 b1=*reinterpret_cast<const bf16x8*>(kb+d0*2048+512);
    if(d0==0){p0=__builtin_amdgcn_mfma_f32_32x32x16_bf16(b0,qr[0],negm,0,0,0);p1=__builtin_amdgcn_mfma_f32_32x32x16_bf16(b1,qr[0],negm,0,0,0);}
    else{p0=__builtin_amdgcn_mfma_f32_32x32x16_bf16(b0,qr[d0],p0,0,0,0);p1=__builtin_amdgcn_mfma_f32_32x32x16_bf16(b1,qr[d0],p1,0,0,0);}}
}
typedef __attribute__((address_space(3))) const char* lds_cptr;
typedef short v4i16_t __attribute__((ext_vector_type(4)));
__device__ __forceinline__ void kload8(bf16x8*kf,lds_cptr kp){
  kf[0]=*(const __attribute__((address_space(3))) bf16x8*)(kp);      kf[1]=*(const __attribute__((address_space(3))) bf16x8*)(kp+512);
  kf[2]=*(const __attribute__((address_space(3))) bf16x8*)(kp+2048); kf[3]=*(const __attribute__((address_space(3))) bf16x8*)(kp+2560);
  kf[4]=*(const __attribute__((address_space(3))) bf16x8*)(kp+4096); kf[5]=*(const __attribute__((address_space(3))) bf16x8*)(kp+4608);
  kf[6]=*(const __attribute__((address_space(3))) bf16x8*)(kp+6144); kf[7]=*(const __attribute__((address_space(3))) bf16x8*)(kp+6656);
}
__device__ __forceinline__ void kload2(bf16x8*kf,lds_cptr kp,int j){ kf[2*j]=*(const __attribute__((address_space(3))) bf16x8*)(kp+j*2048); kf[2*j+1]=*(const __attribute__((address_space(3))) bf16x8*)(kp+j*2048+512); }
__device__ __forceinline__ s16x4 vtr(lds_cptr p){ return __builtin_bit_cast(s16x4,__builtin_amdgcn_ds_read_tr16_b64_v4i16((__attribute__((address_space(3))) v4i16_t*)p)); }
__device__ __forceinline__ float rowmax(const f32x16&p0,const f32x16&p1){
  float a=max3f(p0[0],p0[1],p1[0]),b=max3f(p0[2],p0[3],p1[1]);a=max3f(a,p1[2],p1[3]);
  #pragma unroll
  for(int r=4;r<16;r+=4){a=max3f(a,p0[r],p0[r+1]);b=max3f(b,p0[r+2],p0[r+3]);a=max3f(a,p1[r],p1[r+1]);b=max3f(b,p1[r+2],p1[r+3]);}
  const float m=max2f(a,b);
  auto rr=__builtin_amdgcn_permlane32_swap(__float_as_uint(m),__float_as_uint(m),false,false);
  return max2f(__uint_as_float(rr[0]),__uint_as_float(rr[1]));
}
__device__ __forceinline__ void pv(f32x16*o,int vb,bf16x8 pa0,bf16x8 pa1,bf16x8 pa2,bf16x8 pa3){
  #pragma unroll
  for(int d0=0;d0<2;++d0){s16x4 lo[4],hi[4];
    #pragma unroll
    for(int ks=0;ks<4;++ks){
      asm volatile("ds_read_b64_tr_b16 %0,%1 offset:%c2":"=&v"(lo[ks]):"v"(vb),"i"(d0*4096+ks*1024):"memory");
      asm volatile("ds_read_b64_tr_b16 %0,%1 offset:%c2":"=&v"(hi[ks]):"v"(vb),"i"(d0*4096+ks*1024+512):"memory");}
    asm volatile("s_waitcnt lgkmcnt(0)":::"memory");SBAR();
    #define PK(k) (bf16x8){lo[k][0],lo[k][1],lo[k][2],lo[k][3],hi[k][0],hi[k][1],hi[k][2],hi[k][3]}
    o[d0]=__builtin_amdgcn_mfma_f32_32x32x16_bf16(pa0,PK(0),o[d0],0,0,0);
    o[d0]=__builtin_amdgcn_mfma_f32_32x32x16_bf16(pa1,PK(1),o[d0],0,0,0);
    o[d0]=__builtin_amdgcn_mfma_f32_32x32x16_bf16(pa2,PK(2),o[d0],0,0,0);
    o[d0]=__builtin_amdgcn_mfma_f32_32x32x16_bf16(pa3,PK(3),o[d0],0,0,0);
    #undef PK
  }
}
struct AttnU { const bf16* q; const bf16* k; const bf16* v; bf16* o; const float* sinkp; int opitch, rmask, rshift, NT, kbase, jq; float mref; };
__device__ __forceinline__ int win_tile(int t,int jq,int&lo,int&hi){
  int jt; lo=-1000; hi=1000;
  if(t==0) jt=jq;
  else if(t==1){ jt=jq-1; if(jt<0){jt=jq;lo=1000;hi=-1000;} }
  else if(t==2){ jt=jq+1; if(jt>63){jt=jq;lo=1000;hi=-1000;} }
  else if(t==3){ jt=jq-2; lo=0; if(jt<0){jt=jq;lo=1000;hi=-1000;} }
  else if(t==4){ jt=jq+2; hi=0; if(jt>63){jt=jq;lo=1000;hi=-1000;} }
  else if(t<9) jt=64+(t-5);
  else { jt=67; lo=1000; hi=-1000; }
  return jt*64;
}
__device__ __forceinline__ void wmask(f32x16&p0,f32x16&p1,int lo,int hi_,int dq){
  const float NEG=-INFINITY;
  #pragma unroll
  for(int r=0;r<16;++r){const int d=(r&3)+8*(r>>2)+dq; if(d<lo||d>hi_)p0[r]=NEG; if(d+32<lo||d+32>hi_)p1[r]=NEG;}
}
template<bool WIN> __device__ __forceinline__ int krow_of(int t,int kbase,int jq){ if constexpr(WIN){int lo_,hi_;return win_tile(t,jq,lo_,hi_);} else return kbase+t*KVBLK; }
template<bool WIN,int THRL,bool FR> __device__ __forceinline__ void attn_unit(const AttnU&U,char*shm){
  int tid_=threadIdx.x; asm volatile("":"+v"(tid_));
  const int tid=tid_,lane=tid&63,r32=lane&31,hi=lane>>5; const int wid=__builtin_amdgcn_readfirstlane(tid>>6);
  const int wrow=(wid&U.rmask)*QBLK, wcol=(wid>>U.rshift)*D;
  const bf16*Qw=U.q+(long)wrow*DMP+wcol;
  const bf16*Kh=U.k,*Vh=U.v;
  const unsigned lds0=(unsigned)(uintptr_t)shm;
  float*wsf=(float*)(shm+LDS_WS)+wid*64;
  const bf16*ksrc=Kh+(long)lane*DMP+wid*8;
  const bf16*vsrc=Vh+(long)(16*(wid&3)+(lane>>2))*DMP+(wid>>2)*32+(lane&3)*8;
  const unsigned kdst=lds0+LDS_K+wid*1024, vdst=lds0+LDS_V+wid*1024;
  const int NT=U.NT, kbase=U.kbase, jq=U.jq;
  #define KROW(t) krow_of<WIN>((t),kbase,jq)
  #define DMA_K(t,slot) glds16(ksrc+(long)KROW(t)*DMP,(unsigned)__builtin_amdgcn_readfirstlane(kdst+(slot)))
  #define DMA_V(t,slot) glds16(vsrc+(long)KROW(t)*DMP,(unsigned)__builtin_amdgcn_readfirstlane(vdst+(slot)))
  const int vb0=(int)(lds0+LDS_V)+((lane>>4)&1)*32+(lane&3)*8+(4*hi+((lane&15)>>2))*64;
  const char*Kbase=shm+LDS_K; bf16x8 kf[8];
  const lds_cptr shm3=(lds_cptr)shm; const lds_cptr kp0=shm3+LDS_K+hi*1024+r32*16; const lds_cptr vp0=shm3+LDS_V+((lane>>4)&1)*32+(lane&3)*8+(4*hi+((lane&15)>>2))*64;
  DMA_K(0,0);DMA_V(0,0);DMA_K(1,SLOTB);
  bf16x8 qr[4];
  #pragma unroll
  for(int d0=0;d0<4;++d0)qr[d0]=*reinterpret_cast<const bf16x8*>(&Qw[(long)r32*DMP+d0*16+hi*8]);
  float mhat=FR?U.mref:0.f,l_reg=0.f;f32x16 o[2];o[0]=f32x16{};o[1]=f32x16{};f32x16 negm=f32x16{};
  if constexpr(FR){ _Pragma("unroll") for(int r=0;r<16;++r)negm[r]=-mhat; }
  asm volatile("":"+v"(negm));
  const int dq=4*hi-((wid&1)*QBLK+r32);
  #define CMASK(P0,P1,t) do{ if constexpr(WIN){ int lo_,hi_; (void)win_tile((t),jq,lo_,hi_); if(lo_>-64||hi_<64) wmask(P0,P1,lo_,hi_,dq); } }while(0)
  bool resc=false;
  #define START(P0,P1) do{ if constexpr(!FR){ const float rm=rowmax(P0,P1); resc=false; \
    { const float dl=rm; mhat=fadd_s(mhat,dl); \
      _Pragma("unroll") for(int r=0;r<16;++r){P0[r]=fsub_s(P0[r],dl);P1[r]=fsub_s(P1[r],dl);} \
      _Pragma("unroll") for(int r=0;r<16;++r)negm[r]=-mhat; asm volatile("":"+v"(negm)); } } \
    _Pragma("unroll") for(int r=0;r<16;++r)P0[r]=__builtin_amdgcn_exp2f(P0[r]); }while(0)
  #define RESC() do{ if(!FR&&resc){ asm volatile("s_waitcnt lgkmcnt(0)":::"memory"); \
      _Pragma("unroll") for(int d_=0;d_<2;++d_) _Pragma("unroll") for(int r=0;r<16;++r)o[d_][r]*=wsf[crow(r,hi)]; } }while(0)
  f32x16 pA0,pA1,pB0,pB1;
  int sl_prev=0,sl_cur=0,sl_next=SLOTB;
  #define ROT() do{sl_prev=sl_cur;sl_cur=sl_next;sl_next=(sl_next==(NSLOT-1)*SLOTB)?0:sl_next+SLOTB;}while(0)
  DMA_K(2,2*SLOTB);
  WAIT_BAR(3);
  qkt(pA0,pA1,Kbase,qr,negm,r32,hi);asm volatile("s_nop 15\n\ts_nop 7":"+v"(pA0),"+v"(pA1));
  START(pA0,pA1);
  _Pragma("unroll") for(int r=0;r<16;++r)pA1[r]=__builtin_amdgcn_exp2f(pA1[r]);
  WAIT_BAR(0);
  DMA_K(3,0);DMA_V(1,SLOTB);
  ROT();
  kload8(kf,kp0+sl_cur);
  WAIT_BAR(2);
  s16x4 vlo[8],vhi[8]; u32x4 pw0,pw1,pw2,pw3;
  #define PKW(P,B) cvtpk_s(P[B],P[B+1])
  #define PAF(k) __builtin_bit_cast(bf16x8,pw##k)
  #define VFR(i) (bf16x8){vlo[i][0],vlo[i][1],vlo[i][2],vlo[i][3],vhi[i][0],vhi[i][1],vhi[i][2],vhi[i][3]}
  #define PIN(x) asm volatile("":"+v"(x))
  #define MX3(a,b,c) __builtin_fmaxf(__builtin_fmaxf((a),(b)),(c))
  #define GAPA(MF,A0,A1,A2,A3,W0,W1,PW_) do{ MF; sacc+=A0; sacc+=A1; sacc+=A2; sacc+=A3; PIN(sacc); W0; W1; PIN(PW_); SBAR(); }while(0)
  #define EX(v) __builtin_amdgcn_exp2f(v)
  #define GAPB(MF,X,B) do{ MF; X[B]=EX(X[B]); X[B+1]=EX(X[B+1]); X[B+2]=EX(X[B+2]); X[B+3]=EX(X[B+3]); PIN(X); SBAR(); }while(0)
  #define VRD(i) do{ vlo[i]=vtr(vp_+(((i)>>2)*4096+((i)&3)*1024)); vhi[i]=vtr(vp_+(((i)>>2)*4096+((i)&3)*1024+512)); }while(0)
  #define KRD(G_,j) do{ if(G_){ kload2(kf,kp0+sl_next,j); SBAR(); } }while(0)
  #define STEP(C0,C1,P0,P1,t,GK,GV,GL,DOMASK) do{ SBAR(); \
    const lds_cptr vp_=vp0+sl_prev; \
    VRD(0); SBAR(); float sacc=(P0[0]+P0[1]); \
    GAPA(C0=__builtin_amdgcn_mfma_f32_32x32x16_bf16(kf[0],qr[0],negm,0,0,0), P0[2],P0[3],P0[4],P0[5],     pw0[0]=PKW(P0,0), pw0[1]=PKW(P0,2), pw0); \
    VRD(4); SBAR(); GAPA(C1=__builtin_amdgcn_mfma_f32_32x32x16_bf16(kf[1],qr[0],negm,0,0,0), P0[6],P0[7],P0[8],P0[9],     pw0[2]=PKW(P0,4), pw0[3]=PKW(P0,6), pw0); \
    VRD(1); SBAR(); GAPA(C0=__builtin_amdgcn_mfma_f32_32x32x16_bf16(kf[2],qr[1],C0,0,0,0),   P0[10],P0[11],P0[12],P0[13], pw1[0]=PKW(P0,8), pw1[1]=PKW(P0,10), pw1); \
    VRD(5); SBAR(); GAPA(C1=__builtin_amdgcn_mfma_f32_32x32x16_bf16(kf[3],qr[1],C1,0,0,0),   P0[14],P0[15],P1[0],P1[1],   pw1[2]=PKW(P0,12),pw1[3]=PKW(P0,14), pw1); \
    VRD(2); SBAR(); GAPA(C0=__builtin_amdgcn_mfma_f32_32x32x16_bf16(kf[4],qr[2],C0,0,0,0),   P1[2],P1[3],P1[4],P1[5],     pw2[0]=PKW(P1,0), pw2[1]=PKW(P1,2), pw2); \
    VRD(6); SBAR(); GAPA(C1=__builtin_amdgcn_mfma_f32_32x32x16_bf16(kf[5],qr[2],C1,0,0,0),   P1[6],P1[7],P1[8],P1[9],     pw2[2]=PKW(P1,4), pw2[3]=PKW(P1,6), pw2); \
    VRD(3); SBAR(); GAPA(C0=__builtin_amdgcn_mfma_f32_32x32x16_bf16(kf[6],qr[3],C0,0,0,0),   P1[10],P1[11],P1[12],P1[13], pw3[0]=PKW(P1,8), pw3[1]=PKW(P1,10), pw3); \
    VRD(7); SBAR(); GAPA(C1=__builtin_amdgcn_mfma_f32_32x32x16_bf16(kf[7],qr[3],C1,0,0,0),   P1[14],P1[15],0.f,0.f,       pw3[2]=PKW(P1,12),pw3[3]=PKW(P1,14), pw3); \
    l_reg+=sacc; \
    if(GK){DMA_K((t)+3,sl_cur);} if(GV){DMA_V((t)+1,sl_next);} \
    if(DOMASK){ CMASK(C0,C1,t); } \
    if constexpr(!FR){ float a=MX3(C0[0],C0[1],C1[0]),b=MX3(C0[2],C0[3],C1[1]); a=MX3(a,C1[2],C1[3]); \
      _Pragma("unroll") for(int r=4;r<16;r+=4){a=MX3(a,C0[r],C0[r+1]);b=MX3(b,C0[r+2],C0[r+3]);a=MX3(a,C1[r],C1[r+1]);b=MX3(b,C1[r+2],C1[r+3]);} \
      float rm=__builtin_fmaxf(a,b); { auto rr=__builtin_amdgcn_permlane32_swap(__float_as_uint(rm),__float_as_uint(rm),false,false); rm=__builtin_fmaxf(__uint_as_float(rr[0]),__uint_as_float(rr[1])); } \
      resc=false; \
      if(__builtin_expect(__any(rm>(float)THRL),0)){ const float dl=__builtin_fmaxf(rm,0.f); mhat+=dl; \
        _Pragma("unroll") for(int r=0;r<16;++r){C0[r]-=dl;C1[r]-=dl;} \
        _Pragma("unroll") for(int r=0;r<16;++r)negm[r]=-mhat; asm volatile("":"+v"(negm)); \
        const float f=__builtin_amdgcn_exp2f(-dl); l_reg*=f; if(hi==0)wsf[r32]=f; resc=true; } } \
    SBAR(); \
    GAPB(o[0]=__builtin_amdgcn_mfma_f32_32x32x16_bf16(PAF(0),VFR(0),o[0],0,0,0), C0,0); \
    GAPB(o[1]=__builtin_amdgcn_mfma_f32_32x32x16_bf16(PAF(0),VFR(4),o[1],0,0,0), C0,4); \
    KRD(GL,0); GAPB(o[0]=__builtin_amdgcn_mfma_f32_32x32x16_bf16(PAF(1),VFR(1),o[0],0,0,0), C0,8); \
    KRD(GL,1); GAPB(o[1]=__builtin_amdgcn_mfma_f32_32x32x16_bf16(PAF(1),VFR(5),o[1],0,0,0), C0,12); \
    KRD(GL,2); GAPB(o[0]=__builtin_amdgcn_mfma_f32_32x32x16_bf16(PAF(2),VFR(2),o[0],0,0,0), C1,0); \
    KRD(GL,3); GAPB(o[1]=__builtin_amdgcn_mfma_f32_32x32x16_bf16(PAF(2),VFR(6),o[1],0,0,0), C1,4); \
    GAPB(o[0]=__builtin_amdgcn_mfma_f32_32x32x16_bf16(PAF(3),VFR(3),o[0],0,0,0), C1,8); \
    GAPB(o[1]=__builtin_amdgcn_mfma_f32_32x32x16_bf16(PAF(3),VFR(7),o[1],0,0,0), C1,12); \
    }while(0)
  int t=1;
  if constexpr(!WIN){
    for(;t+5<NT;t+=2){
      STEP(pB0,pB1,pA0,pA1,t,true,true,true,false);     WAIT_BAR(2); RESC(); ROT();
      STEP(pA0,pA1,pB0,pB1,t+1,true,true,true,false);   WAIT_BAR(2); RESC(); ROT();
    }
  }
  #define ENDW(tt) do{ if((tt)+3<NT){WAIT_BAR(2);} else if((tt)+2<NT){WAIT_BAR(1);} else {WAIT_BAR(0);} }while(0)
  for(;t+1<NT;t+=2){
    STEP(pB0,pB1,pA0,pA1,t,(t+3<NT),(t+1<NT),(t+1<NT),true);       ENDW(t);   RESC(); ROT();
    STEP(pA0,pA1,pB0,pB1,t+1,(t+4<NT),(t+2<NT),(t+2<NT),true);     ENDW(t+1); RESC(); ROT();
  }
  STEP(pB0,pB1,pA0,pA1,NT-1,false,false,false,true); RESC();
  { float sacc=pB0[0]+pB0[1]; _Pragma("unroll") for(int r=2;r<16;++r)sacc+=pB0[r]; _Pragma("unroll") for(int r=0;r<16;++r)sacc+=pB1[r]; l_reg+=sacc;
    pw0=(u32x4){PKW(pB0,0),PKW(pB0,2),PKW(pB0,4),PKW(pB0,6)};pw1=(u32x4){PKW(pB0,8),PKW(pB0,10),PKW(pB0,12),PKW(pB0,14)};pw2=(u32x4){PKW(pB1,0),PKW(pB1,2),PKW(pB1,4),PKW(pB1,6)};pw3=(u32x4){PKW(pB1,8),PKW(pB1,10),PKW(pB1,12),PKW(pB1,14)};
    SBAR(); pv(o,vb0+sl_cur,PAF(0),PAF(1),PAF(2),PAF(3)); }
  #undef PKW
  #undef PAF
  #undef VFR
  #undef PIN
  #undef MX3
  #undef GAPA
  #undef GAPB
  #undef EX
  #undef VRD
  #undef KRD
  #undef STEP
  #undef ENDW
  {auto rr=__builtin_amdgcn_permlane32_swap(__float_as_uint(l_reg),__float_as_uint(l_reg),false,false);l_reg=__uint_as_float(rr[0])+__uint_as_float(rr[1]);}
  if(U.sinkp){ const float sk=U.sinkp[wid>>U.rshift]; l_reg+=__builtin_amdgcn_exp2f(sk*LOG2E-mhat); }
  if(hi==0)wsf[32+r32]=l_reg;asm volatile("s_waitcnt lgkmcnt(0)":::"memory");
  float rli[16];
  #pragma unroll
  for(int r=0;r<16;++r)rli[r]=__builtin_amdgcn_rcpf(wsf[32+crow(r,hi)]);
  bf16*Ow=U.o+(long)wrow*U.opitch+wcol;
  { bf16*stg=(bf16*)(shm+LDS_OST)+wid*2048;
    #pragma unroll
    for(int r=0;r<16;++r){const int orow=crow(r,hi);
      #pragma unroll
      for(int d0=0;d0<2;++d0)stg[orow*64+d0*32+r32]=__float2bfloat16(o[d0][r]*rli[r]);}
    asm volatile("s_waitcnt lgkmcnt(0)":::"memory");
    #pragma unroll
    for(int i=0;i<4;++i){const int row=i*8+(lane>>3),ch=lane&7; const u32x4 v=*(const u32x4*)(stg+row*64+ch*8); *(u32x4*)(Ow+(long)row*U.opitch+ch*8)=v;} }
  asm volatile("s_waitcnt lgkmcnt(0)\n\ts_barrier":::"memory");
  #undef KROW
  #undef DMA_K
  #undef DMA_V
  #undef CMASK
  #undef START
  #undef RESC
  #undef ROT
}
#undef SBAR
#undef WAIT_BAR

constexpr int B_LDS_K=0, B_SLOTV=16384, B_LDS_V=NSLOT*SLOTB, B_LDS_WS=B_LDS_V+NSLOT*B_SLOTV, B_LDS_OST=B_LDS_WS+NW*64*4, B_LDS_BYTES=B_LDS_OST+NW*4096;
#define WAIT_BAR(N) asm volatile("s_waitcnt vmcnt(" #N ") lgkmcnt(0)\n\ts_barrier":::"memory")
#define SBAR() __builtin_amdgcn_sched_barrier(0)
template<int THRL,bool FR> __device__ __forceinline__ void attn_unit_b(const AttnU&U,char*shm){
  int tid_=threadIdx.x; asm volatile("":"+v"(tid_));
  const int tid=tid_,lane=tid&63,r32=lane&31,hi=lane>>5; const int wid=__builtin_amdgcn_readfirstlane(tid>>6);
  const int wrow=wid*QBLK;
  const bf16*Qw=U.q+(long)wrow*DMP;
  const unsigned lds0=(unsigned)(uintptr_t)shm;
  float*wsf=(float*)(shm+B_LDS_WS)+wid*64;
  const bf16*ksrc=U.k+(long)lane*DMP+wid*8;
  const bf16*vsrc=U.v+(long)(16*(wid&3)+(lane>>2))*DMP+(wid>>2)*32+(lane&3)*8;
  const unsigned kdst=lds0+B_LDS_K+wid*1024, vdst=lds0+B_LDS_V+wid*1024;
  const int NT=U.NT, kbase=U.kbase;
  #define DMA_K(t,slot) glds16(ksrc+(long)(kbase+(t)*KVBLK)*DMP,(unsigned)__builtin_amdgcn_readfirstlane(kdst+(slot)))
  #define DMA_V(t,slot) do{ glds16(vsrc+(long)(kbase+(t)*KVBLK)*DMP,(unsigned)__builtin_amdgcn_readfirstlane(vdst+2*(slot))); \
                            glds16(vsrc+(long)(kbase+(t)*KVBLK)*DMP+64,(unsigned)__builtin_amdgcn_readfirstlane(vdst+2*(slot)+8192)); }while(0)
  const char*Kbase=shm+B_LDS_K; bf16x8 kf[8];
  const lds_cptr shm3=(lds_cptr)shm; const lds_cptr kp0=shm3+B_LDS_K+hi*1024+r32*16; const lds_cptr vp0=shm3+B_LDS_V+((lane>>4)&1)*32+(lane&3)*8+(4*hi+((lane&15)>>2))*64;
  DMA_K(0,0);DMA_V(0,0);DMA_K(1,SLOTB);
  bf16x8 qr[4];
  #pragma unroll
  for(int d0=0;d0<4;++d0)qr[d0]=*reinterpret_cast<const bf16x8*>(&Qw[(long)r32*DMP+d0*16+hi*8]);
  float mhat=FR?U.mref:0.f,l_reg=0.f;f32x16 o[4];o[0]=f32x16{};o[1]=f32x16{};o[2]=f32x16{};o[3]=f32x16{};f32x16 negm=f32x16{};
  if constexpr(FR){ _Pragma("unroll") for(int r=0;r<16;++r)negm[r]=-mhat; }
  asm volatile("":"+v"(negm));
  bool resc=false;
  #define RESC() do{ if(!FR&&resc){ asm volatile("s_waitcnt lgkmcnt(0)":::"memory"); \
      _Pragma("unroll") for(int d_=0;d_<4;++d_) _Pragma("unroll") for(int r=0;r<16;++r)o[d_][r]*=wsf[crow(r,hi)]; } }while(0)
  f32x16 C0,C1; u32x4 pa0,pa1,pa2,pa3,pb0,pb1,pb2,pb3;
  int sl_prev=0,sl_cur=0,sl_next=SLOTB;
  #define ROT() do{sl_prev=sl_cur;sl_cur=sl_next;sl_next=(sl_next==(NSLOT-1)*SLOTB)?0:sl_next+SLOTB;}while(0)
  #define PKW(P,B) cvtpk_s(P[B],P[B+1])
  #define EX(v) __builtin_amdgcn_exp2f(v)
  #define PIN(x) asm volatile("":"+v"(x))
  #define MX3(a,b,c) __builtin_fmaxf(__builtin_fmaxf((a),(b)),(c))
  DMA_K(2,2*SLOTB);
  WAIT_BAR(3);
  qkt(C0,C1,Kbase,qr,negm,r32,hi);asm volatile("s_nop 15\n\ts_nop 7":"+v"(C0),"+v"(C1));
  { if constexpr(!FR){ const float rm=rowmax(C0,C1); mhat=fadd_s(mhat,rm);
    _Pragma("unroll") for(int r=0;r<16;++r){C0[r]=fsub_s(C0[r],rm);C1[r]=fsub_s(C1[r],rm);}
    _Pragma("unroll") for(int r=0;r<16;++r)negm[r]=-mhat; asm volatile("":"+v"(negm)); }
    _Pragma("unroll") for(int r=0;r<16;++r){C0[r]=EX(C0[r]);C1[r]=EX(C1[r]);}
    float sacc=0.f; _Pragma("unroll") for(int r=0;r<16;++r)sacc+=C0[r]; _Pragma("unroll") for(int r=0;r<16;++r)sacc+=C1[r]; l_reg+=sacc;
    pa0=(u32x4){PKW(C0,0),PKW(C0,2),PKW(C0,4),PKW(C0,6)};pa1=(u32x4){PKW(C0,8),PKW(C0,10),PKW(C0,12),PKW(C0,14)};pa2=(u32x4){PKW(C1,0),PKW(C1,2),PKW(C1,4),PKW(C1,6)};pa3=(u32x4){PKW(C1,8),PKW(C1,10),PKW(C1,12),PKW(C1,14)}; }
  WAIT_BAR(0);
  DMA_K(3,0);DMA_V(1,SLOTB);
  ROT();
  kload8(kf,kp0+sl_cur);
  WAIT_BAR(3);
  s16x4 vl0,vh0,vl1,vh1,vl2,vh2,vl3,vh3;
  #define VRDF(L,H,f) do{ L=vtr(vp_+(((f)&3)*4096+((f)>>2)*1024)); H=vtr(vp_+(((f)&3)*4096+((f)>>2)*1024+512)); }while(0)
  #define VFRF(L,H) (bf16x8){L[0],L[1],L[2],L[3],H[0],H[1],H[2],H[3]}
  #define PAFX(P,k) __builtin_bit_cast(bf16x8,P##k)
  #define KRD(G_,j) do{ if(G_){ kload2(kf,kp0+sl_next,j); SBAR(); } }while(0)
  #define GAPF(PP,PN,g,L,H,CX,ci) do{ \
    o[(g)&3]=__builtin_amdgcn_mfma_f32_32x32x16_bf16(PP,VFRF(L,H),o[(g)&3],0,0,0); \
    CX[ci]=EX(CX[ci]); CX[ci+1]=EX(CX[ci+1]); sacc+=CX[ci]; sacc+=CX[ci+1]; PN=PKW(CX,ci); PIN(sacc); PIN(PN); \
    if((g)+4<16){ VRDF(L,H,(g)+4); } SBAR(); }while(0)
  #define STEP(PP,PN,t,GK,GV,GL) do{ SBAR(); \
    C0=__builtin_amdgcn_mfma_f32_32x32x16_bf16(kf[0],qr[0],negm,0,0,0); C1=__builtin_amdgcn_mfma_f32_32x32x16_bf16(kf[1],qr[0],negm,0,0,0); \
    C0=__builtin_amdgcn_mfma_f32_32x32x16_bf16(kf[2],qr[1],C0,0,0,0);   C1=__builtin_amdgcn_mfma_f32_32x32x16_bf16(kf[3],qr[1],C1,0,0,0); \
    C0=__builtin_amdgcn_mfma_f32_32x32x16_bf16(kf[4],qr[2],C0,0,0,0);   C1=__builtin_amdgcn_mfma_f32_32x32x16_bf16(kf[5],qr[2],C1,0,0,0); \
    C0=__builtin_amdgcn_mfma_f32_32x32x16_bf16(kf[6],qr[3],C0,0,0,0);   C1=__builtin_amdgcn_mfma_f32_32x32x16_bf16(kf[7],qr[3],C1,0,0,0); \
    const lds_cptr vp_=vp0+2*sl_prev; \
    VRDF(vl0,vh0,0); VRDF(vl1,vh1,1); VRDF(vl2,vh2,2); VRDF(vl3,vh3,3); \
    if(GK){DMA_K((t)+3,sl_cur);} if(GV){DMA_V((t)+1,sl_next);} \
    SBAR(); \
    if constexpr(!FR){ float a=MX3(C0[0],C0[1],C1[0]),b=MX3(C0[2],C0[3],C1[1]); a=MX3(a,C1[2],C1[3]); \
      _Pragma("unroll") for(int r=4;r<16;r+=4){a=MX3(a,C0[r],C0[r+1]);b=MX3(b,C0[r+2],C0[r+3]);a=MX3(a,C1[r],C1[r+1]);b=MX3(b,C1[r+2],C1[r+3]);} \
      float rm=__builtin_fmaxf(a,b); { auto rr=__builtin_amdgcn_permlane32_swap(__float_as_uint(rm),__float_as_uint(rm),false,false); rm=__builtin_fmaxf(__uint_as_float(rr[0]),__uint_as_float(rr[1])); } \
      resc=false; \
      if(__builtin_expect(__any(rm>(float)THRL),0)){ const float dl=__builtin_fmaxf(rm,0.f); mhat+=dl; \
        _Pragma("unroll") for(int r=0;r<16;++r){C0[r]-=dl;C1[r]-=dl;} \
        _Pragma("unroll") for(int r=0;r<16;++r)negm[r]=-mhat; asm volatile("":"+v"(negm)); \
        const float f=__builtin_amdgcn_exp2f(-dl); l_reg*=f; if(hi==0)wsf[r32]=f; resc=true; } } \
    SBAR(); float sacc=0.f; \
    GAPF(PAFX(PP,0),PN##0[0],0,vl0,vh0,C0,0);  GAPF(PAFX(PP,0),PN##0[1],1,vl1,vh1,C0,2);  GAPF(PAFX(PP,0),PN##0[2],2,vl2,vh2,C0,4);  GAPF(PAFX(PP,0),PN##0[3],3,vl3,vh3,C0,6); \
    KRD(GL,0); GAPF(PAFX(PP,1),PN##1[0],4,vl0,vh0,C0,8);  KRD(GL,1); GAPF(PAFX(PP,1),PN##1[1],5,vl1,vh1,C0,10); \
    KRD(GL,2); GAPF(PAFX(PP,1),PN##1[2],6,vl2,vh2,C0,12); KRD(GL,3); GAPF(PAFX(PP,1),PN##1[3],7,vl3,vh3,C0,14); \
    GAPF(PAFX(PP,2),PN##2[0],8,vl0,vh0,C1,0);  GAPF(PAFX(PP,2),PN##2[1],9,vl1,vh1,C1,2);  GAPF(PAFX(PP,2),PN##2[2],10,vl2,vh2,C1,4); GAPF(PAFX(PP,2),PN##2[3],11,vl3,vh3,C1,6); \
    GAPF(PAFX(PP,3),PN##3[0],12,vl0,vh0,C1,8); GAPF(PAFX(PP,3),PN##3[1],13,vl1,vh1,C1,10); GAPF(PAFX(PP,3),PN##3[2],14,vl2,vh2,C1,12); GAPF(PAFX(PP,3),PN##3[3],15,vl3,vh3,C1,14); \
    l_reg+=sacc; \
    }while(0)
  int t=1;
  for(;t+5<NT;t+=2){
    STEP(pa,pb,t,true,true,true);     WAIT_BAR(3); RESC(); ROT();
    STEP(pb,pa,t+1,true,true,true);   WAIT_BAR(3); RESC(); ROT();
  }
  #define ENDW(tt) do{ if((tt)+3<NT){WAIT_BAR(3);} else if((tt)+2<NT){WAIT_BAR(2);} else {WAIT_BAR(0);} }while(0)
  for(;t+1<NT;t+=2){
    STEP(pa,pb,t,(t+3<NT),(t+1<NT),(t+1<NT));       ENDW(t);   RESC(); ROT();
    STEP(pb,pa,t+1,(t+4<NT),(t+2<NT),(t+2<NT));     ENDW(t+1); RESC(); ROT();
  }
  STEP(pa,pb,NT-1,false,false,false); RESC();
  { const lds_cptr vp_=vp0+2*sl_cur;
    #pragma unroll
    for(int ks=0;ks<4;++ks){
      #pragma unroll
      for(int db=0;db<4;++db){ s16x4 L_,H_; L_=vtr(vp_+(db*4096+ks*1024)); H_=vtr(vp_+(db*4096+ks*1024+512));
        const bf16x8 pf = ks==0?PAFX(pb,0):(ks==1?PAFX(pb,1):(ks==2?PAFX(pb,2):PAFX(pb,3)));
        o[db]=__builtin_amdgcn_mfma_f32_32x32x16_bf16(pf,VFRF(L_,H_),o[db],0,0,0); } } }
  #undef STEP
  #undef ENDW
  #undef GAPF
  #undef KRD
  #undef PAFX
  #undef VFRF
  #undef VRDF
  {auto rr=__builtin_amdgcn_permlane32_swap(__float_as_uint(l_reg),__float_as_uint(l_reg),false,false);l_reg=__uint_as_float(rr[0])+__uint_as_float(rr[1]);}
  if(hi==0)wsf[32+r32]=l_reg;asm volatile("s_waitcnt lgkmcnt(0)":::"memory");
  float rli[16];
  #pragma unroll
  for(int r=0;r<16;++r)rli[r]=__builtin_amdgcn_rcpf(wsf[32+crow(r,hi)]);
  bf16*Ow=U.o+(long)wrow*U.opitch;
  { bf16*stg=(bf16*)(shm+B_LDS_OST)+wid*2048;
    #pragma unroll
    for(int half=0;half<2;++half){
      #pragma unroll
      for(int r=0;r<16;++r){const int orow=crow(r,hi);
        #pragma unroll
        for(int d0=0;d0<2;++d0)stg[orow*64+d0*32+r32]=__float2bfloat16(o[2*half+d0][r]*rli[r]);}
      asm volatile("s_waitcnt lgkmcnt(0)":::"memory");
      #pragma unroll
      for(int i=0;i<4;++i){const int row=i*8+(lane>>3),ch=lane&7; const u32x4 v=*(const u32x4*)(stg+row*64+ch*8); *(u32x4*)(Ow+(long)row*U.opitch+half*64+ch*8)=v;}
      asm volatile("s_waitcnt lgkmcnt(0)":::"memory"); } }
  asm volatile("s_waitcnt lgkmcnt(0)\n\ts_barrier":::"memory");
  #undef DMA_K
  #undef DMA_V
  #undef RESC
  #undef ROT
  #undef PKW
  #undef EX
  #undef PIN
  #undef MX3
}
#undef SBAR
#undef WAIT_BAR
constexpr int ATTN_LDS_BYTES=(LDS_BYTES>B_LDS_BYTES?LDS_BYTES:B_LDS_BYTES);
}
constexpr int RING_OFF = 0, RING_BYTES = 135168;
constexpr int LDSCTL_OFF = RING_BYTES, MISC_OFF = LDSCTL_OFF + 320;
constexpr int LDS_BYTES = 147456;
static_assert(MISC_OFF + 128 <= LDS_BYTES, "LDS map");
constexpr int LDS_OFFS = LDSCTL_OFF + 2048;
constexpr int LDS_RTR = LDSCTL_OFF + 4608;
static_assert(LDS_RTR + 256 + 224 * 32 <= LDS_BYTES, "router records");
static_assert(attn_body::ATTN_LDS_BYTES <= RING_BYTES && pg8::STAGE_BYTES <= RING_BYTES && 8 * 16640 <= RING_BYTES, "phase scratch fits the ring region");
constexpr int NWAVES = 8;

#define GAS __attribute__((address_space(1)))
#define LAS __attribute__((address_space(3)))
typedef unsigned short bf16;
typedef unsigned v4u __attribute__((ext_vector_type(4)));
typedef unsigned v2u __attribute__((ext_vector_type(2)));
typedef float f32x4 __attribute__((ext_vector_type(4)));
typedef GAS unsigned gu32;
#define RLX_AGENT __ATOMIC_RELAXED, __HIP_MEMORY_SCOPE_AGENT
#define LDS_WAIT() asm volatile("s_waitcnt lgkmcnt(0)" ::: "memory")
#define VM_WAIT() asm volatile("s_waitcnt vmcnt(0)" ::: "memory")
__device__ __forceinline__ unsigned f2bf(float f) { unsigned u = __builtin_bit_cast(unsigned, f); return (u + 0x7fffu + ((u >> 16) & 1u)) >> 16; }
__device__ __forceinline__ unsigned pk2(float lo, float hi) { return f2bf(lo) | (f2bf(hi) << 16); }
__device__ __forceinline__ float bflo(unsigned u) { return __uint_as_float(u << 16); }
__device__ __forceinline__ float bfhi(unsigned u) { return __uint_as_float(u & 0xffff0000u); }

#define XB_TMO      128
#define XB_XCNT(j)  (256  + 64 * (j))
#define XB_XSUB(j)  (1280 + 64 * (j))
#define XB_XGEN(j)  (2304 + 64 * (j))
#define XB_TOP      3328
#define XB_TOPGEN   3392
#define XCD_BAR_WORDS 3456
#define XB_SPIN_CAP (1u << 18)
__device__ __forceinline__ unsigned xb_ld(unsigned* p)              { return __hip_atomic_load(p, __ATOMIC_RELAXED, __HIP_MEMORY_SCOPE_AGENT); }
__device__ __forceinline__ unsigned xb_add(unsigned* p, unsigned v) { return __hip_atomic_fetch_add(p, v, __ATOMIC_RELAXED, __HIP_MEMORY_SCOPE_AGENT); }
__device__ __forceinline__ unsigned xb_xcc_id() { return (unsigned)__builtin_amdgcn_s_getreg((3 << 11) | 20) & 0xFu; }
#define XB_SPIN(cond, bar) do { unsigned _sp = 0; while (cond) { __builtin_amdgcn_s_sleep(1); \
    if ((++_sp & 255u) == 0u) { if (xb_ld(&(bar)[XB_TMO])) break; if (_sp > XB_SPIN_CAP) { atomicAdd(&(bar)[XB_TMO], 1u); break; } } } } while (0)
struct XcdBarrier { unsigned* bar; unsigned x; volatile LAS unsigned* st; };
__device__ __forceinline__ XcdBarrier xcd_barrier_post(unsigned* bar, volatile LAS unsigned* st) {
    XcdBarrier b; b.bar = bar; b.x = xb_xcc_id(); b.st = st;
    if (threadIdx.x == 0) (void)xb_add(&bar[XB_XCNT(b.x)], 1u);
    return b;
}
__device__ __forceinline__ void xcd_barrier_complete(unsigned* bar, unsigned x, unsigned& nloc, unsigned& nx) {
    const unsigned G = gridDim.x * gridDim.y * gridDim.z;
    unsigned sum, cnt, mine, sp = 0u;
    for (;;) {
        sum = 0u; cnt = 0u; mine = 0u;
#pragma unroll
        for (unsigned j = 0; j < 16; ++j) { const unsigned c = xb_ld(&bar[XB_XCNT(j)]); sum += c; cnt += (c > 0u) ? 1u : 0u; mine = (j == x) ? c : mine; }
        if (sum == G) break;
        __builtin_amdgcn_s_sleep(1);
        if ((++sp & 255u) == 0u) { if (xb_ld(&bar[XB_TMO])) break; if (sp > XB_SPIN_CAP) { atomicAdd(&bar[XB_TMO], 1u); break; } }
    }
    nloc = mine > 0u ? mine : 1u; nx = cnt > 0u ? cnt : 1u;
}
__device__ __forceinline__ void xcd_barrier(const XcdBarrier& b) {
    asm volatile("s_waitcnt vmcnt(0)" ::: "memory");
    __syncthreads();
    if (threadIdx.x == 0) {
        unsigned* bar = b.bar;
        __builtin_amdgcn_s_waitcnt(0);
        unsigned nloc = b.st[0], nx = b.st[1];
        if (nloc == 0u) { xcd_barrier_complete(bar, b.x, nloc, nx); b.st[0] = nloc; b.st[1] = nx; }
        const unsigned old = xb_add(&bar[XB_XSUB(b.x)], 1u);
        const unsigned gen = old / nloc;
        if (old + 1u == (gen + 1u) * nloc) {
            __builtin_amdgcn_fence(__ATOMIC_RELEASE, "agent");
            asm volatile("s_waitcnt vmcnt(0)" ::: "memory");
            const unsigned og = xb_add(&bar[XB_TOP], 1u);
            const unsigned tg = og / nx;
            if (og + 1u == (tg + 1u) * nx) xb_add(&bar[XB_TOPGEN], 1u);
            else XB_SPIN(xb_ld(&bar[XB_TOPGEN]) == tg, bar);
            __builtin_amdgcn_fence(__ATOMIC_ACQUIRE, "agent");
            xb_add(&bar[XB_XGEN(b.x)], 1u);
            asm volatile("s_waitcnt vmcnt(0)" ::: "memory");
        } else {
            XB_SPIN(xb_ld(&bar[XB_XGEN(b.x)]) == gen, bar);
            __builtin_amdgcn_fence(__ATOMIC_ACQUIRE, "agent");
            asm volatile("s_waitcnt vmcnt(0)" ::: "memory");
        }
    }
    __syncthreads();
}

struct Args { const float* in[28]; float* out; unsigned char* ws; int ph_lo, ph_hi; };
enum { I_X = 0, I_C, I_CTX, I_CCTX, I_WADA, I_BADA, I_WIN, I_AQN, I_AKN, I_BQN, I_BKN, I_CQN, I_CKN, I_LQ1, I_LK1, I_LQ2, I_LK2, I_SUBLN, I_SINK, I_WBA, I_WBB, I_WBC, I_WOUT, I_WRG, I_WRE, I_WEG, I_WEU, I_WED };
struct Frame { LAS unsigned char* lds; int tid, lane, wave, G, bid; };

__device__ __forceinline__ Frame local_frame(const Frame& F0) { Frame F = F0; int t = F0.tid; asm volatile("" : "+v"(t)); F.tid = t; F.lane = t & 63; return F; }
template <int CTRL> __device__ __forceinline__ float dpp_f(float v) { return __int_as_float(__builtin_amdgcn_update_dpp(0, __float_as_int(v), CTRL, 0xF, 0xF, true)); }
__device__ __forceinline__ float wave_sum(float v) {
    v += dpp_f<0xB1>(v);
    v += dpp_f<0x4E>(v);
    v += dpp_f<0x141>(v);
    v += dpp_f<0x140>(v);
    { auto rr = __builtin_amdgcn_permlane16_swap(__float_as_uint(v), __float_as_uint(v), false, false); v = __uint_as_float(rr[0]) + __uint_as_float(rr[1]); }
    { auto rr = __builtin_amdgcn_permlane32_swap(__float_as_uint(v), __float_as_uint(v), false, false); v = __uint_as_float(rr[0]) + __uint_as_float(rr[1]); }
    return v;
}
__device__ __forceinline__ const float* xrow_c(const float* lat, const float* ctx, int r) { const int b = r / TOKB, i = r - b * TOKB; return i < SEQL ? lat + ((size_t)b * SEQL + i) * DM : ctx + ((size_t)b * CTXL + (i - SEQL)) * DM; }
__device__ __forceinline__ float* xrow_m(float* lat, float* ctx, int r) { const int b = r / TOKB, i = r - b * TOKB; return i < SEQL ? lat + ((size_t)b * SEQL + i) * DM : ctx + ((size_t)b * CTXL + (i - SEQL)) * DM; }
__device__ __forceinline__ int modsel(int r) { const int b = r / TOKB, i = r - b * TOKB; return i < SEQL ? b : 8; }
__device__ __forceinline__ int latrow(int q) { return (q >> 12) * TOKB + (q & 4095); }

__device__ __forceinline__ void ph_prologue(const Frame& F0, const Args& a, float* mod, float* rope) {
    const Frame F = local_frame(F0);
    LAS float* sc = (LAS float*)(F.lds + RING_OFF); LAS float* red = (LAS float*)(F.lds + RING_OFF + 40960);
    if (F.bid < 192) {
        const int l = F.bid / 96, j0 = (F.bid % 96) * 64;
        for (int idx = F.tid; idx < 9 * 1024; idx += NWAVES * 64) { const int s = idx >> 10, k = idx & 1023; const float v = s < 8 ? a.in[I_C][s * 1024 + k] : a.in[I_CCTX][k]; sc[idx] = v / (1.0f + expf(-v)); }
        __syncthreads();
        float acc[9];
#pragma unroll
        for (int s = 0; s < 9; ++s) acc[s] = 0.f;
        const float* wp = a.in[I_WADA] + ((size_t)l * 1024 + F.wave * 128) * 6144 + j0 + F.lane;
#pragma unroll 4
        for (int k = 0; k < 128; ++k) { const float w = wp[(size_t)k * 6144];
#pragma unroll
            for (int s = 0; s < 9; ++s) acc[s] += sc[s * 1024 + F.wave * 128 + k] * w; }
#pragma unroll
        for (int s = 0; s < 9; ++s) red[(F.wave * 9 + s) * 64 + F.lane] = acc[s];
        __syncthreads();
        for (int idx = F.tid; idx < 576; idx += NWAVES * 64) { const int s = idx >> 6, jl = idx & 63; float sum = a.in[I_BADA][l * 6144 + j0 + jl];
#pragma unroll
            for (int w = 0; w < 8; ++w) sum += red[(w * 9 + s) * 64 + jl];
            mod[((size_t)l * 9 + s) * 6144 + j0 + jl] = sum; }
        __syncthreads();
    }
    if (F.bid == F.G - 1) {
        for (int idx = F.tid; idx < 1024; idx += NWAVES * 64) { const int n = idx >> 4, i = idx & 15; const float fr = powf(10000.0f, -(float)i / 16.0f); const float ang = (float)n * fr;
            rope[idx * 2] = cosf(ang); rope[idx * 2 + 1] = sinf(ang); }
    }
}

template <class SrcF, class MapF>
__device__ __forceinline__ void transpose_item(const SrcF& src  , const MapF& nn_of_dr  , bf16* dst  , int ldt, LAS float* scr, int lane) {
    f32x4 v[16];
#pragma unroll
    for (int i = 0; i < 16; ++i) { const int idx = lane + 64 * i; v[i] = __builtin_nontemporal_load((const f32x4*)src(idx >> 4, idx & 15)); }
#pragma unroll
    for (int i = 0; i < 16; ++i) { const int idx = lane + 64 * i; LAS float* d = scr + (idx >> 4) * 65 + (idx & 15) * 4; d[0] = v[i][0]; d[1] = v[i][1]; d[2] = v[i][2]; d[3] = v[i][3]; }
    LDS_WAIT(); asm volatile("" ::: "memory");
    const int c = lane & 7;
#pragma unroll
    for (int j = 0; j < 8; ++j) { const int dr = (lane >> 3) + 8 * j; const LAS float* s = scr + (8 * c) * 65 + nn_of_dr(dr);
        v4u o; o.x = pk2(s[0 * 65], s[1 * 65]); o.y = pk2(s[2 * 65], s[3 * 65]); o.z = pk2(s[4 * 65], s[5 * 65]); o.w = pk2(s[6 * 65], s[7 * 65]);
        *(GAS v4u*)(dst + (size_t)dr * ldt + 8 * c) = o; }
    LDS_WAIT(); asm volatile("" ::: "memory");
}
__device__ __forceinline__ int win_origbase(int t) { return t < 6 ? t * 256 : (t < 12 ? 4608 + (t - 6) * 256 : 1536 + (t - 12) * 256); }
__device__ __forceinline__ void ph_conv_attn(const Frame& F0, const Args& a, int l, bf16* WinT, bf16* WbrT, bf16* WoT, float* WrT) {
    const Frame F = local_frame(F0);
    LAS float* scr = (LAS float*)(F.lds + RING_OFF + F.wave * 16640);
    const int gw = F.bid * NWAVES + F.wave, NGW = F.G * NWAVES;
    constexpr int I_IN = 16 * 96, I_BR = 8 * 16, I_OUT = 16 * 16, NITEMS = I_IN + 3 * I_BR + I_OUT;
    const auto ident = [](int dr) { return dr; };
    for (int it = gw; it < NITEMS; it += NGW) {
        int r = it;
        if (r < I_IN) { const int kb = r / 96, q2 = r % 96, t = q2 >> 2, bj = (q2 >> 1) & 1, wp = q2 & 1;
            const float* W = a.in[I_WIN] + (size_t)l * 1024 * 6144 + (size_t)(kb * 64) * 6144 + win_origbase(t) + bj * 32;
            transpose_item([=](int kk, int q) { return W + (size_t)kk * 6144 + (2 * wp + (q >> 3)) * 64 + 4 * (q & 7); }, ident, WinT + (size_t)(t * 256 + bj * 128 + wp * 64) * 1024 + kb * 64, 1024, scr, F.lane); continue; }
        r -= I_IN;
        if (r < 3 * I_BR) { const int br = r / I_BR, rr = r % I_BR, kb = rr / 16, q = rr % 16;
            const float* W = a.in[I_WBA + br] + (size_t)l * 512 * 1024 + (size_t)(kb * 64) * 1024 + q * 64;
            transpose_item([=](int kk, int q4) { return W + (size_t)kk * 1024 + 4 * q4; }, ident, WbrT + (size_t)br * 1024 * 512 + (size_t)(q * 64) * 512 + kb * 64, 512, scr, F.lane); continue; }
        r -= 3 * I_BR;
        { const int kb = r / 16, q = r % 16;
            const float* W = a.in[I_WOUT] + (size_t)l * 1024 * 1024 + (size_t)(kb * 64) * 1024 + q * 64;
            transpose_item([=](int kk, int q4) { return W + (size_t)kk * 1024 + 4 * q4; }, ident, WoT + (size_t)(q * 64) * 1024 + kb * 64, 1024, scr, F.lane); }
    }
    for (int idx = F.bid * NWAVES * 64 + F.tid; idx < 36 * 1024; idx += F.G * NWAVES * 64) { const int o = idx >> 10, k = idx & 1023;
        WrT[idx] = o < 4 ? a.in[I_WRG][((size_t)l * 1024 + k) * 4 + o] : a.in[I_WRE][((size_t)l * 1024 + k) * 32 + (o - 4)]; }
}
__device__ __forceinline__ void ph_conv_experts(const Frame& F0, const Args& a, int l, bf16* W1t, bf16* W2t) {
    const Frame F = local_frame(F0);
    LAS float* scr = (LAS float*)(F.lds + RING_OFF + F.wave * 16640);
    const int gw = F.bid * NWAVES + F.wave, NGW = F.G * NWAVES;
    constexpr int I_1 = 16 * 16, I_2 = 8 * 16, NITEMS = NEXP * (I_1 + I_2);
    for (int it = gw; it < NITEMS; it += NGW) {
        const int e = it / (I_1 + I_2); int r = it % (I_1 + I_2);
        if (r < I_1) { const int kb = r / 16, gq2 = r % 16, pn = gq2 >> 2, g4 = gq2 & 3, bj = g4 >> 1, wp = g4 & 1; const int hb = pn * 128 + bj * 64 + wp * 32;
            const float* Wg = a.in[I_WEG] + ((size_t)(l * NEXP + e) * 1024 + kb * 64) * EHID + hb;
            const float* Wu = a.in[I_WEU] + ((size_t)(l * NEXP + e) * 1024 + kb * 64) * EHID + hb;
            transpose_item([=](int kk, int q) { return q < 8 ? Wg + (size_t)kk * EHID + 4 * q : Wu + (size_t)kk * EHID + 4 * (q - 8); },
                           [](int dr) { return ((dr >> 2) & 1) * 32 + (dr >> 5) * 16 + ((dr >> 3) & 3) * 4 + (dr & 3); },
                           W1t + ((size_t)e * 1024 + pn * 256 + bj * 128 + wp * 64) * 1024 + kb * 64, 1024, scr, F.lane); }
        else { r -= I_1; const int kb = r / 16, q = r % 16;
            const float* W = a.in[I_WED] + ((size_t)(l * NEXP + e) * EHID + kb * 64) * 1024 + q * 64;
            transpose_item([=](int kk, int q4) { return W + (size_t)kk * 1024 + 4 * q4; }, [](int dr) { return dr; }, W2t + ((size_t)e * 1024 + q * 64) * EHID + kb * 64, EHID, scr, F.lane); }
    }
}

__device__ __forceinline__ void norm_mod_store(const f32x4 (&v)[4], const float* shift, const float* scale, bf16* hrow, int lane) {
    float s2 = 0.f;
#pragma unroll
    for (int j = 0; j < 4; ++j) s2 += (v[j][0] * v[j][0] + v[j][1] * v[j][1]) + (v[j][2] * v[j][2] + v[j][3] * v[j][3]);
    const float rstd = 1.0f / sqrtf(wave_sum(s2) * (1.0f / DM) + 1e-6f);
#pragma unroll
    for (int j = 0; j < 4; ++j) { const int c = 4 * lane + 256 * j; const f32x4 sh = *(const f32x4*)(shift + c), sc = *(const f32x4*)(scale + c);
        const f32x4 h = v[j] * rstd * (sc + 1.0f) + sh; v2u o; o.x = pk2(h[0], h[1]); o.y = pk2(h[2], h[3]); *(v2u*)(hrow + c) = o; }
}
__device__ __forceinline__ void ph_norm1_l0(const Frame& F0, const Args& a, const float* modl, bf16* H) {
    const Frame F = local_frame(F0);
    const int gw = F.bid * NWAVES + F.wave, NGW = F.G * NWAVES;
    for (int r0 = gw; r0 < TT; r0 += 2 * NGW) { const int r1 = (r0 + NGW < TT) ? r0 + NGW : r0;
        const float* x0 = xrow_c(a.in[I_X], a.in[I_CTX], r0); const float* x1 = xrow_c(a.in[I_X], a.in[I_CTX], r1); f32x4 v0[4], v1[4];
#pragma unroll
        for (int j = 0; j < 4; ++j) { v0[j] = *(const f32x4*)(x0 + 4 * F.lane + 256 * j); v1[j] = *(const f32x4*)(x1 + 4 * F.lane + 256 * j); }
        const float* mp0 = modl + (size_t)modsel(r0) * 6144; norm_mod_store(v0, mp0, mp0 + 1024, H + (size_t)r0 * DM, F.lane);
        if (r1 != r0) { const float* mp1 = modl + (size_t)modsel(r1) * 6144; norm_mod_store(v1, mp1, mp1 + 1024, H + (size_t)r1 * DM, F.lane); } }
}
template <bool NORM>
__device__ __forceinline__ void ph_combine(const Frame& F0, float* XL, float* XC, const float* modprev, const float* modnext, const bf16* yout, const int* rte, const int* rtr, bf16* H, bool latent_only, const float* RL = nullptr, const float* RC = nullptr) {
    const Frame F = local_frame(F0);
    const int gw = F.bid * NWAVES + F.wave, NGW = F.G * NWAVES; const int nrows = latent_only ? NB * SEQL : TT;
    const LAS int* offs = (const LAS int*)(F.lds + LDS_OFFS);
    for (int q0 = gw; q0 < nrows; q0 += 2 * NGW) { const int q1 = (q0 + NGW < nrows) ? q0 + NGW : q0; int rr[2]; rr[0] = latent_only ? latrow(q0) : q0; rr[1] = latent_only ? latrow(q1) : q1;
        f32x4 xv[2][4], gg[2][4]; v2u ya[2][4], yb[2][4]; float* xp[2];
#pragma unroll
        for (int k = 0; k < 2; ++k) { const int r = rr[k]; xp[k] = xrow_m(XL, XC, r);
            const int s0 = offs[rte[r]] + rtr[r], s1 = offs[rte[TT + r]] + rtr[TT + r]; const float* gate = modprev + (size_t)modsel(r) * 6144 + 5 * 1024;
#pragma unroll
            for (int j = 0; j < 4; ++j) { const int c = 4 * F.lane + 256 * j; xv[k][j] = *(const f32x4*)((RL ? xrow_c(RL, RC ? RC : XC, r) : (const float*)xp[k]) + c); gg[k][j] = *(const f32x4*)(gate + c);
                ya[k][j] = *(const v2u*)(yout + (size_t)s0 * DM + c); yb[k][j] = *(const v2u*)(yout + (size_t)s1 * DM + c); } }
#pragma unroll
        for (int k = 0; k < 2; ++k) { if (k == 1 && q1 == q0) break; const int r = rr[k]; f32x4 v[4];
#pragma unroll
            for (int j = 0; j < 4; ++j) { const int c = 4 * F.lane + 256 * j; const v2u y0 = ya[k][j], y1 = yb[k][j];
                f32x4 f; f[0] = bflo(y0.x) + bflo(y1.x); f[1] = bfhi(y0.x) + bfhi(y1.x); f[2] = bflo(y0.y) + bflo(y1.y); f[3] = bfhi(y0.y) + bfhi(y1.y);
                v[j] = xv[k][j] + gg[k][j] * f; *(f32x4*)(xp[k] + c) = v[j]; }
            if constexpr (NORM) { const float* mp = modnext + (size_t)modsel(r) * 6144; norm_mod_store(v, mp, mp + 1024, H + (size_t)r * DM, F.lane); } } }
}
template <int R>
__device__ __forceinline__ void ph_norm2_router(const Frame& F0, const float* XL, const float* XC, const float* modl, const float* WrT, bf16* H, int* rte, int* rtr, int* tokr, float* wr, unsigned* cnt, bool latent_only) {
    const Frame F = local_frame(F0);
    const int nrows = latent_only ? NB * SEQL : TT;
    const int nj = (nrows - F.bid + F.G - 1) / F.G;
    LAS int* lcnt = (LAS int*)(F.lds + LDS_RTR);
    LAS int* rec = (LAS int*)(F.lds + LDS_RTR + 256);
    LAS float* wl = (LAS float*)(F.lds + RING_OFF);
    __syncthreads();
    if (F.tid < 64) lcnt[F.tid] = 0;
    for (int i = F.tid; i < NEXP * 256; i += NWAVES * 64) *(LAS f32x4*)(wl + 4 * i) = *(const f32x4*)(WrT + 4 * 1024 + 4 * i);
    __syncthreads();
    for (int j0 = F.wave * R; j0 < nj; j0 += NWAVES * R) {
        f32x4 v[R][4]; int rows[R];
#pragma unroll
        for (int q = 0; q < R; ++q) { int j = j0 + q; if (j >= nj) j = nj - 1; const int qq = F.bid + F.G * j; const int r = latent_only ? latrow(qq) : qq; rows[q] = r;
            const float* x = xrow_c(XL, XC, r);
#pragma unroll
            for (int jj = 0; jj < 4; ++jj) v[q][jj] = *(const f32x4*)(x + 4 * F.lane + 256 * jj);
            float s2 = 0.f;
#pragma unroll
            for (int jj = 0; jj < 4; ++jj) s2 += (v[q][jj][0] * v[q][jj][0] + v[q][jj][1] * v[q][jj][1]) + (v[q][jj][2] * v[q][jj][2] + v[q][jj][3] * v[q][jj][3]);
            const float rstd = 1.0f / sqrtf(wave_sum(s2) * (1.0f / DM) + 1e-6f);
            const float* mp = modl + (size_t)modsel(r) * 6144 + 3 * 1024;
#pragma unroll
            for (int jj = 0; jj < 4; ++jj) { const int c = 4 * F.lane + 256 * jj; const f32x4 sh = *(const f32x4*)(mp + c), sc = *(const f32x4*)(mp + 1024 + c);
                v[q][jj] = v[q][jj] * rstd * (sc + 1.0f) + sh; v2u o; o.x = pk2(v[q][jj][0], v[q][jj][1]); o.y = pk2(v[q][jj][2], v[q][jj][3]);
                if (j0 + q < nj) *(v2u*)(H + (size_t)r * DM + c) = o; } }
        float gl[R][4];
#pragma unroll
        for (int o = 0; o < 4; ++o) { f32x4 w[4];
#pragma unroll
            for (int jj = 0; jj < 4; ++jj) w[jj] = *(const f32x4*)(WrT + o * 1024 + 4 * F.lane + 256 * jj);
#pragma unroll
            for (int q = 0; q < R; ++q) { float p = 0.f;
#pragma unroll
                for (int jj = 0; jj < 4; ++jj) p += (v[q][jj][0] * w[jj][0] + v[q][jj][1] * w[jj][1]) + (v[q][jj][2] * w[jj][2] + v[q][jj][3] * w[jj][3]);
                gl[q][o] = wave_sum(p); } }
        int re0[R], re1[R]; float rw0[R], rw1[R];
#pragma unroll
        for (int q = 0; q < R; ++q) {
            int gi = 0; float gm = gl[q][0];
#pragma unroll
            for (int jj = 1; jj < 4; ++jj) if (gl[q][jj] > gm) { gm = gl[q][jj]; gi = jj; }
            gi = __builtin_amdgcn_readfirstlane(gi);
            float gs = 0.f;
#pragma unroll
            for (int jj = 0; jj < 4; ++jj) gs += __expf(gl[q][jj] - gm);
            const float gwt = __builtin_amdgcn_rcpf(gs);
            const LAS float* We = wl + (8 * gi) * 1024 + 4 * F.lane;
            float ev[8];
#pragma unroll
            for (int k0 = 0; k0 < 8; k0 += 4) {
                f32x4 w[4][4];
#pragma unroll
                for (int kk = 0; kk < 4; ++kk)
#pragma unroll
                    for (int jj = 0; jj < 4; ++jj) w[kk][jj] = *(const LAS f32x4*)(We + (k0 + kk) * 1024 + 256 * jj);
                float p[4];
#pragma unroll
                for (int kk = 0; kk < 4; ++kk) { p[kk] = 0.f;
#pragma unroll
                    for (int jj = 0; jj < 4; ++jj) p[kk] += (v[q][jj][0] * w[kk][jj][0] + v[q][jj][1] * w[kk][jj][1]) + (v[q][jj][2] * w[kk][jj][2] + v[q][jj][3] * w[kk][jj][3]); }
#pragma unroll
                for (int kk = 0; kk < 4; ++kk) ev[k0 + kk] = wave_sum(p[kk]); }
            int i0 = 0; float v0 = ev[0];
#pragma unroll
            for (int jj = 1; jj < 8; ++jj) if (ev[jj] > v0) { v0 = ev[jj]; i0 = jj; }
            int i1 = -1; float v1 = -INFINITY;
#pragma unroll
            for (int jj = 0; jj < 8; ++jj) if (jj != i0 && ev[jj] > v1) { v1 = ev[jj]; i1 = jj; }
            const float tt = __expf(v1 - v0), den = __builtin_amdgcn_rcpf(1.0f + tt);
            rw0[q] = gwt * den; rw1[q] = gwt * tt * den; re0[q] = 8 * gi + i0; re1[q] = 8 * gi + i1;
        }
        if (F.lane == 0) {
#pragma unroll
            for (int q = 0; q < R; ++q) if (j0 + q < nj) {
                const int k0 = atomicAdd((int*)(lcnt + re0[q]), 1), k1 = atomicAdd((int*)(lcnt + re1[q]), 1);
                LAS int* rp = rec + (j0 + q) * 8; rp[0] = re0[q]; rp[1] = re1[q]; rp[2] = k0; rp[3] = k1; rp[4] = __float_as_int(rw0[q]); rp[5] = __float_as_int(rw1[q]); rp[6] = rows[q]; }
        }
    }
    __syncthreads();
    if (F.tid < NEXP) { const int c = lcnt[F.tid]; lcnt[32 + F.tid] = c ? (int)atomicAdd(cnt + F.tid * 64, (unsigned)c) : 0; }
    __syncthreads();
    for (int j = F.tid; j < nj; j += NWAVES * 64) { const LAS int* rp = rec + j * 8; const int e0 = rp[0], e1 = rp[1], r = rp[6];
        const int k0 = lcnt[32 + e0] + rp[2], k1 = lcnt[32 + e1] + rp[3]; const float w0 = __int_as_float(rp[4]), w1 = __int_as_float(rp[5]);
        rte[r] = e0; rte[TT + r] = e1; rtr[r] = k0; rtr[TT + r] = k1;
        tokr[(size_t)e0 * MOE_CAP + k0] = r; tokr[(size_t)e1 * MOE_CAP + k1] = r; wr[(size_t)e0 * MOE_CAP + k0] = w0; wr[(size_t)e1 * MOE_CAP + k1] = w1; }
    __syncthreads();
}
__device__ __forceinline__ void moe_offsets(const Frame& F, unsigned* cnt) {
    LAS int* offs = (LAS int*)(F.lds + LDS_OFFS);
    __syncthreads();
    if (F.tid < NEXP) offs[64 + F.tid] = (int)__hip_atomic_load(cnt + F.tid * 64, RLX_AGENT);
    __syncthreads();
    if (F.tid == 0) { int run = 0; for (int e = 0; e < NEXP; ++e) { offs[e] = run; run += (offs[64 + e] + 255) & ~255; } offs[32] = run; }
    __syncthreads();
}
__device__ __forceinline__ void ph_bpost(const Frame& F0, const Args& a, int l, const bf16* Ob, bf16* Y, bool latent_only) {
    const Frame F = local_frame(F0);
    const float lam_init = (l == 0) ? 0.2f : (0.8f - 0.6f * 0.74081822068f);
    const float s1 = wave_sum(a.in[I_LQ1][l * 64 + F.lane] * a.in[I_LK1][l * 64 + F.lane]), s2 = wave_sum(a.in[I_LQ2][l * 64 + F.lane] * a.in[I_LK2][l * 64 + F.lane]);
    const float lam = expf(s1) - expf(s2) + lam_init, post = 1.0f - lam_init;
    const int n = F.lane >> 4, dd = (F.lane & 15) * 8;
    const f32x4 g0 = *(const f32x4*)(a.in[I_SUBLN] + l * 128 + dd), g1 = *(const f32x4*)(a.in[I_SUBLN] + l * 128 + dd + 4);
    const int gw = F.bid * NWAVES + F.wave, NGW = F.G * NWAVES; const int nrows = latent_only ? NB * SEQL : TT;
    for (int q0 = gw; q0 < nrows; q0 += 4 * NGW) { v4u oa[4], ob[4]; int rr[4];
#pragma unroll
        for (int k = 0; k < 4; ++k) { int q = q0 + k * NGW; if (q >= nrows) q = q0; const int r = latent_only ? latrow(q) : q; rr[k] = r;
            oa[k] = *(const v4u*)(Ob + (size_t)r * OBW + (2 * n) * 128 + dd); ob[k] = *(const v4u*)(Ob + (size_t)r * OBW + (2 * n + 1) * 128 + dd); }
#pragma unroll
        for (int k = 0; k < 4; ++k) { if (k > 0 && q0 + k * NGW >= nrows) break; const v4u o0 = oa[k], o1 = ob[k]; const int r = rr[k];
            float d[8];
            d[0] = bflo(o0.x) - lam * bflo(o1.x); d[1] = bfhi(o0.x) - lam * bfhi(o1.x); d[2] = bflo(o0.y) - lam * bflo(o1.y); d[3] = bfhi(o0.y) - lam * bfhi(o1.y);
            d[4] = bflo(o0.z) - lam * bflo(o1.z); d[5] = bfhi(o0.z) - lam * bfhi(o1.z); d[6] = bflo(o0.w) - lam * bflo(o1.w); d[7] = bfhi(o0.w) - lam * bfhi(o1.w);
            float ss = 0.f;
#pragma unroll
            for (int j = 0; j < 8; ++j) ss += d[j] * d[j];
            ss += dpp_f<0xB1>(ss); ss += dpp_f<0x4E>(ss); ss += dpp_f<0x141>(ss); ss += dpp_f<0x140>(ss);
            const float rs = post / sqrtf(ss * (1.0f / 128.0f) + 1e-6f);
            v4u w; w.x = pk2(d[0] * rs * g0[0], d[1] * rs * g0[1]); w.y = pk2(d[2] * rs * g0[2], d[3] * rs * g0[3]); w.z = pk2(d[4] * rs * g1[0], d[5] * rs * g1[1]); w.w = pk2(d[6] * rs * g1[2], d[7] * rs * g1[3]);
            *(v4u*)(Y + (size_t)r * YW + 512 + n * 128 + dd) = w; } }
}
__device__ __forceinline__ void ph_attention(const Frame& F0, const Args& a, int l, const bf16* P, bf16* Y, bf16* Ob) {
    const Frame F = local_frame(F0);
    using attn_body::AttnU; typedef attn_body::bf16 abf;
    char* shm = (char*)(F.lds + RING_OFF);
    const abf* Pb = (const abf*)P; abf* Yb = (abf*)Y; abf* Obb = (abf*)Ob;
    const float* sinkp = a.in[I_SINK] + l * 8;
    float bnd[3];
    { const int gq[3] = {I_AQN, I_BQN, I_CQN}, gk[3] = {I_AKN, I_BKN, I_CKN};
#pragma unroll
      for (int t = 0; t < 3; ++t) { float mq = fabsf(a.in[gq[t]][l * 64 + F.lane]), mk = fabsf(a.in[gk[t]][l * 64 + F.lane]);
#pragma unroll
          for (int o = 1; o < 64; o <<= 1) { mq = fmaxf(mq, __shfl_xor(mq, o)); mk = fmaxf(mk, __shfl_xor(mk, o)); }
          bnd[t] = __int_as_float(__builtin_amdgcn_readfirstlane(__float_as_int(QSCALE * 64.0f * mq * mk))); } }
    const bool frA = bnd[0] <= 40.0f, frB = bnd[1] <= 40.0f, frC = bnd[2] <= 40.0f;
#define RUN_UNIT(WIN_, fr_, U_) do { if (fr_) attn_body::attn_unit<WIN_, 8, true>(U_, shm); else attn_body::attn_unit<WIN_, 8, false>(U_, shm); } while (0)
    for (int L = F.bid; L < 1024; L += F.G) { const int b = L & 7, s = L >> 3, kh = s >> 6, qb = s & 63; const size_t rb = (size_t)b * TOKB;
        AttnU U; U.q = Pb + (rb + qb * 64) * PW + PC_AQ + kh * 256; U.k = Pb + rb * PW + PC_AK + kh * 64; U.v = Pb + rb * PW + PC_AV + kh * 64;
        U.o = Yb + (rb + qb * 64) * YW + kh * 256; U.opitch = YW; U.rmask = 1; U.rshift = 1; U.NT = 68; U.kbase = 0; U.jq = 0; U.sinkp = nullptr; U.mref = bnd[0];
        RUN_UNIT(false, frA, U); }
    for (int L = F.bid; L < 1024; L += F.G) { const int b = L & 7, s = L >> 3, combo = s >> 4, qb = s & 15, n = combo >> 1, c = combo & 1; const size_t rb = (size_t)b * TOKB;
        AttnU U; U.q = Pb + (rb + qb * 256) * PW + PC_BQ + (2 * n + c) * 64; U.k = Pb + rb * PW + PC_BK + (2 * n + c) * 64; U.v = Pb + rb * PW + PC_BV + n * 128;
        U.o = Obb + (rb + qb * 256) * OBW + (2 * n + c) * 128; U.opitch = OBW; U.rmask = 7; U.rshift = 3; U.NT = 68; U.kbase = 0; U.jq = 0; U.sinkp = nullptr; U.mref = bnd[1];
        if (frB) attn_body::attn_unit_b<8, true>(U, shm); else attn_body::attn_unit_b<8, false>(U, shm); }
#ifndef DUP_C
#define DUP_C 1
#endif
    for (int repc = 0; repc < DUP_C; ++repc)
    for (int L = F.bid; L < 1024; L += F.G) { const int b = L & 7, s = L >> 3, kh = s >> 6, qb = s & 63; const size_t rb = (size_t)b * TOKB;
        AttnU U; U.q = Pb + (rb + qb * 64) * PW + PC_CQ + kh * 256; U.k = Pb + rb * PW + PC_CK + kh * 64; U.v = Pb + rb * PW + PC_CV + kh * 64;
        U.o = Yb + (rb + qb * 64) * YW + 1024 + kh * 256; U.opitch = YW; U.rmask = 1; U.rshift = 1; U.NT = 10; U.kbase = 0; U.jq = qb; U.sinkp = sinkp + kh * 4; U.mref = bnd[2];
        RUN_UNIT(true, frC, U); }
    if (l == 0) {
        for (int L = F.bid; L < 256; L += F.G) { const int b = L & 7, s = L >> 3; const size_t rb = (size_t)b * TOKB; AttnU U; U.NT = 4; U.kbase = SEQL; U.jq = 0; U.sinkp = nullptr;
            if (s < 8) { const int kh = s >> 2, qb = s & 3;
                U.q = Pb + (rb + SEQL + qb * 64) * PW + PC_AQ + kh * 256; U.k = Pb + rb * PW + PC_AK + kh * 64; U.v = Pb + rb * PW + PC_AV + kh * 64;
                U.o = Yb + (rb + SEQL + qb * 64) * YW + kh * 256; U.opitch = YW; U.rmask = 1; U.rshift = 1; }
            else if (s < 24) { const int combo = (s - 8) >> 1, vh = (s - 8) & 1, n = combo >> 1, c = combo & 1;
                U.q = Pb + (rb + SEQL) * PW + PC_BQ + (2 * n + c) * 64; U.k = Pb + rb * PW + PC_BK + (2 * n + c) * 64; U.v = Pb + rb * PW + PC_BV + n * 128 + vh * 64;
                U.o = Obb + (rb + SEQL) * OBW + (2 * n + c) * 128 + vh * 64; U.opitch = OBW; U.rmask = 7; U.rshift = 3; }
            else { const int s2 = s - 24, kh = s2 >> 2, qb = s2 & 3;
                U.q = Pb + (rb + SEQL + qb * 64) * PW + PC_CQ + kh * 256; U.k = Pb + rb * PW + PC_CK + kh * 64; U.v = Pb + rb * PW + PC_CV + kh * 64;
                U.o = Yb + (rb + SEQL + qb * 64) * YW + 1024 + kh * 256; U.opitch = YW; U.rmask = 1; U.rshift = 1; U.sinkp = sinkp + kh * 4; }
            U.mref = 0.f; attn_body::attn_unit<false, 8, false>(U, shm); }
    }
}

constexpr int NPHASE = 22;
__global__ void __launch_bounds__(NWAVES * 64, 2) fwd_kernel(Args args) {
    extern __shared__ __attribute__((aligned(16))) unsigned char lds[];
    Frame F; F.lds = (LAS unsigned char*)lds; F.tid = threadIdx.x; F.lane = F.tid & 63; F.wave = __builtin_amdgcn_readfirstlane(F.tid >> 6); F.G = gridDim.x; F.bid = blockIdx.x;
    unsigned char* ws = args.ws;
    unsigned* ctl = (unsigned*)(ws + WS_CTL);
    float* MOD = (float*)(ws + WS_SMALL + SM_MOD); float* ROPE = (float*)(ws + WS_SMALL + SM_ROPE); float* WRT = (float*)(ws + WS_SMALL + SM_WRT);
    int* RTE = (int*)(ws + WS_SMALL + SM_RTE); int* RTR = (int*)(ws + WS_SMALL + SM_RTR);
    bf16* WINT = (bf16*)(ws + WS_WATT); bf16* WBRT = WINT + (size_t)6144 * 1024; bf16* WOT = WBRT + (size_t)3 * 1024 * 512;
    float* XCTX = (float*)(ws + WS_XCTX); int* TOKR = (int*)(ws + WS_TOKR); float* WRW = (float*)(ws + WS_WR);
    bf16* P = (bf16*)(ws + WS_RP); bf16* MB = (bf16*)(ws + WS_RP); bf16* YOUT = (bf16*)(ws + WS_RP);
    bf16* Gt = (bf16*)(ws + WS_RG); bf16* W1T = (bf16*)(ws + WS_W1T); bf16* W2T = (bf16*)(ws + WS_W2T); bf16* ACT = (bf16*)(ws + WS_ACT);
    bf16* Y = (bf16*)(ws + WS_RY); bf16* H = (bf16*)(ws + WS_RY); bf16* OB = (bf16*)(ws + WS_RO);
    for (int u = F.tid; u < (LDS_BYTES - LDSCTL_OFF) / 4; u += NWAVES * 64) ((LAS unsigned*)(F.lds + LDSCTL_OFF))[u] = 0u;
    __syncthreads();
    volatile LAS unsigned* MISC = (volatile LAS unsigned*)(F.lds + MISC_OFF);
    XcdBarrier bar; bar.bar = ctl + CW_BAR; bar.x = 0; bar.st = nullptr;
    const int lo = args.ph_lo, hi = args.ph_hi;
    if (hi - lo > 1) bar = xcd_barrier_post(ctl + CW_BAR, MISC + 8);
#ifndef SITE_MASK
#define SITE_MASK 0xFFFF
#endif
#define SITE(j) (((SITE_MASK) >> (j)) & 1)
#ifndef DUP_MASK
#define DUP_MASK 0
#endif
#ifndef DRY_MODE
#define DRY_MODE 0
#endif
#define DUP(j) for (int rep_ = 0; rep_ < 1 + ((((DUP_MASK) >> (j)) & 1) && (l == 0 || ((j) != 6))); ++rep_)
#define DUPBAR() do { if (rep_) xcd_barrier(bar); } while (0)
#define IN(k) (lo <= (k) && (k) < hi)
#ifndef PROBE_TIME
#define PROBE_TIME 0
#endif
#if PROBE_TIME
    volatile LAS unsigned* TSL = (volatile LAS unsigned*)(F.lds + LDSCTL_OFF + 4096);
    if (F.tid == 0) { const unsigned long long t0 = __builtin_amdgcn_s_memrealtime(); TSL[16] = (unsigned)t0; TSL[17] = (unsigned)(t0 >> 32); }
#define STAMP(j) do { if (F.tid == 0) { const unsigned long long now_ = __builtin_amdgcn_s_memrealtime(); const unsigned long long last_ = ((unsigned long long)TSL[17] << 32) | TSL[16]; \
        TSL[j] += (unsigned)(now_ - last_); TSL[16] = (unsigned)now_; TSL[17] = (unsigned)(now_ >> 32); } } while (0)
#else
#define STAMP(j) do { } while (0)
#endif
#define SEAM(k, j) do { if (IN(k) && IN((k) + 1)) xcd_barrier(bar); STAMP(j); } while (0)

    { const int l = 0; if (SITE(0) && IN(0)) DUP(0) { DUPBAR(); ph_prologue(F, args, MOD, ROPE); } } SEAM(0, 0);
#pragma nounroll
    for (int l = 0; l < 2; ++l) {
        const int pb = 1 + 10 * l; const float* modl = MOD + (size_t)l * 9 * 6144;
        const bool lat_only = (l == 1);
        const float* srcL = (l == 0) ? args.in[I_X] : args.out; const float* srcC = (l == 0) ? args.in[I_CTX] : XCTX;
        if (SITE(1) && IN(pb + 0)) DUP(1) { DUPBAR();
            ph_conv_attn(F, args, l, WINT, WBRT, WOT, WRT);
            if (l == 0) ph_norm1_l0(F, args, modl, H);
            else { moe_offsets(F, ctl + CW_CNT); const bool dry_ = (((DUP_MASK) >> 1) & 1) && rep_ == 0;
                ph_combine<true>(F, dry_ ? (float*)(ws + WS_RG) : args.out, dry_ ? (float*)(ws + WS_RG + 160 * MiB) : XCTX, MOD, modl, YOUT, RTE, RTR, dry_ ? OB : H, false, dry_ ? args.out : nullptr, dry_ ? XCTX : nullptr); }
        } SEAM(pb + 0, 1);
        if (SITE(2) && IN(pb + 1)) DUP(2) { DUPBAR();
            pg8::Gemm g{DM, DM, DM}; pg8::SchedGrid2 S;
            if (l == 0) S.init(F.G, F.bid, H, DM, WINT, DM, 0, 24, 0, 0, 0, 0); else S.init(F.G, F.bid, H, DM, WINT, DM, 1, 24, 0, 2, 6, 6);
            pg8::EpiProj E{P, Gt, args.in[I_AQN], ROPE, (rep_ > 0) ? (DRY_MODE) : 0};
            LAS float* gl = (LAS float*)(F.lds + LDSCTL_OFF + 512);
            if (F.tid < 384) { const int w = F.tid >> 6, d = F.tid & 63; const int which[6] = {I_AQN, I_BQN, I_CQN, I_AKN, I_BKN, I_CKN}; gl[F.tid] = args.in[which[w]][l * 64 + d]; }
            __syncthreads();
            E.gains = (const float*)gl;
            pg8::gemm_phase<pg8::EpiProj, pg8::SchedGrid2, true>(F.lds + RING_OFF, g, S, E);
        } SEAM(pb + 1, 2);
        if (SITE(3) && IN(pb + 2)) DUP(3) { DUPBAR(); ph_attention(F, args, l, P, Y, OB); } SEAM(pb + 2, 3);
        if (SITE(4) && IN(pb + 3)) DUP(4) { DUPBAR(); ph_bpost(F, args, l, OB, Y, lat_only); } SEAM(pb + 3, 4);
        if (SITE(5) && IN(pb + 4)) DUP(5) { DUPBAR();
            pg8::Gemm g{YW, 512, 512}; pg8::SchedMerge S; S.init(F.G, F.bid, Y, WBRT, lat_only ? 1 : 0);
            pg8::EpiMerge E{Gt, MB};
            pg8::gemm_phase<pg8::EpiMerge, pg8::SchedMerge, true>(F.lds + RING_OFF, g, S, E);
        } SEAM(pb + 4, 5);
        if (SITE(6) && IN(pb + 5)) DUP(6) { DUPBAR();
            pg8::Gemm g{DM, DM, DM}; pg8::SchedGrid2 S; S.init(F.G, F.bid, MB, DM, WOT, DM, lat_only ? 1 : 0, 4, 0, 0, 0, 0);
            pg8::EpiOut E{srcL, srcC, args.out, XCTX, modl};
            pg8::gemm_phase<pg8::EpiOut, pg8::SchedGrid2, true>(F.lds + RING_OFF, g, S, E);
        } SEAM(pb + 5, 6);
        if (SITE(7) && IN(pb + 6)) DUP(7) { DUPBAR();
#ifndef DUP_CONVX
#define DUP_CONVX 1
#endif
#ifndef DUP_ROUTER
#define DUP_ROUTER 1
#endif
            for (int rc_ = 0; rc_ < DUP_CONVX; ++rc_) ph_conv_experts(F, args, l, W1T, W2T);
            ph_norm2_router<4>(F, args.out, XCTX, modl, WRT, H, RTE, RTR, TOKR, WRW, ctl + CW_CNT + (l + ((((DUP_MASK) >> 7) & 1) && rep_ == 0 ? 2 : 0)) * NEXP * 64, lat_only);
            for (int rr_ = 1; rr_ < DUP_ROUTER; ++rr_) ph_norm2_router<4>(F, args.out, XCTX, modl, WRT, H, (int*)(ws + WS_RO), (int*)(ws + WS_RO + 1 * MiB), (int*)(ws + WS_RO + 2 * MiB), (float*)(ws + WS_RO + 8 * MiB), ctl + CW_CNT + (l + 2 * rr_) * NEXP * 64, lat_only);
        } SEAM(pb + 6, 7);
        if (SITE(9) && IN(pb + 8)) DUP(9) { DUPBAR();
            moe_offsets(F, ctl + CW_CNT + l * NEXP * 64);
            pg8::Gemm g{DM, DM, DM}; pg8::SchedMoe S; S.init(F.G, F.bid, (const LAS int*)(F.lds + LDS_OFFS), TOKR, H, DM, W1T, DM, true);
            pg8::EpiAct E{ACT};
            pg8::gemm_phase<pg8::EpiAct, pg8::SchedMoe, true, true>(F.lds + RING_OFF, g, S, E);
        } SEAM(pb + 8, 9);
        if (SITE(10) && IN(pb + 9)) DUP(10) { DUPBAR();
            moe_offsets(F, ctl + CW_CNT + l * NEXP * 64);
            pg8::Gemm g{EHID, EHID, EHID}; pg8::SchedMoe S; S.init(F.G, F.bid, (const LAS int*)(F.lds + LDS_OFFS), TOKR, ACT, EHID, W2T, EHID, false);
            pg8::EpiDown E{YOUT, WRW};
            pg8::gemm_phase<pg8::EpiDown, pg8::SchedMoe, true>(F.lds + RING_OFF, g, S, E);
        } SEAM(pb + 9, 10);
    }
    if (SITE(11) && IN(21)) { const int l = 0; DUP(11) { DUPBAR(); moe_offsets(F, ctl + CW_CNT + NEXP * 64); const bool dry_ = (((DUP_MASK) >> 11) & 1) && rep_ == 0;
        ph_combine<false>(F, dry_ ? (float*)(ws + WS_RG) : args.out, XCTX, MOD + (size_t)9 * 6144, MOD, YOUT, RTE, RTR, H, true, dry_ ? args.out : nullptr, nullptr); } }
#if PROBE_TIME
    {   xcd_barrier(bar); STAMP(11);
        unsigned* TG = (unsigned*)(ws + WS_SMALL + 6 * MiB);
        if (F.bid == 0 && F.tid < 12) __hip_atomic_store(TG + F.tid, TSL[F.tid], RLX_AGENT);
        xcd_barrier(bar);
        unsigned tot = 0; for (int j = 0; j < 12; ++j) tot += __hip_atomic_load(TG + j, RLX_AGENT);
        const unsigned ta = (PROBE_A) >= 12 ? tot : __hip_atomic_load(TG + (PROBE_A) % 12, RLX_AGENT), tb = __hip_atomic_load(TG + (PROBE_B) % 12, RLX_AGENT);
        const float us_a = (float)ta * 0.01f;
        const float cval = sqrtf(us_a), vbig = 1000.0f * (float)tb / (float)tot;
        for (size_t i = (size_t)F.bid * NWAVES * 64 + F.tid; i < (size_t)NB * SEQL * DM; i += (size_t)F.G * NWAVES * 64) args.out[i] = (i == 12345) ? vbig : cval;
    }
#endif
#undef IN
#undef SEAM
}

extern "C" void kernel_launch(void* const* d_in, const int* in_sizes, int n_in, void* d_out, int out_size, void* d_ws, size_t ws_size, hipStream_t stream) {
    static int grid = 0;
    if (grid == 0) {
        if (n_in != 28 || out_size != NB * SEQL * DM || ws_size < WS_END) { fprintf(stderr, "kernel_launch: unexpected problem (n_in %d out %d ws %zu need %zu); nothing launched\n", n_in, out_size, ws_size, (size_t)WS_END); grid = -1; return; }
        int dev = 0, cus = 0;
        if (hipGetDevice(&dev) != hipSuccess || hipDeviceGetAttribute(&cus, hipDeviceAttributeMultiprocessorCount, dev) != hipSuccess) { grid = -1; return; }
        if (hipFuncSetAttribute((const void*)fwd_kernel, hipFuncAttributeMaxDynamicSharedMemorySize, LDS_BYTES) != hipSuccess) { fprintf(stderr, "kernel_launch: hipFuncSetAttribute failed\n"); grid = -1; return; }
        int per_cu = 0;
        if (hipOccupancyMaxActiveBlocksPerMultiprocessor(&per_cu, (const void*)fwd_kernel, NWAVES * 64, LDS_BYTES) != hipSuccess || per_cu < 1) fprintf(stderr, "kernel_launch: occupancy query says %d per CU\n", per_cu);
        (void)hipGetLastError();
        grid = cus;
        if (grid < 160 || grid > 1024) { fprintf(stderr, "kernel_launch: unexpected CU count %d; nothing launched\n", cus); grid = -1; return; }
    }
    if (grid < 0) return;
    if (hipMemsetAsync((char*)d_ws + WS_CTL, 0, CTL_ZERO_BYTES, stream) != hipSuccess) return;
    Args a{};
    for (int i = 0; i < 28; ++i) a.in[i] = (const float*)d_in[i];
    a.out = (float*)d_out; a.ws = (unsigned char*)d_ws;
#if defined(PROBE_CHECK) && PROBE_CHECK
    a.ph_lo = 0; a.ph_hi = 5;
    hipLaunchKernelGGL(fwd_kernel, dim3(grid), dim3(NWAVES * 64), LDS_BYTES, stream, a);
    unsigned* eb = (unsigned*)d_ws + 8;
    hipLaunchKernelGGL(chk_proj, dim3(64 * 96), dim3(64), 0, stream, a, eb);
    hipLaunchKernelGGL(chk_attn, dim3(64 * 24), dim3(64), 0, stream, a, eb + 1);
    hipLaunchKernelGGL(chk_fill, dim3(1024), dim3(256), 0, stream, (float*)d_out, eb, (size_t)out_size);
#elif MK_MULTI
    for (int p = 0; p < NPHASE; ++p) { a.ph_lo = p; a.ph_hi = p + 1; hipLaunchKernelGGL(fwd_kernel, dim3(grid), dim3(NWAVES * 64), LDS_BYTES, stream, a); }
#else
    a.ph_lo = 0; a.ph_hi = NPHASE;
    hipLaunchKernelGGL(fwd_kernel, dim3(grid), dim3(NWAVES * 64), LDS_BYTES, stream, a);
#endif
}
```
